# Optimizing an MI355X kernel written in HIP

```python
import math
import jax, jax.numpy as jnp
from jax import lax
import numpy as np

D_MODEL = 1024
BATCH = 8
SEQ = 2048
DEPTH = 1

CHUNK = 64
N_META = 16
Q_BLOCK = 128
RMS_EPS = 1e-6

D_MIX = D_MODEL
MLA_HEADS = 4
MLA_NOPE = 128
MLA_ROPE = 64
MLA_V = 128
MLA_Q_RANK = 256
MLA_KV_RANK = 128
ROPE_THETA = 10000.0
D_MLA = MLA_HEADS * MLA_V
D_MLA_IN = MLA_Q_RANK + MLA_KV_RANK + MLA_ROPE
RWKV_HEAD = 64
D_RWKV = D_MIX - D_MLA
RWKV_HEADS = D_RWKV // RWKV_HEAD
DECAY_RANK = 64
AAA_RANK = 64
GATE_RANK = 128
GN_EPS = 64e-5
D_RWKV_IN = 3 * D_RWKV + DECAY_RANK + AAA_RANK + GATE_RANK
D_IN = D_MLA_IN + D_RWKV_IN

PEER_HEADS = 8
N_KEYS = 128
N_EXPERTS = N_KEYS * N_KEYS
PEER_KEY_DIM = 256
PEER_HALF = PEER_KEY_DIM // 2
PEER_TOPK = 16
PEER_TOKEN_BLOCK = 128

kernel_name = "hymba_mla_rwkv7_peer_streaming"


def rmsnorm(x, g, eps=RMS_EPS):
    xf = x.astype(jnp.float32)
    y = xf * lax.rsqrt(jnp.mean(xf * xf, axis=-1, keepdims=True) + eps)
    return (y * g.astype(jnp.float32)).astype(x.dtype)


def chunk_ids(length):
    pos = jnp.arange(length)
    return jnp.where(pos < N_META, 0, (pos - N_META) // CHUNK + 1)


def rope_tables(length):
    half = MLA_ROPE // 2
    inv = ROPE_THETA ** (-jnp.arange(half, dtype=jnp.float32) / half)
    ang = jnp.arange(length, dtype=jnp.float32)[:, None] * inv[None, :]
    return jnp.cos(ang), jnp.sin(ang)


def apply_rope(x, cos, sin):
    half = x.shape[-1] // 2
    x1, x2 = x[..., :half], x[..., half:]
    c, s = cos.astype(x.dtype), sin.astype(x.dtype)
    return jnp.concatenate([x1 * c - x2 * s, x1 * s + x2 * c], axis=-1)


def mla_group(p_q, p_kv, p_kr, q_norm_g, w_uq, kv_norm_g, w_ukv, out_g):
    B, L, _ = p_q.shape
    q = (rmsnorm(p_q, q_norm_g) @ w_uq).reshape(B, L, MLA_HEADS, MLA_NOPE + MLA_ROPE).transpose(0, 2, 1, 3)
    kv = (rmsnorm(p_kv, kv_norm_g) @ w_ukv).reshape(B, L, MLA_HEADS, MLA_NOPE + MLA_V).transpose(0, 2, 1, 3)
    k_nope, v = kv[..., :MLA_NOPE], kv[..., MLA_NOPE:]
    cos, sin = rope_tables(L)
    q_nope = q[..., :MLA_NOPE]
    q_rope = apply_rope(q[..., MLA_NOPE:], cos, sin)
    k_rope = apply_rope(p_kr, cos, sin)

    n_blk = -(-L // Q_BLOCK)
    L_pad = n_blk * Q_BLOCK
    pad = L_pad - L
    cid = chunk_ids(L_pad)
    k_cid = cid[:L]

    def to_blocks(t):
        t = jnp.pad(t, ((0, 0), (0, 0), (0, pad), (0, 0)))
        return t.reshape(B, MLA_HEADS, n_blk, Q_BLOCK, t.shape[-1]).transpose(2, 0, 1, 3, 4)

    scale = (MLA_NOPE + MLA_ROPE) ** -0.5

    def attend(blk):
        qn, qr, qc = blk
        s = jnp.einsum('bhqd,bhkd->bhqk', qn, k_nope) + jnp.einsum('bhqr,bkr->bhqk', qr, k_rope)
        s = s.astype(jnp.float32) * scale
        visible = k_cid[None, :] <= qc[:, None]
        s = jnp.where(visible, s, -jnp.inf)
        p = jax.nn.softmax(s, axis=-1).astype(v.dtype)
        return jnp.einsum('bhqk,bhkv->bhqv', p, v)

    o = lax.map(attend, (to_blocks(q_nope), to_blocks(q_rope), cid.reshape(n_blk, Q_BLOCK)))
    o = o.transpose(1, 0, 3, 2, 4).reshape(B, L_pad, D_MLA)[:, :L]
    return rmsnorm(o, out_g)


def token_shift(p):
    return jnp.pad(p, ((0, 0), (1, 0), (0, 0)))[:, :-1]


def rwkv_group(p, mu, w0, w_up, a0, a_up, g_up, k_k, k_a, r_k, ln_w, ln_b):
    B, L, _ = p.shape
    dt = p.dtype
    p = p + mu * (token_shift(p) - p)
    i1 = D_RWKV
    i2 = 2 * D_RWKV
    i3 = 3 * D_RWKV
    i4 = i3 + DECAY_RANK
    i5 = i4 + AAA_RANK
    r, k, v, dw, da, dg = jnp.split(p, [i1, i2, i3, i4, i5], axis=-1)
    w = -jax.nn.softplus(-(w0 + jnp.tanh(dw) @ w_up)) - 0.5
    decay = jnp.exp(-jnp.exp(w.astype(jnp.float32)))
    a = jax.nn.sigmoid(a0 + da @ a_up)
    g = jax.nn.sigmoid(dg) @ g_up

    heads = lambda t: t.reshape(B, L, RWKV_HEADS, RWKV_HEAD)
    kk = heads(k * k_k).astype(jnp.float32)
    kk = kk / jnp.maximum(jnp.sqrt(jnp.sum(kk * kk, axis=-1, keepdims=True)), 1e-12)
    k = k * (1.0 + (a - 1.0) * k_a)
    r_h, k_h, v_h, a_h, w_h = heads(r), heads(k), heads(v), heads(a), heads(decay)
    b_h = kk * a_h

    def step(S, inp):
        r_t, w_t, k_t, v_t, kk_t, b_t = inp
        sa = jnp.einsum('bhij,bhj->bhi', S, -kk_t)
        S = S * w_t[:, :, None, :] + sa[..., :, None] * b_t[:, :, None, :] + v_t[..., :, None] * k_t[:, :, None, :]
        return S, jnp.einsum('bhij,bhj->bhi', S, r_t)

    xs = tuple(t.astype(jnp.float32).transpose(1, 0, 2, 3) for t in (r_h, w_h, k_h, v_h, kk, b_h))
    S0 = jnp.zeros((B, RWKV_HEADS, RWKV_HEAD, RWKV_HEAD), jnp.float32)
    _, o = lax.scan(step, S0, xs)
    o = o.transpose(1, 0, 2, 3)
    mean = jnp.mean(o, axis=-1, keepdims=True)
    var = jnp.mean(jnp.square(o - mean), axis=-1, keepdims=True)
    o = ((o - mean) * lax.rsqrt(var + GN_EPS)).reshape(B, L, D_RWKV)
    o = o * ln_w.astype(jnp.float32) + ln_b.astype(jnp.float32)
    bonus = jnp.sum(r_h * k_h * r_k, axis=-1, keepdims=True) * v_h
    o = o + bonus.reshape(B, L, D_RWKV).astype(jnp.float32)
    return (o * g.astype(jnp.float32)).astype(dt)


def peer_ffn(x, w_q, sub_keys, u, v):
    B, L, D = x.shape
    T = B * L
    t = x.reshape(T, D)
    q = (t @ w_q).reshape(T, PEER_HEADS, 2, PEER_HALF)
    s = jnp.einsum('thcd,hcnd->thcn', q, sub_keys)
    s1, i1 = lax.top_k(s[:, :, 0], PEER_TOPK)
    s2, i2 = lax.top_k(s[:, :, 1], PEER_TOPK)
    cand_s = (s1[..., :, None] + s2[..., None, :]).reshape(T, PEER_HEADS, PEER_TOPK * PEER_TOPK)
    cand_i = (i1[..., :, None] * N_KEYS + i2[..., None, :]).reshape(T, PEER_HEADS, PEER_TOPK * PEER_TOPK)
    top_s, sel = lax.top_k(cand_s, PEER_TOPK)
    idx = jnp.take_along_axis(cand_i, sel, axis=-1)
    gate = jax.nn.softmax(top_s.astype(jnp.float32), axis=-1).astype(x.dtype)

    n_blk = -(-T // PEER_TOKEN_BLOCK)
    pad = n_blk * PEER_TOKEN_BLOCK - T
    tb = jnp.pad(t, ((0, pad), (0, 0))).reshape(n_blk, PEER_TOKEN_BLOCK, D)
    ib = jnp.pad(idx, ((0, pad), (0, 0), (0, 0))).reshape(n_blk, PEER_TOKEN_BLOCK, PEER_HEADS, PEER_TOPK)
    gb = jnp.pad(gate, ((0, pad), (0, 0), (0, 0))).reshape(n_blk, PEER_TOKEN_BLOCK, PEER_HEADS, PEER_TOPK)

    def expert_block(blk):
        xt, it, gt = blk
        u_sel = jnp.take(u, it, axis=0)
        act = jax.nn.gelu(jnp.einsum('td,thkd->thk', xt, u_sel), approximate=False) * gt
        return jnp.einsum('thk,thkd->td', act, jnp.take(v, it, axis=0))

    out = lax.map(expert_block, (tb, ib, gb)).reshape(-1, D)[:T]
    return out.reshape(B, L, D)


def setup_inputs(seed: int = 0) -> dict:
    key = jax.random.key(seed)
    ks = jax.random.split(key, 27)
    f32 = jnp.float32
    nrm = lambda k, shape, sc: jax.random.normal(k, shape, f32) * sc
    gain = lambda k, shape: 1.0 + 0.01 * jax.random.normal(k, shape, f32)
    Ld = DEPTH
    return {
        "x": nrm(ks[0], (BATCH, SEQ, D_MODEL), 1.0),
        "meta_tokens": nrm(ks[1], (N_META, D_MODEL), 1.0),
        "norm_mix_g": gain(ks[2], (Ld, D_MODEL)),
        "w_in": nrm(ks[3], (Ld, D_MODEL, D_IN), D_MODEL ** -0.5),
        "mla_q_norm_g": gain(ks[4], (Ld, MLA_Q_RANK)),
        "mla_w_uq": nrm(ks[5], (Ld, MLA_Q_RANK, MLA_HEADS * (MLA_NOPE + MLA_ROPE)), MLA_Q_RANK ** -0.5),
        "mla_kv_norm_g": gain(ks[6], (Ld, MLA_KV_RANK)),
        "mla_w_ukv": nrm(ks[7], (Ld, MLA_KV_RANK, MLA_HEADS * (MLA_NOPE + MLA_V)), MLA_KV_RANK ** -0.5),
        "mla_out_g": gain(ks[8], (Ld, D_MLA)),
        "rwkv_mu": jax.random.uniform(ks[9], (Ld, D_RWKV_IN), f32, 0.0, 1.0),
        "rwkv_w0": jax.random.uniform(ks[10], (Ld, D_RWKV), f32, -6.0, 0.0),
        "rwkv_w_up": nrm(ks[11], (Ld, DECAY_RANK, D_RWKV), 0.1),
        "rwkv_a0": nrm(ks[12], (Ld, D_RWKV), 0.1),
        "rwkv_a_up": nrm(ks[13], (Ld, AAA_RANK, D_RWKV), 0.1),
        "rwkv_g_up": nrm(ks[14], (Ld, GATE_RANK, D_RWKV), GATE_RANK ** -0.5),
        "rwkv_k_k": 0.85 + nrm(ks[15], (Ld, D_RWKV), 0.02),
        "rwkv_k_a": 1.0 + nrm(ks[16], (Ld, D_RWKV), 0.02),
        "rwkv_r_k": nrm(ks[17], (Ld, RWKV_HEADS, RWKV_HEAD), 0.1),
        "rwkv_ln_w": gain(ks[18], (Ld, D_RWKV)),
        "rwkv_ln_b": nrm(ks[19], (Ld, D_RWKV), 0.01),
        "w_out": nrm(ks[20], (Ld, D_MIX, D_MODEL), D_MIX ** -0.5),
        "norm_ffn_g": gain(ks[21], (Ld, D_MODEL)),
        "peer_w_q": nrm(ks[22], (Ld, D_MODEL, PEER_HEADS * PEER_KEY_DIM), D_MODEL ** -0.5),
        "peer_sub_keys": nrm(ks[23], (Ld, PEER_HEADS, 2, N_KEYS, PEER_HALF), PEER_HALF ** -0.5),
        "peer_u": nrm(ks[24], (Ld, N_EXPERTS, D_MODEL), D_MODEL ** -0.5),
        "peer_v": nrm(ks[25], (Ld, N_EXPERTS, D_MODEL), 0.5),
        "norm_final_g": gain(ks[26], (D_MODEL,)),
    }


def reference(x, meta_tokens, norm_mix_g, w_in, mla_q_norm_g, mla_w_uq, mla_kv_norm_g, mla_w_ukv,
              mla_out_g, rwkv_mu, rwkv_w0, rwkv_w_up, rwkv_a0, rwkv_a_up, rwkv_g_up, rwkv_k_k, rwkv_k_a,
              rwkv_r_k, rwkv_ln_w, rwkv_ln_b, w_out, norm_ffn_g, peer_w_q, peer_sub_keys, peer_u, peer_v,
              norm_final_g):
    B = x.shape[0]
    meta = jnp.broadcast_to(meta_tokens[None].astype(x.dtype), (B, N_META, D_MODEL))
    h = jnp.concatenate([meta, x], axis=1)
    for l in range(DEPTH):
        n = rmsnorm(h, norm_mix_g[l])
        proj = n @ w_in[l]
        p_q, p_kv, p_kr, p_rwkv = jnp.split(
            proj, [MLA_Q_RANK, MLA_Q_RANK + MLA_KV_RANK, D_MLA_IN], axis=-1)
        y_mla = mla_group(p_q, p_kv, p_kr, mla_q_norm_g[l], mla_w_uq[l], mla_kv_norm_g[l],
                          mla_w_ukv[l], mla_out_g[l])
        y_rwkv = rwkv_group(p_rwkv, rwkv_mu[l], rwkv_w0[l], rwkv_w_up[l], rwkv_a0[l], rwkv_a_up[l],
                            rwkv_g_up[l], rwkv_k_k[l], rwkv_k_a[l], rwkv_r_k[l], rwkv_ln_w[l], rwkv_ln_b[l])
        h = h + jnp.concatenate([y_mla, y_rwkv], axis=-1) @ w_out[l]
        h = h + peer_ffn(rmsnorm(h, norm_ffn_g[l]), peer_w_q[l], peer_sub_keys[l], peer_u[l], peer_v[l])
    h = rmsnorm(h, norm_final_g)
    return h[:, N_META:]
```

```cpp
#include <hip/hip_runtime.h>
#include <stdint.h>
#include <math.h>

constexpr int NB_ = 8, SEQ = 2048, NM = 16, L = 2064, T = NB_ * L, TR = NB_ * SEQ, D = 1024, DIN = 2240;
constexpr int NTHR = 256;
constexpr float RMS_EPS = 1e-6f;
typedef unsigned short bf16_t;

struct Params {
  const float *x, *meta, *g_mix, *w_in, *g_q, *w_uq, *g_kv, *w_ukv, *g_out, *mu, *w0, *w_up, *a0, *a_up, *g_up,
      *k_k, *k_a, *r_k, *ln_w, *ln_b, *w_out, *g_ffn, *w_q, *subk, *pu, *pv, *g_fin;
  float* out;
  float *rstd1, *rstdq, *rstdkv;
  bf16_t* proj;
  bf16_t *qf, *kvf, *kr;
  bf16_t *rr, *rk2, *rv, *rkk, *rbb, *rg, *rlw;
  float *omla, *orwkv;
  bf16_t* y;
  float* h2;
  bf16_t* x2;
  bf16_t* pq;
  int* pidx;
  float* pgate;
};

__device__ __forceinline__ bf16_t f2bf(float f) {
  unsigned u = __float_as_uint(f);
  u += 0x7FFFu + ((u >> 16) & 1u);
  return (bf16_t)(u >> 16);
}
__device__ __forceinline__ float bf2f(bf16_t h) { return __uint_as_float(((unsigned)h) << 16); }
__device__ __forceinline__ float wave_sum(float v) {
#pragma unroll
  for (int o = 32; o > 0; o >>= 1) v += __shfl_xor(v, o, 64);
  return v;
}
__device__ __forceinline__ const float* hrow(const Params& p, int tt) {
  int b = tt / L, pos = tt - b * L;
  return pos < NM ? p.meta + (size_t)pos * D : p.x + ((size_t)(b * SEQ + pos - NM)) * D;
}
__device__ __forceinline__ int rt2tt(int rt) { return (rt >> 11) * L + NM + (rt & 2047); }

template <class AF, class BF, class EF>
__device__ __forceinline__ void gemm_naive(int M, int N, int K, AF af, BF bf, EF ef, int bid, int nb) {
  const int ncb = (N + 255) / 256;
  const int ntiles = (M / 8) * ncb;
  for (int tile = bid; tile < ntiles; tile += nb) {
    const int r0 = (tile / ncb) * 8;
    const int n = (tile % ncb) * 256 + threadIdx.x;
    if (n < N) {
      float a0 = 0, a1 = 0, a2 = 0, a3 = 0, a4 = 0, a5 = 0, a6 = 0, a7 = 0;
      for (int k = 0; k < K; ++k) {
        const float bv = bf(k, n);
        a0 += af(r0 + 0, k) * bv; a1 += af(r0 + 1, k) * bv; a2 += af(r0 + 2, k) * bv; a3 += af(r0 + 3, k) * bv;
        a4 += af(r0 + 4, k) * bv; a5 += af(r0 + 5, k) * bv; a6 += af(r0 + 6, k) * bv; a7 += af(r0 + 7, k) * bv;
      }
      ef(r0 + 0, n, a0); ef(r0 + 1, n, a1); ef(r0 + 2, n, a2); ef(r0 + 3, n, a3);
      ef(r0 + 4, n, a4); ef(r0 + 5, n, a5); ef(r0 + 6, n, a6); ef(r0 + 7, n, a7);
    }
  }
}

__device__ void ph_rstd1(const Params& p, int bid, int nb) {
  const int lane = threadIdx.x & 63, wv = threadIdx.x >> 6;
  for (int tt = bid * 4 + wv; tt < T; tt += nb * 4) {
    const float* hr = hrow(p, tt);
    float s = 0;
    for (int c = lane; c < D; c += 64) { float v = hr[c]; s += v * v; }
    s = wave_sum(s);
    if (lane == 0) p.rstd1[tt] = rsqrtf(s * (1.0f / D) + RMS_EPS);
  }
}
__device__ void ph_inproj(const Params& p, int bid, int nb) {
  gemm_naive(T, DIN, D,
      [&](int r, int k) { return hrow(p, r)[k] * p.g_mix[k]; },
      [&](int k, int n) { return p.w_in[(size_t)k * DIN + n]; },
      [&](int r, int n, float v) { p.proj[(size_t)r * DIN + n] = f2bf(v * p.rstd1[r]); }, bid, nb);
}
__device__ void ph_mla_pre(const Params& p, int bid, int nb) {
  const int lane = threadIdx.x & 63, wv = threadIdx.x >> 6;
  for (int tt = bid * 4 + wv; tt < T; tt += nb * 4) {
    const bf16_t* pr = p.proj + (size_t)tt * DIN;
    float s = 0;
    for (int c = lane; c < 256; c += 64) { float v = bf2f(pr[c]); s += v * v; }
    s = wave_sum(s);
    float s2 = 0;
    for (int c = lane; c < 128; c += 64) { float v = bf2f(pr[256 + c]); s2 += v * v; }
    s2 = wave_sum(s2);
    if (lane == 0) { p.rstdq[tt] = rsqrtf(s * (1.0f / 256) + RMS_EPS); p.rstdkv[tt] = rsqrtf(s2 * (1.0f / 128) + RMS_EPS); }
    if (lane < 32) {
      const int pos = tt % L;
      const float inv = exp2f(-(float)lane * (13.287712379549449f / 32.0f));
      const float ang = (float)pos * inv;
      float sn, cs; sincosf(ang, &sn, &cs);
      const float x1 = bf2f(pr[384 + lane]), x2 = bf2f(pr[384 + 32 + lane]);
      p.kr[(size_t)tt * 64 + lane] = f2bf(x1 * cs - x2 * sn);
      p.kr[(size_t)tt * 64 + 32 + lane] = f2bf(x1 * sn + x2 * cs);
    }
  }
}
__device__ void ph_q_up(const Params& p, int bid, int nb) {
  gemm_naive(T, 768, 256,
      [&](int r, int k) { return bf2f(p.proj[(size_t)r * DIN + k]) * p.g_q[k]; },
      [&](int k, int n) { return p.w_uq[(size_t)k * 768 + n]; },
      [&](int r, int n, float v) { p.qf[(size_t)r * 768 + n] = f2bf(v * p.rstdq[r]); }, bid, nb);
}
__device__ void ph_q_rope(const Params& p, int bid, int nb) {
  const int total = T * 4 * 32;
  for (int e = bid * NTHR + threadIdx.x; e < total; e += nb * NTHR) {
    const int i = e & 31, h = (e >> 5) & 3, tt = e >> 7;
    const int pos = tt % L;
    const float inv = exp2f(-(float)i * (13.287712379549449f / 32.0f));
    const float ang = (float)pos * inv;
    float sn, cs; sincosf(ang, &sn, &cs);
    bf16_t* q = p.qf + (size_t)tt * 768 + h * 192 + 128;
    const float x1 = bf2f(q[i]), x2 = bf2f(q[i + 32]);
    q[i] = f2bf(x1 * cs - x2 * sn);
    q[i + 32] = f2bf(x1 * sn + x2 * cs);
  }
}
__device__ void ph_kv_up(const Params& p, int bid, int nb) {
  gemm_naive(T, 1024, 128,
      [&](int r, int k) { return bf2f(p.proj[(size_t)r * DIN + 256 + k]) * p.g_kv[k]; },
      [&](int k, int n) { return p.w_ukv[(size_t)k * 1024 + n]; },
      [&](int r, int n, float v) { p.kvf[(size_t)r * 1024 + n] = f2bf(v * p.rstdkv[r]); }, bid, nb);
}
__device__ void ph_rwkv_prep(const Params& p, float* smem, int bid, int nb) {
  float* ps = smem;
  float* t1 = smem + 1792;
  float* dav = t1 + 64;
  float* sg = dav + 64;
  float* kkraw = sg + 128;
  const int tid = threadIdx.x;
  for (int tt = bid; tt < T; tt += nb) {
    const int pos = tt % L;
    const bf16_t* pr = p.proj + (size_t)tt * DIN + 448;
    __syncthreads();
    for (int c = tid; c < 1792; c += NTHR) {
      const float cur = bf2f(pr[c]);
      const float prev = pos > 0 ? bf2f(pr[c - DIN]) : 0.0f;
      ps[c] = cur + p.mu[c] * (prev - cur);
    }
    __syncthreads();
    if (tid < 64) t1[tid] = tanhf(ps[1536 + tid]);
    else if (tid < 128) dav[tid - 64] = ps[1600 + tid - 64];
    else sg[tid - 128] = 1.0f / (1.0f + expf(-ps[1664 + tid - 128]));
    __syncthreads();
    float av[2];
#pragma unroll
    for (int q = 0; q < 2; ++q) {
      const int c = tid + q * 256;
      float wl = p.w0[c], al = p.a0[c], gv = 0;
#pragma unroll 4
      for (int j = 0; j < 64; ++j) { wl += t1[j] * p.w_up[j * 512 + c]; al += dav[j] * p.a_up[j * 512 + c]; }
#pragma unroll 4
      for (int j = 0; j < 128; ++j) gv += sg[j] * p.g_up[j * 512 + c];
      const float nx = -wl;
      const float sp = fmaxf(nx, 0.0f) + log1pf(expf(-fabsf(nx)));
      const float w = -sp - 0.5f;
      const float lw = -expf(w);
      const float a = 1.0f / (1.0f + expf(-al));
      const float k = ps[512 + c];
      kkraw[c] = k * p.k_k[c];
      av[q] = a;
      const size_t o = (size_t)tt * 512 + c;
      p.rlw[o] = f2bf(lw);
      p.rg[o] = f2bf(gv);
      p.rr[o] = f2bf(ps[c]);
      p.rv[o] = f2bf(ps[1024 + c]);
      p.rk2[o] = f2bf(k * (1.0f + (a - 1.0f) * p.k_a[c]));
    }
    __syncthreads();
#pragma unroll
    for (int q = 0; q < 2; ++q) {
      const int c = tid + q * 256;
      const int h0 = (c >> 6) << 6;
      float ss = 0;
#pragma unroll 8
      for (int j = 0; j < 64; ++j) { float v = kkraw[h0 + j]; ss += v * v; }
      const float nrm = fmaxf(sqrtf(ss), 1e-12f);
      const float kk = kkraw[c] / nrm;
      const size_t o = (size_t)tt * 512 + c;
      p.rkk[o] = f2bf(kk);
      p.rbb[o] = f2bf(kk * av[q]);
    }
  }
}
__device__ void ph_attn(const Params& p, float* smem, int bid, int nb) {
  float* Qs = smem;
  float* Ks = Qs + 64 * 193;
  float* Vs = Ks + 32 * 193;
  float* Ps = Vs + 32 * 128;
  const int tid = threadIdx.x;
  const int q = tid >> 2, sub = tid & 3;
  const float scale = 0.07216878364870322f;
  const int nitems = NB_ * 4 * 33;
  for (int item = bid; item < nitems; item += nb) {
    const int qt = item % 33, h = (item / 33) & 3, b = item / 132;
    const int q0 = qt * 64;
    const int nq = min(64, L - q0);
    __syncthreads();
    for (int e = tid; e < 64 * 192; e += NTHR) {
      const int r = e / 192, d = e - r * 192;
      float v = 0;
      if (r < nq) v = bf2f(p.qf[(size_t)(b * L + q0 + r) * 768 + h * 192 + d]);
      Qs[r * 193 + d] = v;
    }
    const int qpos = q0 + q;
    const int kend_q = (qpos < NM) ? NM : min(L, NM + 64 * ((qpos - NM) / 64 + 1));
    const int qlast = q0 + nq - 1;
    const int kend_max = (qlast < NM) ? NM : min(L, NM + 64 * ((qlast - NM) / 64 + 1));
    float m = -INFINITY, l = 0;
    float o[32];
#pragma unroll
    for (int i = 0; i < 32; ++i) o[i] = 0;
    for (int k0 = 0; k0 < kend_max; k0 += 32) {
      __syncthreads();
      for (int e = tid; e < 32 * 192; e += NTHR) {
        const int r = e / 192, d = e - r * 192;
        const int kp = k0 + r;
        float v = 0;
        if (kp < L) {
          const size_t tt = (size_t)b * L + kp;
          v = d < 128 ? bf2f(p.kvf[tt * 1024 + h * 256 + d]) : bf2f(p.kr[tt * 64 + d - 128]);
        }
        Ks[r * 193 + d] = v;
      }
      for (int e = tid; e < 32 * 128; e += NTHR) {
        const int r = e >> 7, d = e & 127;
        const int kp = k0 + r;
        Vs[e] = kp < L ? bf2f(p.kvf[((size_t)b * L + kp) * 1024 + h * 256 + 128 + d]) : 0.0f;
      }
      __syncthreads();
      float s[8];
#pragma unroll
      for (int j = 0; j < 8; ++j) s[j] = 0;
      for (int d = 0; d < 192; ++d) {
        const float qv = Qs[q * 193 + d];
#pragma unroll
        for (int j = 0; j < 8; ++j) s[j] += qv * Ks[(sub * 8 + j) * 193 + d];
      }
      float mx = -INFINITY;
#pragma unroll
      for (int j = 0; j < 8; ++j) {
        const int kp = k0 + sub * 8 + j;
        s[j] = (kp < kend_q) ? s[j] * scale : -INFINITY;
        mx = fmaxf(mx, s[j]);
      }
      mx = fmaxf(mx, __shfl_xor(mx, 1, 64));
      mx = fmaxf(mx, __shfl_xor(mx, 2, 64));
      const float mn = fmaxf(m, mx);
      const float alpha = (m == -INFINITY) ? 0.0f : expf(m - mn);
      float rs = 0;
#pragma unroll
      for (int j = 0; j < 8; ++j) {
        const float pv = (s[j] == -INFINITY) ? 0.0f : expf(s[j] - mn);
        rs += pv;
        Ps[q * 33 + sub * 8 + j] = pv;
      }
      rs += __shfl_xor(rs, 1, 64);
      rs += __shfl_xor(rs, 2, 64);
      l = l * alpha + rs;
      m = mn;
      __syncthreads();
#pragma unroll
      for (int i = 0; i < 32; ++i) o[i] *= alpha;
      for (int k = 0; k < 32; ++k) {
        const float pv = Ps[q * 33 + k];
#pragma unroll
        for (int i = 0; i < 32; ++i) o[i] += pv * Vs[k * 128 + sub + 4 * i];
      }
    }
    if (q < nq) {
      const float il = 1.0f / l;
      float* dst = p.omla + (size_t)(b * L + q0 + q) * 512 + h * 128;
#pragma unroll
      for (int i = 0; i < 32; ++i) dst[sub + 4 * i] = o[i] * il;
    }
  }
}
__device__ void ph_scan(const Params& p, float* smem, int bid, int nb) {
  const int lane = threadIdx.x & 63, wv = threadIdx.x >> 6;
  float* my = smem + wv * (5 * 8 * 64);
  for (int item = bid * 4 + wv; item < NB_ * 8; item += nb * 4) {
    const int b = item >> 3, h = item & 7;
    float S[64];
#pragma unroll
    for (int j = 0; j < 64; ++j) S[j] = 0;
    for (int t0 = 0; t0 < L; t0 += 8) {
#pragma unroll
      for (int s = 0; s < 8; ++s) {
        const size_t o = ((size_t)b * L + t0 + s) * 512 + h * 64 + lane;
        my[(0 * 8 + s) * 64 + lane] = bf2f(p.rr[o]);
        my[(1 * 8 + s) * 64 + lane] = expf(bf2f(p.rlw[o]));
        my[(2 * 8 + s) * 64 + lane] = bf2f(p.rk2[o]);
        my[(3 * 8 + s) * 64 + lane] = -bf2f(p.rkk[o]);
        my[(4 * 8 + s) * 64 + lane] = bf2f(p.rbb[o]);
      }
      __builtin_amdgcn_s_waitcnt(0);
      __builtin_amdgcn_wave_barrier();
#pragma unroll 1
      for (int s = 0; s < 8; ++s) {
        const size_t o = ((size_t)b * L + t0 + s) * 512 + h * 64 + lane;
        const float vi = bf2f(p.rv[o]);
        const float* R = my + (0 * 8 + s) * 64;
        const float* W = my + (1 * 8 + s) * 64;
        const float* K = my + (2 * 8 + s) * 64;
        const float* A = my + (3 * 8 + s) * 64;
        const float* Bv = my + (4 * 8 + s) * 64;
        float sa = 0;
#pragma unroll
        for (int j = 0; j < 64; ++j) sa += S[j] * A[j];
        float ov = 0;
#pragma unroll
        for (int j = 0; j < 64; ++j) {
          S[j] = S[j] * W[j] + sa * Bv[j] + vi * K[j];
          ov += S[j] * R[j];
        }
        p.orwkv[o] = ov;
      }
      __builtin_amdgcn_wave_barrier();
    }
  }
}
__device__ void ph_post(const Params& p, int bid, int nb) {
  const int lane = threadIdx.x & 63, wv = threadIdx.x >> 6;
  for (int tt = bid * 4 + wv; tt < T; tt += nb * 4) {
    const float* om = p.omla + (size_t)tt * 512;
    float v[8], s = 0;
#pragma unroll
    for (int i = 0; i < 8; ++i) { v[i] = om[lane + 64 * i]; s += v[i] * v[i]; }
    s = wave_sum(s);
    const float rs = rsqrtf(s * (1.0f / 512) + RMS_EPS);
    bf16_t* yr = p.y + (size_t)tt * 1024;
#pragma unroll
    for (int i = 0; i < 8; ++i) yr[lane + 64 * i] = f2bf(v[i] * rs * p.g_out[lane + 64 * i]);
    for (int h = 0; h < 8; ++h) {
      const int c = h * 64 + lane;
      const size_t o = (size_t)tt * 512 + c;
      const float ov = p.orwkv[o];
      const float mean = wave_sum(ov) * (1.0f / 64);
      const float dv = ov - mean;
      const float var = wave_sum(dv * dv) * (1.0f / 64);
      float on = dv * rsqrtf(var + 64e-5f);
      on = on * p.ln_w[c] + p.ln_b[c];
      const float rkr = wave_sum(bf2f(p.rr[o]) * bf2f(p.rk2[o]) * p.r_k[c]);
      on += rkr * bf2f(p.rv[o]);
      yr[512 + c] = f2bf(on * bf2f(p.rg[o]));
    }
  }
}
__device__ void ph_outproj(const Params& p, int bid, int nb) {
  gemm_naive(TR, D, 1024,
      [&](int r, int k) { return bf2f(p.y[(size_t)rt2tt(r) * 1024 + k]); },
      [&](int k, int n) { return p.w_out[(size_t)k * D + n]; },
      [&](int r, int n, float v) { p.h2[(size_t)r * D + n] = hrow(p, rt2tt(r))[n] + v; }, bid, nb);
}
__device__ void ph_norm2(const Params& p, int bid, int nb) {
  const int lane = threadIdx.x & 63, wv = threadIdx.x >> 6;
  for (int rt = bid * 4 + wv; rt < TR; rt += nb * 4) {
    const float* hr = p.h2 + (size_t)rt * D;
    float v[16], s = 0;
#pragma unroll
    for (int i = 0; i < 16; ++i) { v[i] = hr[lane + 64 * i]; s += v[i] * v[i]; }
    s = wave_sum(s);
    const float rs = rsqrtf(s * (1.0f / D) + RMS_EPS);
#pragma unroll
    for (int i = 0; i < 16; ++i) p.x2[(size_t)rt * D + lane + 64 * i] = f2bf(v[i] * rs * p.g_ffn[lane + 64 * i]);
  }
}
__device__ void ph_peerq(const Params& p, int bid, int nb) {
  gemm_naive(TR, 2048, 1024,
      [&](int r, int k) { return bf2f(p.x2[(size_t)r * D + k]); },
      [&](int k, int n) { return p.w_q[(size_t)k * 2048 + n]; },
      [&](int r, int n, float v) { p.pq[(size_t)r * 2048 + n] = f2bf(v); }, bid, nb);
}
__device__ __forceinline__ void wave_argmax(float& bv, int& bi) {
#pragma unroll
  for (int o = 32; o > 0; o >>= 1) {
    const float ov = __shfl_xor(bv, o, 64);
    const int oi = __shfl_xor(bi, o, 64);
    if (ov > bv || (ov == bv && oi < bi)) { bv = ov; bi = oi; }
  }
}
__device__ void ph_peersel(const Params& p, int bid, int nb) {
  const int lane = threadIdx.x & 63, wv = threadIdx.x >> 6;
  for (int item = bid * 4 + wv; item < TR * 8; item += nb * 4) {
    const int rt = item >> 3, h = item & 7;
    const bf16_t* q = p.pq + (size_t)rt * 2048 + h * 256;
    float topS[2]; int topI[2];
#pragma unroll
    for (int c = 0; c < 2; ++c) {
      const float* k0 = p.subk + ((size_t)((h * 2 + c) * 128 + lane)) * 128;
      const float* k1 = k0 + 64 * 128;
      float v0 = 0, v1 = 0;
      for (int d = 0; d < 128; ++d) { const float qv = bf2f(q[c * 128 + d]); v0 += qv * k0[d]; v1 += qv * k1[d]; }
      const int i0 = lane, i1 = lane + 64;
      float myS = 0; int myI = 0;
      for (int it = 0; it < 16; ++it) {
        float bv; int bi;
        if (v0 >= v1) { bv = v0; bi = i0; } else { bv = v1; bi = i1; }
        wave_argmax(bv, bi);
        if (lane == it) { myS = bv; myI = bi; }
        if (bi == i0) v0 = -INFINITY; else if (bi == i1) v1 = -INFINITY;
      }
      topS[c] = myS; topI[c] = myI;
    }
    const int a = lane >> 2, b0 = (lane & 3) * 4;
    const float sa = __shfl(topS[0], a, 64);
    const int ia = __shfl(topI[0], a, 64);
    float c0 = sa + __shfl(topS[1], b0 + 0, 64), c1 = sa + __shfl(topS[1], b0 + 1, 64);
    float c2 = sa + __shfl(topS[1], b0 + 2, 64), c3 = sa + __shfl(topS[1], b0 + 3, 64);
    const int e0 = ia * 128 + __shfl(topI[1], b0 + 0, 64), e1 = ia * 128 + __shfl(topI[1], b0 + 1, 64);
    const int e2 = ia * 128 + __shfl(topI[1], b0 + 2, 64), e3 = ia * 128 + __shfl(topI[1], b0 + 3, 64);
    const int p0 = a * 16 + b0;
    float fS = 0; int fE = 0;
    for (int it = 0; it < 16; ++it) {
      float bv = c0; int bi = p0;
      if (c1 > bv) { bv = c1; bi = p0 + 1; }
      if (c2 > bv) { bv = c2; bi = p0 + 2; }
      if (c3 > bv) { bv = c3; bi = p0 + 3; }
      wave_argmax(bv, bi);
      const int src = bi >> 2;
      const int j = bi & 3;
      const int esel = j == 0 ? e0 : (j == 1 ? e1 : (j == 2 ? e2 : e3));
      const int eid = __shfl(esel, src, 64);
      if (lane == it) { fS = bv; fE = eid; }
      if (lane == src) { if (j == 0) c0 = -INFINITY; else if (j == 1) c1 = -INFINITY; else if (j == 2) c2 = -INFINITY; else c3 = -INFINITY; }
    }
    const float mx = __shfl(fS, 0, 64);
    const float ex = lane < 16 ? expf(fS - mx) : 0.0f;
    const float sm = wave_sum(ex);
    if (lane < 16) {
      p.pidx[(size_t)rt * 128 + h * 16 + lane] = fE;
      p.pgate[(size_t)rt * 128 + h * 16 + lane] = ex / sm;
    }
  }
}
__device__ void ph_expert(const Params& p, int bid, int nb) {
  const int lane = threadIdx.x & 63, wv = threadIdx.x >> 6;
  for (int rt = bid * 4 + wv; rt < TR; rt += nb * 4) {
    float xv[16], ov[16];
#pragma unroll
    for (int j = 0; j < 4; ++j)
#pragma unroll
      for (int e = 0; e < 4; ++e) { xv[j * 4 + e] = bf2f(p.x2[(size_t)rt * D + j * 256 + lane * 4 + e]); ov[j * 4 + e] = 0; }
    for (int kk = 0; kk < 128; ++kk) {
      const int id = p.pidx[(size_t)rt * 128 + kk];
      const float gt = p.pgate[(size_t)rt * 128 + kk];
      const float4* ur = reinterpret_cast<const float4*>(p.pu + (size_t)id * D);
      const float4* vr = reinterpret_cast<const float4*>(p.pv + (size_t)id * D);
      float dot = 0;
#pragma unroll
      for (int j = 0; j < 4; ++j) {
        const float4 u4 = ur[j * 64 + lane];
        dot += xv[j * 4 + 0] * u4.x + xv[j * 4 + 1] * u4.y + xv[j * 4 + 2] * u4.z + xv[j * 4 + 3] * u4.w;
      }
      dot = wave_sum(dot);
      const float act = 0.5f * dot * (1.0f + erff(dot * 0.7071067811865476f)) * gt;
#pragma unroll
      for (int j = 0; j < 4; ++j) {
        const float4 v4 = vr[j * 64 + lane];
        ov[j * 4 + 0] += act * v4.x; ov[j * 4 + 1] += act * v4.y; ov[j * 4 + 2] += act * v4.z; ov[j * 4 + 3] += act * v4.w;
      }
    }
    float ss = 0;
#pragma unroll
    for (int j = 0; j < 4; ++j) {
      const float4 h4 = reinterpret_cast<const float4*>(p.h2 + (size_t)rt * D)[j * 64 + lane];
      ov[j * 4 + 0] += h4.x; ov[j * 4 + 1] += h4.y; ov[j * 4 + 2] += h4.z; ov[j * 4 + 3] += h4.w;
#pragma unroll
      for (int e = 0; e < 4; ++e) ss += ov[j * 4 + e] * ov[j * 4 + e];
    }
    ss = wave_sum(ss);
    const float rs = rsqrtf(ss * (1.0f / D) + RMS_EPS);
#pragma unroll
    for (int j = 0; j < 4; ++j) {
      const float4 g4 = reinterpret_cast<const float4*>(p.g_fin)[j * 64 + lane];
      float4 o4;
      o4.x = ov[j * 4 + 0] * rs * g4.x; o4.y = ov[j * 4 + 1] * rs * g4.y; o4.z = ov[j * 4 + 2] * rs * g4.z; o4.w = ov[j * 4 + 3] * rs * g4.w;
      reinterpret_cast<float4*>(p.out + (size_t)rt * D)[j * 64 + lane] = o4;
    }
  }
}

constexpr int SMEM_FLOATS = 64 * 193 + 32 * 193 + 32 * 128 + 64 * 33 + 64;

template <int PH>
__global__ void __launch_bounds__(NTHR) k_phase(Params p) {
  __shared__ __attribute__((aligned(16))) float smem[SMEM_FLOATS];
  const int bid = blockIdx.x, nb = gridDim.x;
  if constexpr (PH == 0) ph_rstd1(p, bid, nb);
  if constexpr (PH == 1) ph_inproj(p, bid, nb);
  if constexpr (PH == 2) ph_mla_pre(p, bid, nb);
  if constexpr (PH == 3) ph_q_up(p, bid, nb);
  if constexpr (PH == 4) ph_q_rope(p, bid, nb);
  if constexpr (PH == 5) ph_kv_up(p, bid, nb);
  if constexpr (PH == 6) ph_rwkv_prep(p, smem, bid, nb);
  if constexpr (PH == 7) ph_attn(p, smem, bid, nb);
  if constexpr (PH == 8) ph_scan(p, smem, bid, nb);
  if constexpr (PH == 9) ph_post(p, bid, nb);
  if constexpr (PH == 10) ph_outproj(p, bid, nb);
  if constexpr (PH == 11) ph_norm2(p, bid, nb);
  if constexpr (PH == 12) ph_peerq(p, bid, nb);
  if constexpr (PH == 13) ph_peersel(p, bid, nb);
  if constexpr (PH == 14) ph_expert(p, bid, nb);
}

extern "C" void kernel_launch(void* const* d_in, const int* in_sizes, int n_in, void* d_out, int out_size, void* d_ws,
                              size_t ws_size, hipStream_t stream) {
  Params p{};
  const float* const* in = reinterpret_cast<const float* const*>(d_in);
  p.x = in[0]; p.meta = in[1]; p.g_mix = in[2]; p.w_in = in[3]; p.g_q = in[4]; p.w_uq = in[5]; p.g_kv = in[6];
  p.w_ukv = in[7]; p.g_out = in[8]; p.mu = in[9]; p.w0 = in[10]; p.w_up = in[11]; p.a0 = in[12]; p.a_up = in[13];
  p.g_up = in[14]; p.k_k = in[15]; p.k_a = in[16]; p.r_k = in[17]; p.ln_w = in[18]; p.ln_b = in[19]; p.w_out = in[20];
  p.g_ffn = in[21]; p.w_q = in[22]; p.subk = in[23]; p.pu = in[24]; p.pv = in[25]; p.g_fin = in[26];
  p.out = (float*)d_out;
  char* ws = (char*)d_ws;
  size_t off = 0;
  auto take = [&](size_t bytes) { char* r = ws + off; off += (bytes + 255) & ~(size_t)255; return r; };
  p.rstd1 = (float*)take((size_t)T * 4);
  p.rstdq = (float*)take((size_t)T * 4);
  p.rstdkv = (float*)take((size_t)T * 4);
  char* regA = take((size_t)T * DIN * 2);
  char* regB = take((size_t)TR * 2048 * 2);
  char* regC = take((size_t)T * 512 * 2 * 7);
  p.proj = (bf16_t*)regA;
  p.omla = (float*)regA;
  p.orwkv = (float*)(regA + (size_t)T * 512 * 4);
  p.x2 = (bf16_t*)regA;
  p.pidx = (int*)(regA + (size_t)TR * D * 2);
  p.pgate = (float*)(regA + (size_t)TR * D * 2 + (size_t)TR * 128 * 4);
  p.qf = (bf16_t*)regB;
  p.kvf = (bf16_t*)(regB + (size_t)T * 768 * 2);
  p.kr = (bf16_t*)(regB + (size_t)T * (768 + 1024) * 2);
  p.y = (bf16_t*)regB;
  p.pq = (bf16_t*)regB;
  bf16_t* c = (bf16_t*)regC;
  const size_t a512 = (size_t)T * 512;
  p.rr = c; p.rk2 = c + a512; p.rv = c + 2 * a512; p.rkk = c + 3 * a512; p.rbb = c + 4 * a512; p.rg = c + 5 * a512; p.rlw = c + 6 * a512;
  p.h2 = (float*)regC;
  const int G = 2048;
  hipLaunchKernelGGL(k_phase<0>, dim3(G), dim3(NTHR), 0, stream, p);
  hipLaunchKernelGGL(k_phase<1>, dim3(G), dim3(NTHR), 0, stream, p);
  hipLaunchKernelGGL(k_phase<2>, dim3(G), dim3(NTHR), 0, stream, p);
  hipLaunchKernelGGL(k_phase<3>, dim3(G), dim3(NTHR), 0, stream, p);
  hipLaunchKernelGGL(k_phase<4>, dim3(G), dim3(NTHR), 0, stream, p);
  hipLaunchKernelGGL(k_phase<5>, dim3(G), dim3(NTHR), 0, stream, p);
  hipLaunchKernelGGL(k_phase<6>, dim3(G), dim3(NTHR), 0, stream, p);
  hipLaunchKernelGGL(k_phase<7>, dim3(1056), dim3(NTHR), 0, stream, p);
  hipLaunchKernelGGL(k_phase<8>, dim3(16), dim3(NTHR), 0, stream, p);
  hipLaunchKernelGGL(k_phase<9>, dim3(G), dim3(NTHR), 0, stream, p);
  hipLaunchKernelGGL(k_phase<10>, dim3(G), dim3(NTHR), 0, stream, p);
  hipLaunchKernelGGL(k_phase<11>, dim3(G), dim3(NTHR), 0, stream, p);
  hipLaunchKernelGGL(k_phase<12>, dim3(G), dim3(NTHR), 0, stream, p);
  hipLaunchKernelGGL(k_phase<13>, dim3(G), dim3(NTHR), 0, stream, p);
  hipLaunchKernelGGL(k_phase<14>, dim3(G), dim3(NTHR), 0, stream, p);
}
```

```cpp
#include <hip/hip_runtime.h>
#include <hip/hip_cooperative_groups.h>
#include <stdint.h>
#include <stdio.h>
#include <math.h>

constexpr int NB_ = 8, SEQ = 2048, NM = 16, L = 2064, T = NB_ * L, TR = NB_ * SEQ, D = 1024, DIN = 2240;
constexpr int NTHR = 256;
constexpr float RMS_EPS = 1e-6f;
typedef unsigned short bf16_t;
namespace cg = cooperative_groups;

struct Params {
  const float *x, *meta, *g_mix, *w_in, *g_q, *w_uq, *g_kv, *w_ukv, *g_out, *mu, *w0, *w_up, *a0, *a_up, *g_up,
      *k_k, *k_a, *r_k, *ln_w, *ln_b, *w_out, *g_ffn, *w_q, *subk, *pu, *pv, *g_fin;
  float* out;
  float *rstd1;
  float *ossq;
  float *h2ss;
  bf16_t* proj;
  bf16_t *qf, *kn, *vt, *kr;
  float *ropec, *ropes;
  bf16_t *rr, *rk2, *rv, *rkk, *rbb, *rg, *rlw;
  unsigned char *cd_ah, *cd_qm, *cd_bk, *cd_wt, *cd_zt, *cd_vb;
  float* cd_gc;
  bf16_t* h2b;
  int* pidx;
  float* pgate;
  unsigned* bar;
  int never;
  int pad0;
  bf16_t* hb;
  unsigned char *u8, *v8;
  bf16_t *w_inT, *w_uqT, *w_ukvT, *w_outT, *w_qT;
  bf16_t *w_qb;
  bf16_t *subkb;
  bf16_t *w_lrT;
};

__device__ __forceinline__ bf16_t f2bf(float f) {
  unsigned u = __float_as_uint(f);
  u += 0x7FFFu + ((u >> 16) & 1u);
  return (bf16_t)(u >> 16);
}
__device__ __forceinline__ float bf2f(bf16_t h) { return __uint_as_float(((unsigned)h) << 16); }
__device__ __forceinline__ float wave_sum(float v) {
#pragma unroll
  for (int o = 32; o > 0; o >>= 1) v += __shfl_xor(v, o, 64);
  return v;
}
__device__ __forceinline__ const float* hrow(const Params& p, int tt) {
  int b = tt / L, pos = tt - b * L;
  return pos < NM ? p.meta + (size_t)pos * D : p.x + ((size_t)(b * SEQ + pos - NM)) * D;
}
__device__ __forceinline__ int rt2tt(int rt) { return (rt >> 11) * L + NM + (rt & 2047); }

template <class AF, class BF, class EF>
__device__ __forceinline__ void gemm_naive(int M, int N, int K, AF af, BF bf, EF ef, int bid, int nb) {
  const int ncb = (N + 255) / 256;
  const int ntiles = (M / 8) * ncb;
  for (int tile = bid; tile < ntiles; tile += nb) {
    const int r0 = (tile / ncb) * 8;
    const int n = (tile % ncb) * 256 + threadIdx.x;
    if (n < N) {
      float a0 = 0, a1 = 0, a2 = 0, a3 = 0, a4 = 0, a5 = 0, a6 = 0, a7 = 0;
      for (int k = 0; k < K; ++k) {
        const float bv = bf(k, n);
        a0 += af(r0 + 0, k) * bv; a1 += af(r0 + 1, k) * bv; a2 += af(r0 + 2, k) * bv; a3 += af(r0 + 3, k) * bv;
        a4 += af(r0 + 4, k) * bv; a5 += af(r0 + 5, k) * bv; a6 += af(r0 + 6, k) * bv; a7 += af(r0 + 7, k) * bv;
      }
      ef(r0 + 0, n, a0); ef(r0 + 1, n, a1); ef(r0 + 2, n, a2); ef(r0 + 3, n, a3);
      ef(r0 + 4, n, a4); ef(r0 + 5, n, a5); ef(r0 + 6, n, a6); ef(r0 + 7, n, a7);
    }
  }
}


typedef __attribute__((ext_vector_type(8))) short bf16x8;
typedef __attribute__((ext_vector_type(4))) float f32x4;
typedef __attribute__((ext_vector_type(4))) unsigned u32x4;
typedef __attribute__((ext_vector_type(2))) float f32x2;
typedef __attribute__((ext_vector_type(4))) short bf16x4;
typedef __attribute__((ext_vector_type(2))) unsigned u32x2;
constexpr int NCH = 129;

__device__ __forceinline__ uint2 pack4bf(float a, float b, float c, float d) {
  uint2 r;
  r.x = (unsigned)f2bf(a) | ((unsigned)f2bf(b) << 16);
  r.y = (unsigned)f2bf(c) | ((unsigned)f2bf(d) << 16);
  return r;
}

__device__ __forceinline__ bf16x4 pk4(const f32x4 v) {
  const uint2 t = pack4bf(v[0], v[1], v[2], v[3]);
  u32x2 u; u[0] = t.x; u[1] = t.y;
  return __builtin_bit_cast(bf16x4, u);
}
__device__ __forceinline__ f32x4 unpk4(const u32x2 u) {
  f32x4 r;
  r[0] = __uint_as_float(u[0] << 16); r[1] = __uint_as_float(u[0] & 0xffff0000u);
  r[2] = __uint_as_float(u[1] << 16); r[3] = __uint_as_float(u[1] & 0xffff0000u);
  return r;
}
#define MFMA16(a, b, c) __builtin_amdgcn_mfma_f32_16x16x16bf16_1k(a, b, c, 0, 0, 0)
#define MFMA32(a, b, c) __builtin_amdgcn_mfma_f32_16x16x32_bf16(a, b, c, 0, 0, 0)

__device__ __forceinline__ float dpp_sum8(float v) {
  v += __int_as_float(__builtin_amdgcn_update_dpp(0, __float_as_int(v), 0xB1, 0xF, 0xF, true));
  v += __int_as_float(__builtin_amdgcn_update_dpp(0, __float_as_int(v), 0x4E, 0xF, 0xF, true));
  v += __int_as_float(__builtin_amdgcn_update_dpp(0, __float_as_int(v), 0x141, 0xF, 0xF, true));
  return v;
}
__device__ __forceinline__ float tr_reduce16(const float (&pd)[16], int lane) {
  const bool b5 = lane & 32, b4 = lane & 16, b3 = lane & 8, b2 = lane & 4;
  float q8[8], q4[4], q2[2], q1;
#pragma unroll
  for (int i = 0; i < 8; ++i) { const float sd = b5 ? pd[i] : pd[i + 8], kp = b5 ? pd[i + 8] : pd[i]; q8[i] = kp + __shfl_xor(sd, 32, 64); }
#pragma unroll
  for (int i = 0; i < 4; ++i) { const float sd = b4 ? q8[i] : q8[i + 4], kp = b4 ? q8[i + 4] : q8[i]; q4[i] = kp + __shfl_xor(sd, 16, 64); }
#pragma unroll
  for (int i = 0; i < 2; ++i) { const float sd = b3 ? q4[i] : q4[i + 2], kp = b3 ? q4[i + 2] : q4[i]; q2[i] = kp + __shfl_xor(sd, 8, 64); }
  { const float sd = b2 ? q2[0] : q2[1], kp = b2 ? q2[1] : q2[0]; q1 = kp + __shfl_xor(sd, 4, 64); }
  q1 += __shfl_xor(q1, 2, 64);
  q1 += __shfl_xor(q1, 1, 64);
  return q1;
}

struct NoMid { __device__ __forceinline__ void operator()(int, f32x4 (&)[4][4]) const {} };
template <bool TRANS, bool ZERO = true, bool SPLITA = false, class ALoad, class BLoad, class Mid = NoMid>
__device__ __forceinline__ void gemm_tile(char* smem, int m0, int n0, int kt0, int kt1, ALoad aload, BLoad bload, f32x4 (&acc)[4][4], Mid mid = Mid()) {
  const int tid = threadIdx.x, lane = tid & 63, w = tid >> 6, wm = w >> 1, wn = w & 1;
  const int srow = tid >> 3, sslot = tid & 7;
  const int swz = (sslot ^ (srow & 7)) << 4;
  char* sA = smem;
  char* sB = smem + 32768;
  const int g = lane >> 4, r16 = lane & 15;
  const int fa0 = (wm * 64 + r16) * 128 + (((0 + g) ^ (lane & 7)) << 4);
  const int fa1 = (wm * 64 + r16) * 128 + (((4 + g) ^ (lane & 7)) << 4);
  const int fb0 = (wn * 64 + r16) * 128 + (((0 + g) ^ (lane & 7)) << 4);
  const int fb1 = (wn * 64 + r16) * 128 + (((4 + g) ^ (lane & 7)) << 4);
  u32x4 ra[4], rb[4];
#pragma unroll
  for (int i = 0; i < 4; ++i) {
    ra[i] = aload(m0 + srow + 32 * i, kt0 * 64 + sslot * 8, i);
    rb[i] = bload(n0 + srow + 32 * i, kt0 * 64 + sslot * 8);
  }
  if constexpr (ZERO) {
#pragma unroll
    for (int i = 0; i < 4; ++i)
#pragma unroll
      for (int j = 0; j < 4; ++j) acc[i][j] = (f32x4){0.f, 0.f, 0.f, 0.f};
  }
  __syncthreads();
#pragma unroll
  for (int i = 0; i < 4; ++i) {
    *reinterpret_cast<u32x4*>(sA + (srow + 32 * i) * 128 + swz) = ra[i];
    *reinterpret_cast<u32x4*>(sB + (srow + 32 * i) * 128 + swz) = rb[i];
  }
  __syncthreads();
  for (int kt = kt0; kt < kt1; ++kt) {
    const int cur = ((kt - kt0) & 1) * 16384;
    mid(kt, acc);
    if (kt + 1 < kt1) {
#pragma unroll
      for (int i = 0; i < 4; ++i) {
        if (!SPLITA || i < 2) ra[i] = aload(m0 + srow + 32 * i, (kt + 1) * 64 + sslot * 8, i);
        rb[i] = bload(n0 + srow + 32 * i, (kt + 1) * 64 + sslot * 8);
      }
    }
#pragma unroll
    for (int ks = 0; ks < 2; ++ks) {
      if (SPLITA && ks == 1 && kt + 1 < kt1) {
#pragma unroll
        for (int i = 2; i < 4; ++i) ra[i] = aload(m0 + srow + 32 * i, (kt + 1) * 64 + sslot * 8, i);
      }
      bf16x8 af[4], bfr[4];
#pragma unroll
      for (int i = 0; i < 4; ++i) af[i] = *reinterpret_cast<const bf16x8*>(sA + cur + (ks ? fa1 : fa0) + i * 2048);
#pragma unroll
      for (int j = 0; j < 4; ++j) bfr[j] = *reinterpret_cast<const bf16x8*>(sB + cur + (ks ? fb1 : fb0) + j * 2048);
#pragma unroll
      for (int i = 0; i < 4; ++i)
#pragma unroll
        for (int j = 0; j < 4; ++j) {
          if constexpr (TRANS) acc[i][j] = __builtin_amdgcn_mfma_f32_16x16x32_bf16(bfr[j], af[i], acc[i][j], 0, 0, 0);
          else acc[i][j] = __builtin_amdgcn_mfma_f32_16x16x32_bf16(af[i], bfr[j], acc[i][j], 0, 0, 0);
        }
    }
    if (kt + 1 < kt1) {
      const int nxt = 16384 - cur;
#pragma unroll
      for (int i = 0; i < 4; ++i) {
        *reinterpret_cast<u32x4*>(sA + nxt + (srow + 32 * i) * 128 + swz) = ra[i];
        *reinterpret_cast<u32x4*>(sB + nxt + (srow + 32 * i) * 128 + swz) = rb[i];
      }
    }
    __syncthreads();
  }
}
#define GLDS16(gp, lp) __builtin_amdgcn_global_load_lds((const __attribute__((address_space(1))) void*)(gp), (__attribute__((address_space(3))) void*)(lp), 16, 0, 0)
template <bool TRANS, class APtr, class BPtr, class Mid = NoMid>
__device__ __forceinline__ void gemm_tile_glds(char* smem, int m0, int n0, int nk32, APtr aptr, BPtr bptr, f32x4 (&acc)[4][4], Mid mid = Mid()) {
  const int tid = threadIdx.x, lane = tid & 63, w = tid >> 6, wm = w >> 1, wn = w & 1;
  const int lrow = lane >> 2;
  const int schunk = ((lane & 3) ^ ((lrow >> 2) & 3)) * 8;
  const int wb = (__builtin_amdgcn_readfirstlane(tid) >> 6);
  const int g = lane >> 4, r16 = lane & 15;
  const int fsl = (g ^ ((r16 >> 2) & 3)) << 4;
  const int fa = (wm * 64 + r16) * 64 + fsl;
  const int fb = 8192 + (wn * 64 + r16) * 64 + fsl;
#pragma unroll
  for (int i = 0; i < 4; ++i)
#pragma unroll
    for (int j = 0; j < 4; ++j) acc[i][j] = (f32x4){0.f, 0.f, 0.f, 0.f};
  __syncthreads();
  auto issue = [&](int kt) {
    char* st = smem + (kt & 3) * 16384;
#pragma unroll
    for (int i = 0; i < 2; ++i) {
      const int row = 16 * wb + 64 * i + lrow;
      GLDS16(aptr(m0 + row, kt * 32 + schunk), st + (16 * wb + 64 * i) * 64);
      GLDS16(bptr(n0 + row, kt * 32 + schunk), st + 8192 + (16 * wb + 64 * i) * 64);
    }
  };
  issue(0);
  if (nk32 > 1) issue(1);
  if (nk32 > 2) issue(2);
  for (int kt = 0; kt < nk32; ++kt) {
    if (kt + 2 < nk32) asm volatile("s_waitcnt vmcnt(8)\n\ts_barrier" ::: "memory");
    else if (kt + 1 < nk32) asm volatile("s_waitcnt vmcnt(4)\n\ts_barrier" ::: "memory");
    else asm volatile("s_waitcnt vmcnt(0)\n\ts_barrier" ::: "memory");
    if (kt + 3 < nk32) issue(kt + 3);
    mid(kt, acc);
    const char* st = smem + (kt & 3) * 16384;
    bf16x8 af[4], bfr[4];
#pragma unroll
    for (int i = 0; i < 4; ++i) af[i] = *reinterpret_cast<const bf16x8*>(st + fa + i * 1024);
#pragma unroll
    for (int j = 0; j < 4; ++j) bfr[j] = *reinterpret_cast<const bf16x8*>(st + fb + j * 1024);
#pragma unroll
    for (int i = 0; i < 4; ++i)
#pragma unroll
      for (int j = 0; j < 4; ++j) {
        if constexpr (TRANS) acc[i][j] = __builtin_amdgcn_mfma_f32_16x16x32_bf16(bfr[j], af[i], acc[i][j], 0, 0, 0);
        else acc[i][j] = __builtin_amdgcn_mfma_f32_16x16x32_bf16(af[i], bfr[j], acc[i][j], 0, 0, 0);
      }
  }
  __syncthreads();
}
struct NoMidW { __device__ __forceinline__ void operator()(int, f32x4 (&)[4][8]) const {} };
template <class APtr, class BPtr, class Mid = NoMidW>
__device__ __forceinline__ void gemm_tile_wide(char* smem, int m0, int n0, int nk32, APtr aptr, BPtr bptr, f32x4 (&acc)[4][8], Mid mid = Mid()) {
  const int tid = threadIdx.x, lane = tid & 63, w = tid >> 6, wm = w >> 1, wn = w & 1;
  const int lrow = lane >> 2;
  const int schunk = ((lane & 3) ^ ((lrow >> 2) & 3)) * 8;
  const int wb = (__builtin_amdgcn_readfirstlane(tid) >> 6);
  const int g = lane >> 4, r16 = lane & 15;
  const int fsl = (g ^ ((r16 >> 2) & 3)) << 4;
  const int fa = (wm * 64 + r16) * 64 + fsl;
  const int fb = 8192 + (wn * 128 + r16) * 64 + fsl;
#pragma unroll
  for (int i = 0; i < 4; ++i)
#pragma unroll
    for (int j = 0; j < 8; ++j) acc[i][j] = (f32x4){0.f, 0.f, 0.f, 0.f};
  __syncthreads();
  auto issue = [&](int kt) {
    char* st = smem + (kt % 3) * 24576;
#pragma unroll
    for (int i = 0; i < 2; ++i) GLDS16(aptr(m0 + 16 * wb + 64 * i + lrow, kt * 32 + schunk), st + (16 * wb + 64 * i) * 64);
#pragma unroll
    for (int i = 0; i < 4; ++i) GLDS16(bptr(n0 + 16 * wb + 64 * i + lrow, kt * 32 + schunk), st + 8192 + (16 * wb + 64 * i) * 64);
  };
  issue(0);
  if (nk32 > 1) issue(1);
  for (int kt = 0; kt < nk32; ++kt) {
    if (kt + 1 < nk32) asm volatile("s_waitcnt vmcnt(6)\n\ts_barrier" ::: "memory");
    else asm volatile("s_waitcnt vmcnt(0)\n\ts_barrier" ::: "memory");
    if (kt + 2 < nk32) issue(kt + 2);
    mid(kt, acc);
    const char* st = smem + (kt % 3) * 24576;
    bf16x8 af[4], bfr[8];
#pragma unroll
    for (int i = 0; i < 4; ++i) af[i] = *reinterpret_cast<const bf16x8*>(st + fa + i * 1024);
#pragma unroll
    for (int j = 0; j < 8; ++j) bfr[j] = *reinterpret_cast<const bf16x8*>(st + fb + j * 1024);
#pragma unroll
    for (int i = 0; i < 4; ++i)
#pragma unroll
      for (int j = 0; j < 8; ++j) acc[i][j] = __builtin_amdgcn_mfma_f32_16x16x32_bf16(bfr[j], af[i], acc[i][j], 0, 0, 0);
  }
  __syncthreads();
}
__device__ __forceinline__ void stage_acc_half(char* smem, const f32x4 (&acc)[4][8], int half) {
  const int lane = threadIdx.x & 63, w = threadIdx.x >> 6, wm = w >> 1, wn = w & 1, g = lane >> 4, r16 = lane & 15;
  float* Et = reinterpret_cast<float*>(smem);
  __syncthreads();
  if (wn == half) {
#pragma unroll
    for (int i = 0; i < 4; ++i)
#pragma unroll
      for (int j = 0; j < 8; ++j)
        *reinterpret_cast<f32x4*>(Et + (wm * 64 + 16 * i + r16) * 132 + 16 * j + 4 * g) = acc[i][j];
  }
  __syncthreads();
}
template <class Body>
__device__ __forceinline__ void for_tiles_xcd(int MT, int NT, int bid, int nb, Body body) {
  if (nb & 7) {
    for (int e = bid; e < MT * NT; e += nb) body(e / NT, e % NT);
    return;
  }
  const int x = bid & 7, lb = bid >> 3, nlb = nb >> 3;
  const int mper = (MT >> 3) & ~3;
  const int main_cnt = mper * NT;
  for (int q = lb; q < main_cnt; q += nlb) {
    const int patch = q / (4 * NT), r = q - patch * (4 * NT);
    body(x * mper + patch * 4 + (r & 3), r >> 2);
  }
  const int rem = (MT - 8 * mper) * NT;
  for (int e = bid; e < rem; e += nb) body(8 * mper + e / NT, e % NT);
}
__device__ __forceinline__ void st8f(bf16_t* dst, const float (&v)[8]) {
  u32x4 w;
#pragma unroll
  for (int e = 0; e < 4; ++e) w[e] = (unsigned)f2bf(v[2 * e]) | ((unsigned)f2bf(v[2 * e + 1]) << 16);
  *reinterpret_cast<u32x4*>(dst) = w;
}
__device__ __forceinline__ void stage_acc(char* smem, const f32x4 (&acc)[4][4]) {
  const int lane = threadIdx.x & 63, w = threadIdx.x >> 6, wm = w >> 1, wn = w & 1, g = lane >> 4, r16 = lane & 15;
  float* Et = reinterpret_cast<float*>(smem);
#pragma unroll
  for (int i = 0; i < 4; ++i)
#pragma unroll
    for (int j = 0; j < 4; ++j)
      *reinterpret_cast<f32x4*>(Et + (wm * 64 + 16 * i + r16) * 132 + wn * 64 + 16 * j + 4 * g) = acc[i][j];
  __syncthreads();
}
__device__ __forceinline__ void ld8(const char* smem, int row, int col8, float (&v)[8]) {
  const float* Et = reinterpret_cast<const float*>(smem);
  const f32x4 a = *reinterpret_cast<const f32x4*>(Et + row * 132 + col8), b = *reinterpret_cast<const f32x4*>(Et + row * 132 + col8 + 4);
#pragma unroll
  for (int e = 0; e < 4; ++e) { v[e] = a[e]; v[4 + e] = b[e]; }
}
__device__ __forceinline__ float sumsq8(const u32x4 v) {
  float s = 0.f;
#pragma unroll
  for (int q = 0; q < 4; ++q) {
    const float lo = __uint_as_float(v[q] << 16), hi = __uint_as_float(v[q] & 0xffff0000u);
    s += lo * lo + hi * hi;
  }
  return s;
}
__device__ __forceinline__ void rowss_publish(float* rowss, const float (&ss)[4]) {
  const int srow = threadIdx.x >> 3, sslot = threadIdx.x & 7;
#pragma unroll
  for (int i = 0; i < 4; ++i) {
    float v = ss[i];
    v += __shfl_xor(v, 1, 64); v += __shfl_xor(v, 2, 64); v += __shfl_xor(v, 4, 64);
    if (sslot == 0) rowss[srow + 32 * i] = v;
  }
  __syncthreads();
}
template <bool TRANS, class ARow, class BRow, class Epi>
__device__ __forceinline__ void gemm_bf16(char* smem, int mtiles, int N, int K, ARow arow, BRow brow,
                                          Epi epi, int bid, int nb) {
  const int lane = threadIdx.x & 63, w = threadIdx.x >> 6, wm = w >> 1, wn = w & 1, g = lane >> 4, r16 = lane & 15;
  const int ntn = (N + 127) >> 7;
  for (int tile = bid; tile < mtiles * ntn; tile += nb) {
    const int tm = tile / ntn, tn = tile - tm * ntn;
    const int m0 = tm * 128, n0 = tn * 128;
    f32x4 acc[4][4];
    gemm_tile<TRANS>(smem, m0, n0, 0, K >> 6,
        [&](int r, int k, int) { return *reinterpret_cast<const u32x4*>(arow(r) + k); },
        [&](int n, int k) { return *reinterpret_cast<const u32x4*>(brow(min(n, N - 1)) + k); }, acc);
    if constexpr (TRANS) epi(acc, m0 + wm * 64 + r16, n0 + wn * 64 + 4 * g);
    else epi(acc, m0 + wm * 64 + 4 * g, n0 + wn * 64 + r16);
  }
}

__device__ __forceinline__ void wtrans(const float* __restrict__ W, const float* __restrict__ gk, int K, int N, bf16_t* out,
                                       int gtid, int gthreads, int glim = 1 << 30) {
  const int total = N * (K >> 3);
  for (int idx = gtid; idx < total; idx += gthreads) {
    const int n = idx % N, kc = idx / N;
    float v[8];
#pragma unroll
    for (int i = 0; i < 8; ++i) {
      const int k = kc * 8 + i;
      v[i] = W[(size_t)k * N + n] * ((gk && k < glim) ? gk[k] : 1.0f);
    }
    uint4 o;
    uint2 lo = pack4bf(v[0], v[1], v[2], v[3]), hi = pack4bf(v[4], v[5], v[6], v[7]);
    o.x = lo.x; o.y = lo.y; o.z = hi.x; o.w = hi.y;
    *reinterpret_cast<uint4*>(out + (size_t)n * K + kc * 8) = o;
  }
}

__device__ __forceinline__ void ph_prep(const Params& p, int bid, int nb) {
  const int lane = threadIdx.x & 63, wv = threadIdx.x >> 6;
  for (int tt = bid * 4 + wv; tt < T; tt += nb * 4) {
    const float4* hr = reinterpret_cast<const float4*>(hrow(p, tt));
    float s = 0;
#pragma unroll
    for (int j = 0; j < 4; ++j) {
      const float4 v = hr[j * 64 + lane];
      s += v.x * v.x + v.y * v.y + v.z * v.z + v.w * v.w;
      *reinterpret_cast<uint2*>(p.hb + (size_t)tt * D + (j * 64 + lane) * 4) = pack4bf(v.x, v.y, v.z, v.w);
    }
    s = wave_sum(s);
    if (lane == 0) p.rstd1[tt] = rsqrtf(s * (1.0f / D) + RMS_EPS);
  }
  const int gtid = bid * NTHR + threadIdx.x, gth = nb * NTHR;
  for (int e = gtid; e < L * 32; e += gth) {
    const int i = e & 31, pos = e >> 5;
    const float inv = exp2f(-(float)i * (13.287712379549449f / 32.0f));
    float sn, cs; sincosf((float)pos * inv, &sn, &cs);
    p.ropec[e] = cs; p.ropes[e] = sn;
  }
  wtrans(p.w_in, p.g_mix, 1024, DIN, p.w_inT, gtid, gth);
  wtrans(p.w_uq, p.g_q, 256, 768, p.w_uqT, gtid, gth);
  wtrans(p.w_ukv, p.g_kv, 128, 1024, p.w_ukvT, gtid, gth);
  wtrans(p.w_out, p.g_out, 1024, 1024, p.w_outT, gtid, gth, 512);
  for (int e = gtid; e < 1024 * 2048 / 4; e += gth) {
    const f32x4 v = *reinterpret_cast<const f32x4*>(p.w_q + (size_t)e * 4);
    *reinterpret_cast<uint2*>(p.w_qb + (size_t)e * 4) = pack4bf(v[0], v[1], v[2], v[3]);
  }
  for (int e = gtid; e < 8 * 2 * 128 * 128 / 4; e += gth) {
    const f32x4 v = *reinterpret_cast<const f32x4*>(p.subk + (size_t)e * 4);
    *reinterpret_cast<uint2*>(p.subkb + (size_t)e * 4) = pack4bf(v[0], v[1], v[2], v[3]);
  }
  for (int e = gtid; e < 1536 * 128; e += gth) {
    const int n = e >> 7, k = e & 127;
    float v = 0.f;
    if (n < 512) { if (k < 64) v = p.w_up[k * 512 + n]; }
    else if (n < 1024) { if (k < 64) v = p.a_up[k * 512 + n - 512]; }
    else v = p.g_up[k * 512 + n - 1024];
    p.w_lrT[e] = f2bf(v);
  }
}
__device__ __forceinline__ void ph_inproj(const Params& p, char* smem, int bid, int nb) {
  const int lane = threadIdx.x & 63, w = threadIdx.x >> 6, wm = w >> 1, wn = w & 1, g = lane >> 4, r16 = lane & 15;
  for_tiles_xcd(T / 128, (DIN + 127) >> 7, bid, nb, [&](int tm, int tn) {
    const int m0 = tm * 128, n0 = tn * 128;
    f32x4 acc[4][4];
    gemm_tile_glds<true>(smem, m0, n0, 32,
        [&](int r, int k) { return p.hb + (size_t)r * D + k; },
        [&](int n, int k) { return p.w_inT + (size_t)min(n, DIN - 1) * 1024 + k; }, acc);
    float rsq[8];
#pragma unroll
    for (int q = 0; q < 8; ++q) rsq[q] = p.rstd1[m0 + ((threadIdx.x + 256 * q) >> 4)];
    stage_acc(smem, acc);
#pragma unroll
    for (int q = 0; q < 8; ++q) {
      const int c = threadIdx.x + 256 * q;
      const int row = c >> 4, col8 = (c & 15) * 8;
      const int m = m0 + row, n = n0 + col8;
      const float rs = rsq[q];
      float v[8];
      ld8(smem, row, col8, v);
      if (n0 == 384 && col8 < 64) {
        if (col8 < 32) {
          float v2[8], y1[8], y2[8];
          ld8(smem, row, col8 + 32, v2);
          const int pos = m % L;
          const f32x4 c0 = *reinterpret_cast<const f32x4*>(p.ropec + pos * 32 + col8), c1 = *reinterpret_cast<const f32x4*>(p.ropec + pos * 32 + col8 + 4);
          const f32x4 s0 = *reinterpret_cast<const f32x4*>(p.ropes + pos * 32 + col8), s1 = *reinterpret_cast<const f32x4*>(p.ropes + pos * 32 + col8 + 4);
#pragma unroll
          for (int e = 0; e < 8; ++e) {
            const float cs = e < 4 ? c0[e] : c1[e - 4], sn = e < 4 ? s0[e] : s1[e - 4];
            const float x1 = v[e] * rs, x2 = v2[e] * rs;
            y1[e] = x1 * cs - x2 * sn; y2[e] = x1 * sn + x2 * cs;
          }
          st8f(p.kr + (size_t)m * 64 + col8, y1);
          st8f(p.kr + (size_t)m * 64 + 32 + col8, y2);
        }
      } else if (n < DIN) {
#pragma unroll
        for (int e = 0; e < 8; ++e) v[e] *= rs;
        st8f(p.proj + (size_t)m * DIN + n, v);
      }
    }
  });
}
__device__ __forceinline__ void ph_w2(const Params& p, char* smem, int bid, int nb) {
  for (int e = bid; e < 128; e += nb) {
    const int hc = e >> 3, n0 = (e & 7) * 128;
    f32x4 acc[4][4];
    gemm_tile_glds<true>(smem, 0, n0, 4,
        [&](int r, int k) { return p.subkb + ((size_t)hc * 128 + r) * 128 + k; },
        [&](int n, int k) { return p.w_qb + (size_t)n * 2048 + hc * 128 + k; }, acc);
    stage_acc(smem, acc);
#pragma unroll 2
    for (int q = 0; q < 8; ++q) {
      const int c = threadIdx.x + 256 * q;
      const int row = c >> 4, col8 = (c & 15) * 8;
      float v[8];
      ld8(smem, row, col8, v);
      const f32x4 g0 = *reinterpret_cast<const f32x4*>(p.g_ffn + n0 + col8), g1 = *reinterpret_cast<const f32x4*>(p.g_ffn + n0 + col8 + 4);
#pragma unroll
      for (int e2 = 0; e2 < 8; ++e2) v[e2] *= e2 < 4 ? g0[e2] : g1[e2 - 4];
      st8f(p.w_qT + ((size_t)hc * 128 + row) * 1024 + n0 + col8, v);
    }
  }
}
__device__ __forceinline__ void ph_q_up(const Params& p, char* smem, int bid, int nb) {
  const int lane = threadIdx.x & 63, w = threadIdx.x >> 6, wm = w >> 1, wn = w & 1, g = lane >> 4, r16 = lane & 15;
  float* rowss = reinterpret_cast<float*>(smem);
  for_tiles_xcd(T / 128, 6, bid, nb, [&](int tm, int tn) {
    const int m0 = tm * 128, n0 = tn * 128;
    f32x4 acc[4][4];
    float ss[4] = {0.f, 0.f, 0.f, 0.f};
    gemm_tile<true>(smem, m0, n0, 0, 4,
        [&](int r, int k, int i) { const u32x4 v = *reinterpret_cast<const u32x4*>(p.proj + (size_t)r * DIN + k); ss[i] += sumsq8(v); return v; },
        [&](int n, int k) { return *reinterpret_cast<const u32x4*>(p.w_uqT + (size_t)n * 256 + k); }, acc);
    float rsum[4];
#pragma unroll
    for (int i = 0; i < 4; ++i) {
      float v = ss[i];
      v += __shfl_xor(v, 1, 64); v += __shfl_xor(v, 2, 64); v += __shfl_xor(v, 4, 64);
      rsum[i] = v;
    }
    stage_acc(smem, acc);
    float* rowss2 = reinterpret_cast<float*>(smem + 128 * 132 * 4);
    if ((threadIdx.x & 7) == 0) {
#pragma unroll
      for (int i = 0; i < 4; ++i) rowss2[(threadIdx.x >> 3) + 32 * i] = rsum[i];
    }
    __syncthreads();
#pragma unroll 2
    for (int q = 0; q < 8; ++q) {
      const int c = threadIdx.x + 256 * q;
      const int row = c >> 4, col8 = (c & 15) * 8;
      const int m = m0 + row, n = n0 + col8;
      const float rs = rsqrtf(rowss2[row] * (1.0f / 256) + RMS_EPS) * (0.07216878364870322f * 1.4426950408889634f);
      const int off = n % 192;
      float v[8];
      ld8(smem, row, col8, v);
      if (off >= 128) {
        if (off < 160) {
          float v2[8], y1[8], y2[8];
          ld8(smem, row, col8 + 32, v2);
          const int pos = m % L, ii = off - 128;
          const f32x4 c0 = *reinterpret_cast<const f32x4*>(p.ropec + pos * 32 + ii), c1 = *reinterpret_cast<const f32x4*>(p.ropec + pos * 32 + ii + 4);
          const f32x4 s0 = *reinterpret_cast<const f32x4*>(p.ropes + pos * 32 + ii), s1 = *reinterpret_cast<const f32x4*>(p.ropes + pos * 32 + ii + 4);
#pragma unroll
          for (int e = 0; e < 8; ++e) {
            const float cs = e < 4 ? c0[e] : c1[e - 4], sn = e < 4 ? s0[e] : s1[e - 4];
            const float x1 = v[e] * rs, x2 = v2[e] * rs;
            y1[e] = x1 * cs - x2 * sn; y2[e] = x1 * sn + x2 * cs;
          }
          st8f(p.qf + (size_t)m * 768 + n, y1);
          st8f(p.qf + (size_t)m * 768 + n + 32, y2);
        }
      } else {
#pragma unroll
        for (int e = 0; e < 8; ++e) v[e] *= rs;
        st8f(p.qf + (size_t)m * 768 + n, v);
      }
    }
  });
}
__device__ __forceinline__ void ph_kv_up(const Params& p, char* smem, int bid, int nb) {
  const int lane = threadIdx.x & 63, w = threadIdx.x >> 6, wm = w >> 1, wn = w & 1, g = lane >> 4, r16 = lane & 15;
  float* rowss = reinterpret_cast<float*>(smem);
  for_tiles_xcd(T / 128, 8, bid, nb, [&](int tm, int tn) {
    const bool vpart = tn >= 4;
    const int m0 = tm * 128, n0 = (tn & 3) * 128;
    f32x4 acc[4][4];
    float ss[4] = {0.f, 0.f, 0.f, 0.f};
    auto al = [&](int r, int k, int i) { const u32x4 v = *reinterpret_cast<const u32x4*>(p.proj + (size_t)r * DIN + 256 + k); ss[i] += sumsq8(v); return v; };
    if (!vpart) {
      gemm_tile<true>(smem, m0, n0, 0, 2, al,
          [&](int n, int k) { return *reinterpret_cast<const u32x4*>(p.w_ukvT + (size_t)((n >> 7) * 256 + (n & 127)) * 128 + k); }, acc);
      float rsum[4];
#pragma unroll
      for (int i = 0; i < 4; ++i) {
        float v = ss[i];
        v += __shfl_xor(v, 1, 64); v += __shfl_xor(v, 2, 64); v += __shfl_xor(v, 4, 64);
        rsum[i] = v;
      }
      stage_acc(smem, acc);
      float* rowss2 = reinterpret_cast<float*>(smem + 128 * 132 * 4);
      if ((threadIdx.x & 7) == 0) {
#pragma unroll
        for (int i = 0; i < 4; ++i) rowss2[(threadIdx.x >> 3) + 32 * i] = rsum[i];
      }
      __syncthreads();
#pragma unroll 2
      for (int q = 0; q < 8; ++q) {
        const int c = threadIdx.x + 256 * q;
        const int row = c >> 4, col8 = (c & 15) * 8;
        const int m = m0 + row, n = n0 + col8;
        const float rs = rsqrtf(rowss2[row] * (1.0f / 128) + RMS_EPS);
        const int b = m / L, pos = m - b * L;
        float v[8];
        ld8(smem, row, col8, v);
#pragma unroll
        for (int e = 0; e < 8; ++e) v[e] *= rs;
        st8f(p.kn + ((size_t)((b * 4 + (n >> 7)) * L + pos)) * 128 + (n & 127), v);
      }
    } else {
      gemm_tile<false>(smem, m0, n0, 0, 2, al,
          [&](int n, int k) { return *reinterpret_cast<const u32x4*>(p.w_ukvT + (size_t)((n >> 7) * 256 + 128 + (n & 127)) * 128 + k); }, acc);
      rowss_publish(rowss, ss);
      const int mb = m0 + wm * 64 + 4 * g, nbase = n0 + wn * 64 + r16;
#pragma unroll
      for (int i = 0; i < 4; ++i) {
        const int m = mb + 16 * i;
        f32x4 rs;
#pragma unroll
        for (int r = 0; r < 4; ++r) rs[r] = rsqrtf(rowss[wm * 64 + 16 * i + 4 * g + r] * (1.0f / 128) + RMS_EPS);
        const int b = m / L, pos = m - b * L;
#pragma unroll
        for (int j = 0; j < 4; ++j) {
          const int n = nbase + 16 * j;
          const int h = n >> 7, dv = n & 127;
          const f32x4 v = acc[i][j] * rs;
          *reinterpret_cast<uint2*>(p.vt + ((size_t)((b * 4 + h) * 128 + dv)) * L + pos) = pack4bf(v[0], v[1], v[2], v[3]);
        }
      }
    }
  });
}
__device__ __forceinline__ float fast_rcp(float x) { return __builtin_amdgcn_rcpf(x); }
__device__ __forceinline__ float fast_sigmoid(float x) { return fast_rcp(1.0f + __expf(-x)); }
__device__ __forceinline__ float fast_tanh(float x) { return 1.0f - 2.0f * fast_rcp(1.0f + __expf(2.0f * x)); }
__device__ __forceinline__ float lerp_tok(const Params& p, int tt, int pos, int c) {
  const float cur = bf2f(p.proj[(size_t)tt * DIN + 448 + c]);
  const float prev = pos > 0 ? bf2f(p.proj[(size_t)(tt - 1) * DIN + 448 + c]) : 0.0f;
  return cur + p.mu[c] * (prev - cur);
}
__device__ __forceinline__ f32x4 lerp4(const Params& p, int tt, int pos, int c) {
  const f32x4 cur = unpk4(*reinterpret_cast<const u32x2*>(p.proj + (size_t)tt * DIN + 448 + c));
  f32x4 prev = {0.f, 0.f, 0.f, 0.f};
  if (pos > 0) prev = unpk4(*reinterpret_cast<const u32x2*>(p.proj + (size_t)(tt - 1) * DIN + 448 + c));
  const f32x4 m = *reinterpret_cast<const f32x4*>(p.mu + c);
  return cur + m * (prev - cur);
}
__device__ __forceinline__ void ph_rwkv_prep(const Params& p, char* smem, int bid, int nb) {
  const int lane = threadIdx.x & 63, w = threadIdx.x >> 6, wm = w >> 1, wn = w & 1, g = lane >> 4, r16 = lane & 15;
  for_tiles_xcd(T / 128, 12, bid, nb, [&](int tm, int tn) {
    const int kind = tn >> 2, n0 = (tn & 3) * 128;
    const int m0 = tm * 128;
    const int kbase = kind == 0 ? 1536 : (kind == 1 ? 1600 : 1664);
    f32x4 acc[4][4];
    gemm_tile<true>(smem, m0, n0, 0, kind == 2 ? 2 : 1,
        [&](int r, int k, int) {
          const int pos = r % L;
          const u32x4 cu = *reinterpret_cast<const u32x4*>(p.proj + (size_t)r * DIN + 448 + kbase + k);
          u32x4 pv = {0u, 0u, 0u, 0u};
          if (pos > 0) pv = *reinterpret_cast<const u32x4*>(p.proj + (size_t)(r - 1) * DIN + 448 + kbase + k);
          u32x4 o;
#pragma unroll
          for (int q = 0; q < 4; ++q) {
            float c0 = __uint_as_float(cu[q] << 16), c1 = __uint_as_float(cu[q] & 0xffff0000u);
            const float p0 = __uint_as_float(pv[q] << 16), p1 = __uint_as_float(pv[q] & 0xffff0000u);
            c0 += p.mu[kbase + k + 2 * q] * (p0 - c0);
            c1 += p.mu[kbase + k + 2 * q + 1] * (p1 - c1);
            if (kind == 0) { c0 = fast_tanh(c0); c1 = fast_tanh(c1); }
            else if (kind == 2) { c0 = fast_sigmoid(c0); c1 = fast_sigmoid(c1); }
            o[q] = (unsigned)f2bf(c0) | ((unsigned)f2bf(c1) << 16);
          }
          return o;
        },
        [&](int n, int k) { return *reinterpret_cast<const u32x4*>(p.w_lrT + (size_t)(kind * 512 + n) * 128 + k); }, acc);
    float* Et = reinterpret_cast<float*>(smem);
#pragma unroll
    for (int i = 0; i < 4; ++i)
#pragma unroll
      for (int j = 0; j < 4; ++j)
        *reinterpret_cast<f32x4*>(Et + (wm * 64 + 16 * i + r16) * 132 + wn * 64 + 16 * j + 4 * g) = acc[i][j];
    __syncthreads();
    const int coloff = kind == 0 ? 0 : (kind == 1 ? 512 : 1024);
    bf16_t* const xdst = kind == 0 ? p.rr : (kind == 1 ? p.rk2 : p.rv);
    bf16_t* const ldst = kind == 0 ? p.rlw : (kind == 1 ? p.rkk : p.rg);
    const int chh = n0 + (threadIdx.x & 15) * 8;
    const f32x4 mu0 = *reinterpret_cast<const f32x4*>(p.mu + coloff + chh), mu1 = *reinterpret_cast<const f32x4*>(p.mu + coloff + chh + 4);
#pragma unroll 1
    for (int qb = 0; qb < 8; qb += 4) {
    u32x4 cuv[4], pvv[4];
#pragma unroll
    for (int qi = 0; qi < 4; ++qi) {
      const int c = threadIdx.x + 256 * (qb + qi);
      const int m = m0 + (c >> 4);
      const bf16_t* pc = p.proj + (size_t)m * DIN + 448 + coloff + n0 + (c & 15) * 8;
      cuv[qi] = *reinterpret_cast<const u32x4*>(pc);
      pvv[qi] = *reinterpret_cast<const u32x4*>(pc - ((m % L) > 0 ? DIN : 0));
    }
#pragma unroll
    for (int qi = 0; qi < 4; ++qi) {
      const int q = qb + qi;
      const int c = threadIdx.x + 256 * q;
      const int row = c >> 4, ch = n0 + (c & 15) * 8;
      const int m = m0 + row, pos = m % L;
      const f32x4 l0 = *reinterpret_cast<const f32x4*>(Et + row * 132 + (c & 15) * 8);
      const f32x4 l1 = *reinterpret_cast<const f32x4*>(Et + row * 132 + (c & 15) * 8 + 4);
      const u32x4 cu = cuv[qi];
      u32x4 pv = pvv[qi];
      if (pos == 0) pv = (u32x4){0u, 0u, 0u, 0u};
      float xs[8], lr[8];
#pragma unroll
      for (int e = 0; e < 4; ++e) {
        const float c0 = __uint_as_float(cu[e] << 16), c1 = __uint_as_float(cu[e] & 0xffff0000u);
        const float p0 = __uint_as_float(pv[e] << 16), p1 = __uint_as_float(pv[e] & 0xffff0000u);
        const float m0_ = e < 2 ? mu0[2 * e] : mu1[2 * e - 4], m1_ = e < 2 ? mu0[2 * e + 1] : mu1[2 * e - 3];
        xs[2 * e] = c0 + m0_ * (p0 - c0);
        xs[2 * e + 1] = c1 + m1_ * (p1 - c1);
      }
#pragma unroll
      for (int e = 0; e < 4; ++e) { lr[e] = l0[e]; lr[4 + e] = l1[e]; }
      const size_t o = (size_t)m * 512 + ch;
      if (kind == 0) {
        const f32x4 w00 = *reinterpret_cast<const f32x4*>(p.w0 + ch), w01 = *reinterpret_cast<const f32x4*>(p.w0 + ch + 4);
        float lw[8];
#pragma unroll
        for (int e = 0; e < 8; ++e) {
          const float nx = -(lr[e] + (e < 4 ? w00[e] : w01[e - 4]));
          const float sp = fmaxf(nx, 0.0f) + __logf(1.0f + __expf(-fabsf(nx)));
          lw[e] = -__expf(-sp - 0.5f);
        }
        st8f(ldst + o, lw);
        st8f(xdst + o, xs);
      } else if (kind == 2) {
        st8f(ldst + o, lr);
        st8f(xdst + o, xs);
      } else {
        const f32x4 a00 = *reinterpret_cast<const f32x4*>(p.a0 + ch), a01 = *reinterpret_cast<const f32x4*>(p.a0 + ch + 4);
        const f32x4 kk0 = *reinterpret_cast<const f32x4*>(p.k_k + ch), kk1 = *reinterpret_cast<const f32x4*>(p.k_k + ch + 4);
        const f32x4 ka0 = *reinterpret_cast<const f32x4*>(p.k_a + ch), ka1 = *reinterpret_cast<const f32x4*>(p.k_a + ch + 4);
        float av[8], kkr[8], ss = 0.f;
#pragma unroll
        for (int e = 0; e < 8; ++e) {
          av[e] = fast_sigmoid(lr[e] + (e < 4 ? a00[e] : a01[e - 4]));
          kkr[e] = xs[e] * (e < 4 ? kk0[e] : kk1[e - 4]);
          ss += kkr[e] * kkr[e];
        }
        ss = dpp_sum8(ss);
        const float inr = 1.0f / fmaxf(sqrtf(ss), 1e-12f);
        float kkn[8], k2[8], bb[8];
#pragma unroll
        for (int e = 0; e < 8; ++e) {
          kkn[e] = kkr[e] * inr;
          k2[e] = xs[e] * (1.0f + (av[e] - 1.0f) * (e < 4 ? ka0[e] : ka1[e - 4]));
          bb[e] = kkn[e] * av[e];
        }
        st8f(ldst + o, kkn);
        st8f(xdst + o, k2);
        st8f(p.rbb + o, bb);
      }
    }
    }
  });
}
template <bool STORE = true>
__device__ __forceinline__ void ph_attn(const Params& p, char* smem, int bid, int nb) {
  char* Kb = smem;
  char* Vs = smem + 49152;
  const int tid = threadIdx.x, lane = tid & 63, w = tid >> 6, g = lane >> 4, r16 = lane & 15;
  const int wu = __builtin_amdgcn_readfirstlane(tid) >> 6;
  const int nitems = 32 * 17;
  for (int it = bid; it < nitems; it += nb) {
    const int bh = it & 31, grp = it >> 5;
    const bool meta = grp == 16;
    const int j = 15 - grp;
    const int b = bh >> 2, h = bh & 3;
    const int qbase = meta ? 0 : 16 + 128 * j;
    const int ntiles = meta ? 1 : 2 * j + 3;
    const int my_ntiles = meta ? 1 : (w < 2 ? 2 * j + 2 : 2 * j + 3);
    bf16x8 qf[2][6];
#pragma unroll
    for (int nt = 0; nt < 2; ++nt)
#pragma unroll
      for (int ks = 0; ks < 6; ++ks) {
        const int pos = qbase + 32 * w + 16 * nt + r16;
        qf[nt][ks] = *reinterpret_cast<const bf16x8*>(p.qf + ((size_t)(b * L + pos)) * 768 + h * 192 + ks * 32 + 8 * g);
      }
    f32x4 o[8][2];
#pragma unroll
    for (int a = 0; a < 8; ++a) { o[a][0] = (f32x4){0.f, 0.f, 0.f, 0.f}; o[a][1] = (f32x4){0.f, 0.f, 0.f, 0.f}; }
    float mrun[2] = {-1e30f, -1e30f}, lrun[2] = {0.f, 0.f};
    const bf16_t* knb = p.kn + (size_t)(b * 4 + h) * L * 128;
    const bf16_t* krb = p.kr + (size_t)b * L * 64;
    const bf16_t* vtb = p.vt + (size_t)(b * 4 + h) * 128 * L;
    int koff[6], voff[4];
    unsigned kmask = 0;
#pragma unroll
    for (int i = 0; i < 6; ++i) {
      const int Lk = 64 * (6 * wu + i) + lane;
      const int row = Lk / 24, sp = Lk - row * 24;
      const int ch = (sp & ~7) | ((sp ^ row) & 7);
      if (ch < 16) koff[i] = row * 128 + ch * 8; else { koff[i] = row * 64 + (ch - 16) * 8; kmask |= 1u << i; }
    }
#pragma unroll
    for (int i = 0; i < 4; ++i) {
      const int row = 8 * (4 * wu + i) + (lane >> 3);
      voff[i] = row * L + (((lane & 7) ^ ((row >> 1) & 7)) * 8);
    }
    auto issueK = [&](int t) {
      const int kp0 = t == 0 ? 0 : 16 + 64 * (t - 1);
      char* dst = Kb + (t & 1) * 24576;
      const bf16_t* kb0 = knb + (size_t)kp0 * 128;
      const bf16_t* kb1 = krb + (size_t)kp0 * 64;
#pragma unroll
      for (int i = 0; i < 6; ++i) GLDS16(((kmask >> i) & 1u ? kb1 : kb0) + koff[i], dst + (6 * wu + i) * 1024);
    };
    auto issueV = [&](int t) {
      const int kp0 = t == 0 ? 0 : 16 + 64 * (t - 1);
      const bf16_t* vb0 = vtb + kp0;
#pragma unroll
      for (int i = 0; i < 4; ++i) GLDS16(vb0 + voff[i], Vs + (4 * wu + i) * 1024);
    };
    __syncthreads();
    issueK(0);
    asm volatile("s_waitcnt vmcnt(0)\n\ts_barrier" ::: "memory");
    for (int t = 0; t < ntiles; ++t) {
      const char* Ks = Kb + (t & 1) * 24576;
      issueV(t);
      if (t + 1 < ntiles) issueK(t + 1);
      bf16x8 pb[2][2];
      if (t < my_ntiles) {
        f32x4 s[4][2];
#pragma unroll
        for (int a = 0; a < 4; ++a) { s[a][0] = (f32x4){0.f, 0.f, 0.f, 0.f}; s[a][1] = (f32x4){0.f, 0.f, 0.f, 0.f}; }
#pragma unroll
        for (int ks = 0; ks < 6; ++ks) {
          const int slot = ks * 4 + g;
          const int so = ((slot & ~7) | ((slot ^ lane) & 7)) << 4;
#pragma unroll
          for (int mt = 0; mt < 4; ++mt) {
            const bf16x8 kf = *reinterpret_cast<const bf16x8*>(Ks + (mt * 16 + r16) * 384 + so);
            s[mt][0] = __builtin_amdgcn_mfma_f32_16x16x32_bf16(kf, qf[0][ks], s[mt][0], 0, 0, 0);
            s[mt][1] = __builtin_amdgcn_mfma_f32_16x16x32_bf16(kf, qf[1][ks], s[mt][1], 0, 0, 0);
          }
        }
        if (t == 0) {
#pragma unroll
          for (int mt = 1; mt < 4; ++mt) { s[mt][0] = (f32x4){-1e30f, -1e30f, -1e30f, -1e30f}; s[mt][1] = s[mt][0]; }
        }
#pragma unroll
        for (int nt = 0; nt < 2; ++nt) {
          float mx = -1e30f;
#pragma unroll
          for (int mt = 0; mt < 4; ++mt)
#pragma unroll
            for (int r = 0; r < 4; ++r) mx = fmaxf(mx, s[mt][nt][r]);
          mx = fmaxf(mx, __shfl_xor(mx, 16, 64));
          mx = fmaxf(mx, __shfl_xor(mx, 32, 64));
          const float mn = fmaxf(mrun[nt], mx);
          const float alpha = __builtin_amdgcn_exp2f(mrun[nt] - mn);
          mrun[nt] = mn;
          float rs = 0.f;
#pragma unroll
          for (int mt = 0; mt < 4; ++mt)
#pragma unroll
            for (int r = 0; r < 4; ++r) { const float pv = __builtin_amdgcn_exp2f(s[mt][nt][r] - mn); s[mt][nt][r] = pv; rs += pv; }
          lrun[nt] = lrun[nt] * alpha + rs;
#pragma unroll
          for (int a = 0; a < 8; ++a) o[a][nt] *= alpha;
#pragma unroll
          for (int k2 = 0; k2 < 2; ++k2) {
            const uint2 lo = pack4bf(s[2 * k2][nt][0], s[2 * k2][nt][1], s[2 * k2][nt][2], s[2 * k2][nt][3]);
            const uint2 hi = pack4bf(s[2 * k2 + 1][nt][0], s[2 * k2 + 1][nt][1], s[2 * k2 + 1][nt][2], s[2 * k2 + 1][nt][3]);
            u32x4 pk; pk[0] = lo.x; pk[1] = lo.y; pk[2] = hi.x; pk[3] = hi.y;
            pb[k2][nt] = __builtin_bit_cast(bf16x8, pk);
          }
        }
      }
      if (t + 1 < ntiles) asm volatile("s_waitcnt vmcnt(6)\n\ts_barrier" ::: "memory");
      else asm volatile("s_waitcnt vmcnt(0)\n\ts_barrier" ::: "memory");
      if (t < my_ntiles) {
#pragma unroll
        for (int k2 = 0; k2 < 2; ++k2) {
          const int sa = ((8 * k2 + g) ^ (r16 & 14)) << 3;
          const int sb = ((8 * k2 + 4 + g) ^ (r16 & 14)) << 3;
#pragma unroll
          for (int a = 0; a < 8; ++a) {
            const uint2 va = *reinterpret_cast<const uint2*>(Vs + (a * 16 + r16) * 128 + sa);
            const uint2 vb = *reinterpret_cast<const uint2*>(Vs + (a * 16 + r16) * 128 + sb);
            u32x4 pk; pk[0] = va.x; pk[1] = va.y; pk[2] = vb.x; pk[3] = vb.y;
            const bf16x8 vf = __builtin_bit_cast(bf16x8, pk);
            o[a][0] = __builtin_amdgcn_mfma_f32_16x16x32_bf16(vf, pb[k2][0], o[a][0], 0, 0, 0);
            o[a][1] = __builtin_amdgcn_mfma_f32_16x16x32_bf16(vf, pb[k2][1], o[a][1], 0, 0, 0);
          }
        }
      }
      asm volatile("s_waitcnt vmcnt(0)\n\ts_waitcnt lgkmcnt(0)\n\ts_barrier" ::: "memory");
    }
#pragma unroll
    for (int nt = 0; nt < 2; ++nt) {
      float l = lrun[nt];
      l += __shfl_xor(l, 16, 64);
      l += __shfl_xor(l, 32, 64);
      const float il = 1.0f / l;
      const int pos = qbase + 32 * w + 16 * nt + r16;
      float sq = 0.f;
#pragma unroll
      for (int a = 0; a < 8; ++a) { const f32x4 v = o[a][nt] * il; sq += v[0] * v[0] + v[1] * v[1] + v[2] * v[2] + v[3] * v[3]; }
      sq += __shfl_xor(sq, 16, 64);
      sq += __shfl_xor(sq, 32, 64);
      if (STORE && (!meta || pos < NM)) {
        bf16_t* dst = p.qf + (size_t)(b * L + pos) * 768 + h * 192 + 4 * g;
#pragma unroll
        for (int a = 0; a < 8; ++a) {
          const f32x4 v = o[a][nt] * il;
          *reinterpret_cast<uint2*>(dst + a * 16) = pack4bf(v[0], v[1], v[2], v[3]);
        }
        if (g == 0) p.ossq[(size_t)(b * L + pos) * 4 + h] = sq;
      }
    }
  }
}
__device__ __forceinline__ void ph_rwkv_pre(const Params& p, char* smem, int bid, int nb) {
  const int lane = threadIdx.x & 63, wv = threadIdx.x >> 6, g = lane >> 4, r16 = lane & 15;
  char* my = smem + wv * 16384;
  char* At = my;
  char* Bt = my + 2048;
  char* Kt = my + 4096;
  char* Rt = my + 6144;
  char* AtT = my + 8192;
  char* VtT = my + 10240;
  char* BhT = my + 12288;
  char* KhT = my + 14336;
  const int nitems = NB_ * 8 * NCH;
  for (int wi = bid * 4 + wv; wi < nitems; wi += nb * 4) {
    const int chunk = wi % NCH, bh = wi / NCH, b = bh >> 3, h = bh & 7;
    float btv[16], ktv[16];
    unsigned atp[8], vtp[8];
    float cum = 0.f;
    const size_t o0 = ((size_t)b * L + chunk * 16) * 512 + h * 64 + lane;
#pragma unroll
    for (int t = 0; t < 16; ++t) {
      const size_t o = o0 + (size_t)t * 512;
      const float lw = bf2f(p.rlw[o]);
      const float gp = __expf(cum);
      cum += lw;
      const float gc = __expf(cum), ig = __expf(-cum);
      const float av = -bf2f(p.rkk[o]) * gp;
      const float bv = bf2f(p.rbb[o]) * ig;
      const float kv = bf2f(p.rk2[o]) * ig;
      const float rv = bf2f(p.rr[o]) * gc;
      const bf16_t vb = p.rv[o];
      btv[t] = bv; ktv[t] = kv;
      const bf16_t ab = f2bf(av);
      *reinterpret_cast<bf16_t*>(At + t * 128 + lane * 2) = ab;
      *reinterpret_cast<bf16_t*>(Bt + t * 128 + lane * 2) = f2bf(bv);
      *reinterpret_cast<bf16_t*>(Kt + t * 128 + lane * 2) = f2bf(kv);
      *reinterpret_cast<bf16_t*>(Rt + t * 128 + lane * 2) = f2bf(rv);
      if (t & 1) { atp[t >> 1] |= (unsigned)ab << 16; vtp[t >> 1] |= (unsigned)vb << 16; }
      else { atp[t >> 1] = ab; vtp[t >> 1] = vb; }
    }
    const float gC = __expf(cum);
    p.cd_gc[(size_t)wi * 64 + lane] = gC;
    {
      u32x4 w0, w1;
#pragma unroll
      for (int q = 0; q < 4; ++q) { w0[q] = atp[q]; w1[q] = atp[4 + q]; }
      *reinterpret_cast<u32x4*>(AtT + lane * 32) = w0; *reinterpret_cast<u32x4*>(AtT + lane * 32 + 16) = w1;
#pragma unroll
      for (int q = 0; q < 4; ++q) { w0[q] = vtp[q]; w1[q] = vtp[4 + q]; }
      *reinterpret_cast<u32x4*>(VtT + lane * 32) = w0; *reinterpret_cast<u32x4*>(VtT + lane * 32 + 16) = w1;
#pragma unroll
      for (int q = 0; q < 4; ++q) {
        w0[q] = (unsigned)f2bf(btv[2 * q] * gC) | ((unsigned)f2bf(btv[2 * q + 1] * gC) << 16);
        w1[q] = (unsigned)f2bf(btv[8 + 2 * q] * gC) | ((unsigned)f2bf(btv[8 + 2 * q + 1] * gC) << 16);
      }
      *reinterpret_cast<u32x4*>(BhT + lane * 32) = w0; *reinterpret_cast<u32x4*>(BhT + lane * 32 + 16) = w1;
#pragma unroll
      for (int q = 0; q < 4; ++q) {
        w0[q] = (unsigned)f2bf(ktv[2 * q] * gC) | ((unsigned)f2bf(ktv[2 * q + 1] * gC) << 16);
        w1[q] = (unsigned)f2bf(ktv[8 + 2 * q] * gC) | ((unsigned)f2bf(ktv[8 + 2 * q + 1] * gC) << 16);
      }
      *reinterpret_cast<u32x4*>(KhT + lane * 32) = w0; *reinterpret_cast<u32x4*>(KhT + lane * 32 + 16) = w1;
    }
    __builtin_amdgcn_wave_barrier();
    f32x4 mab = {0.f, 0.f, 0.f, 0.f}, mak = mab, nbr = mab, nkr = mab;
#pragma unroll
    for (int ks = 0; ks < 2; ++ks) {
      const int off = r16 * 128 + ks * 64 + g * 16;
      const bf16x8 fa = *reinterpret_cast<const bf16x8*>(At + off);
      const bf16x8 fb = *reinterpret_cast<const bf16x8*>(Bt + off);
      const bf16x8 fk = *reinterpret_cast<const bf16x8*>(Kt + off);
      const bf16x8 fr = *reinterpret_cast<const bf16x8*>(Rt + off);
      mab = MFMA32(fb, fa, mab); mak = MFMA32(fk, fa, mak);
      nbr = MFMA32(fb, fr, nbr); nkr = MFMA32(fk, fr, nkr);
    }
#pragma unroll
    for (int r = 0; r < 4; ++r) {
      const int sidx = 4 * g + r;
      if (!(sidx < r16)) { mab[r] = 0.f; mak[r] = 0.f; }
      if (!(sidx <= r16)) { nbr[r] = 0.f; nkr[r] = 0.f; }
    }
    float Tc[16];
#pragma unroll
    for (int sidx = 15; sidx >= 0; --sidx) {
      float acc = (r16 == sidx) ? 1.0f : 0.0f;
#pragma unroll
      for (int u = sidx + 1; u < 16; ++u) {
        const float m = __int_as_float(__builtin_amdgcn_readlane(__float_as_int(mab[sidx & 3]), 16 * (sidx >> 2) + u));
        acc += m * Tc[u];
      }
      Tc[sidx] = acc;
    }
    f32x4 tqf;
#pragma unroll
    for (int r = 0; r < 4; ++r) tqf[r] = g == 0 ? Tc[r] : (g == 1 ? Tc[4 + r] : (g == 2 ? Tc[8 + r] : Tc[12 + r]));
    const bf16x4 tq = pk4(tqf);
    const bf16x4 makA = pk4(mak), nbrA = pk4(nbr), nkrA = pk4(nkr);
    f32x4 ah[4], qm[4], wt[4], zt[4];
    bf16x4 vfr[4];
#pragma unroll
    for (int q = 0; q < 4; ++q) {
      const f32x4 z4 = {0.f, 0.f, 0.f, 0.f};
      const bf16x4 atf = *reinterpret_cast<const bf16x4*>(AtT + (16 * q + r16) * 32 + g * 8);
      vfr[q] = *reinterpret_cast<const bf16x4*>(VtT + (16 * q + r16) * 32 + g * 8);
      ah[q] = MFMA16(tq, atf, z4);
      const f32x4 xt = MFMA16(makA, vfr[q], z4);
      wt[q] = MFMA16(tq, pk4(xt), z4);
      qm[q] = MFMA16(nbrA, pk4(ah[q]), z4);
      zt[q] = MFMA16(nbrA, pk4(wt[q]), z4);
      zt[q] = MFMA16(nkrA, vfr[q], zt[q]);
    }
    unsigned char* oah = p.cd_ah + (size_t)wi * 2048;
    unsigned char* oqm = p.cd_qm + (size_t)wi * 2048;
    unsigned char* obk = p.cd_bk + (size_t)wi * 4096;
    unsigned char* owt = p.cd_wt + (size_t)wi * 2048;
    unsigned char* ozt = p.cd_zt + (size_t)wi * 2048;
    unsigned char* ovb = p.cd_vb + (size_t)wi * 2048;
#pragma unroll
    for (int q = 0; q < 4; ++q) {
      *reinterpret_cast<bf16x4*>(owt + (q * 64 + lane) * 8) = pk4(wt[q]);
      *reinterpret_cast<bf16x4*>(ozt + (q * 64 + lane) * 8) = pk4(zt[q]);
      *reinterpret_cast<bf16x4*>(ovb + (q * 64 + lane) * 8) = vfr[q];
      const u32x2 bh2 = *reinterpret_cast<const u32x2*>(BhT + (16 * q + r16) * 32 + g * 8);
      const u32x2 kh2 = *reinterpret_cast<const u32x2*>(KhT + (16 * q + r16) * 32 + g * 8);
      u32x4 bk; bk[0] = bh2[0]; bk[1] = bh2[1]; bk[2] = kh2[0]; bk[3] = kh2[1];
      *reinterpret_cast<u32x4*>(obk + (q * 64 + lane) * 16) = bk;
    }
    __builtin_amdgcn_wave_barrier();
#pragma unroll
    for (int q = 0; q < 4; ++q)
#pragma unroll
      for (int r = 0; r < 4; ++r) *reinterpret_cast<bf16_t*>(Bt + (4 * g + r) * 128 + (16 * q + r16) * 2) = f2bf(ah[q][r]);
    __builtin_amdgcn_wave_barrier();
#pragma unroll
    for (int ks = 0; ks < 2; ++ks) {
      const u32x2 lo = *reinterpret_cast<const u32x2*>(Bt + r16 * 128 + (32 * ks + 4 * g) * 2);
      const u32x2 hi = *reinterpret_cast<const u32x2*>(Bt + r16 * 128 + (32 * ks + 16 + 4 * g) * 2);
      u32x4 v; v[0] = lo[0]; v[1] = lo[1]; v[2] = hi[0]; v[3] = hi[1];
      *reinterpret_cast<u32x4*>(oah + (ks * 64 + lane) * 16) = v;
    }
    __builtin_amdgcn_wave_barrier();
#pragma unroll
    for (int q = 0; q < 4; ++q)
#pragma unroll
      for (int r = 0; r < 4; ++r) *reinterpret_cast<bf16_t*>(Bt + (4 * g + r) * 128 + (16 * q + r16) * 2) = f2bf(qm[q][r]);
    __builtin_amdgcn_wave_barrier();
#pragma unroll
    for (int ks = 0; ks < 2; ++ks) {
      const int o1 = r16 * 128 + (32 * ks + 4 * g) * 2, o2 = r16 * 128 + (32 * ks + 16 + 4 * g) * 2;
      const f32x4 a1 = unpk4(*reinterpret_cast<const u32x2*>(Bt + o1)) + unpk4(*reinterpret_cast<const u32x2*>(Rt + o1));
      const f32x4 a2 = unpk4(*reinterpret_cast<const u32x2*>(Bt + o2)) + unpk4(*reinterpret_cast<const u32x2*>(Rt + o2));
      const uint2 lo = pack4bf(a1[0], a1[1], a1[2], a1[3]), hi = pack4bf(a2[0], a2[1], a2[2], a2[3]);
      u32x4 v; v[0] = lo.x; v[1] = lo.y; v[2] = hi.x; v[3] = hi.y;
      *reinterpret_cast<u32x4*>(oqm + (ks * 64 + lane) * 16) = v;
    }
    __builtin_amdgcn_wave_barrier();
  }
}
__device__ __forceinline__ void ph_rwkv_pq(const Params& p, int bid, int nb) {
  const int lane = threadIdx.x & 63, wv = threadIdx.x >> 6;
  const int nitems = NB_ * 8 * NCH;
  for (int wi = bid * 4 + wv; wi < nitems; wi += nb * 4) {
    const int chunk = wi % NCH, bh = wi / NCH, b = bh >> 3, h = bh & 7;
    const size_t o0 = ((size_t)b * L + chunk * 16) * 512 + h * 64 + lane;
    float pdv[16];
    const float rkc = p.r_k[h * 64 + lane];
#pragma unroll
    for (int t = 0; t < 16; ++t) { const size_t o = o0 + (size_t)t * 512; pdv[t] = bf2f(p.rr[o]) * bf2f(p.rk2[o]) * rkc; }
    const float s3l = tr_reduce16(pdv, lane);
    const float lnw = p.ln_w[h * 64 + lane], lnb = p.ln_b[h * 64 + lane];
    bf16_t gtv[16], vtv[16];
#pragma unroll
    for (int t = 0; t < 16; ++t) { const size_t o = o0 + (size_t)t * 512; gtv[t] = p.rg[o]; vtv[t] = p.rv[o]; }
#pragma unroll
    for (int t = 0; t < 16; ++t) {
      const float s3 = __int_as_float(__builtin_amdgcn_readlane(__float_as_int(s3l), 4 * t));
      const size_t o = o0 + (size_t)t * 512;
      const float gt = bf2f(gtv[t]), vt_ = bf2f(vtv[t]);
      p.rlw[o] = f2bf(lnw * gt);
      p.rbb[o] = f2bf((lnb + s3 * vt_) * gt);
    }
  }
}
struct ChainRegs { u32x4 s0, s1; u32x2 wt, zt, vb, pp, qq; float gcs; };
__device__ __forceinline__ void chain_load(const Params& p, int wi, unsigned ytok, int it, int lane, ChainRegs& c) {
  const unsigned char* q0 = (it < 2 ? p.cd_ah : p.cd_qm) + (size_t)wi * 2048 + (it & 1) * 1024;
  c.gcs = p.cd_gc[(size_t)wi * 64 + lane];
  c.s0 = *reinterpret_cast<const u32x4*>(q0 + lane * 16);
  c.s1 = *reinterpret_cast<const u32x4*>(p.cd_bk + (size_t)wi * 4096 + it * 1024 + lane * 16);
  c.wt = *reinterpret_cast<const u32x2*>(p.cd_wt + (size_t)wi * 2048 + (it * 64 + lane) * 8);
  c.zt = *reinterpret_cast<const u32x2*>(p.cd_zt + (size_t)wi * 2048 + (it * 64 + lane) * 8);
  c.vb = *reinterpret_cast<const u32x2*>(p.cd_vb + (size_t)wi * 2048 + (it * 64 + lane) * 8);
  c.pp = *reinterpret_cast<const u32x2*>(p.rlw + ytok);
  c.qq = *reinterpret_cast<const u32x2*>(p.rbb + ytok);
}
__device__ __forceinline__ void chain_publish(char* sh, int it, int lane, const ChainRegs& c) {
  *reinterpret_cast<u32x4*>(sh + it * 1024 + lane * 16) = c.s0;
  *reinterpret_cast<u32x4*>(sh + 4096 + it * 1024 + lane * 16) = c.s1;
  if (it == 0) reinterpret_cast<float*>(sh + 8192)[lane] = c.gcs;
}
__device__ __forceinline__ float dpp_sum16(float v) {
  v += __int_as_float(__builtin_amdgcn_update_dpp(0, __float_as_int(v), 0xB1, 0xF, 0xF, true));
  v += __int_as_float(__builtin_amdgcn_update_dpp(0, __float_as_int(v), 0x4E, 0xF, 0xF, true));
  v += __int_as_float(__builtin_amdgcn_update_dpp(0, __float_as_int(v), 0x141, 0xF, 0xF, true));
  v += __int_as_float(__builtin_amdgcn_update_dpp(0, __float_as_int(v), 0x140, 0xF, 0xF, true));
  return v;
}
template <bool STORE>
__device__ __forceinline__ void chain_finalize(const Params& p, const char* otile, unsigned ytok, u32x2 pp, u32x2 qq) {
  const int tid = threadIdx.x;
  const f32x4 o4 = *reinterpret_cast<const f32x4*>(otile + (tid >> 4) * 256 + (tid & 15) * 16);
  const float s1 = dpp_sum16(o4[0] + o4[1] + o4[2] + o4[3]);
  const float s2 = dpp_sum16(o4[0] * o4[0] + o4[1] * o4[1] + o4[2] * o4[2] + o4[3] * o4[3]);
  const float mean = s1 * (1.0f / 64);
  const float var = fmaxf(s2 * (1.0f / 64) - mean * mean, 0.0f);
  const float istd = rsqrtf(var + 64e-5f);
  const f32x4 y = (o4 - mean) * istd * unpk4(pp) + unpk4(qq);
  if (STORE) *reinterpret_cast<uint2*>(p.rkk + ytok) = pack4bf(y[0], y[1], y[2], y[3]);
  else asm volatile("" :: "v"(y[0]), "v"(y[1]), "v"(y[2]), "v"(y[3]));
}
template <bool STORE>
__device__ __forceinline__ void chain_step(const Params& p, char* otile, const char* otile_prev, bool have_prev, unsigned ytok_prev, u32x2 pp_prev, u32x2 qq_prev,
                                           const char* sh, char* shn, int it, int lane,
                                           const ChainRegs& c, const ChainRegs& cn, f32x4 (&st)[4]) {
  const int g = lane >> 4, r16 = lane & 15;
  const float* gcur = reinterpret_cast<const float*>(sh + 8192);
  u32x4 s0, s1;
  {
    const uint2 a = pack4bf(st[0][0], st[0][1], st[0][2], st[0][3]), b = pack4bf(st[1][0], st[1][1], st[1][2], st[1][3]);
    const uint2 cc = pack4bf(st[2][0], st[2][1], st[2][2], st[2][3]), d = pack4bf(st[3][0], st[3][1], st[3][2], st[3][3]);
    s0[0] = a.x; s0[1] = a.y; s0[2] = b.x; s0[3] = b.y;
    s1[0] = cc.x; s1[1] = cc.y; s1[2] = d.x; s1[3] = d.y;
  }
  const bf16x8 sb0 = __builtin_bit_cast(bf16x8, s0), sb1 = __builtin_bit_cast(bf16x8, s1);
  f32x4 ut = unpk4(c.wt), ot = unpk4(c.zt);
  ut = MFMA32(*reinterpret_cast<const bf16x8*>(sh + lane * 16), sb0, ut);
  ot = MFMA32(*reinterpret_cast<const bf16x8*>(sh + 2048 + lane * 16), sb0, ot);
  ut = MFMA32(*reinterpret_cast<const bf16x8*>(sh + 1024 + lane * 16), sb1, ut);
  ot = MFMA32(*reinterpret_cast<const bf16x8*>(sh + 3072 + lane * 16), sb1, ot);
  chain_publish(shn, it, lane, cn);
  if (have_prev) chain_finalize<STORE>(p, otile_prev, ytok_prev, pp_prev, qq_prev);
#pragma unroll
  for (int r = 0; r < 4; ++r) *reinterpret_cast<float*>(otile + (4 * g + r) * 256 + (16 * it + r16) * 4) = ot[r];
  const uint2 u2 = pack4bf(ut[0], ut[1], ut[2], ut[3]);
  u32x4 uv; uv[0] = u2.x; uv[1] = u2.y; uv[2] = c.vb[0]; uv[3] = c.vb[1];
  const bf16x8 uvb = __builtin_bit_cast(bf16x8, uv);
#pragma unroll
  for (int q = 0; q < 4; ++q)
    st[q] = MFMA32(*reinterpret_cast<const bf16x8*>(sh + 4096 + q * 1024 + lane * 16), uvb, st[q] * *reinterpret_cast<const f32x4*>(gcur + 16 * q + 4 * g));
  __syncthreads();
}
template <bool STORE = true>
__device__ __forceinline__ void ph_chain(const Params& p, char* smem, int bid, int nb) {
  const int tid = threadIdx.x, lane = tid & 63, it = tid >> 6;
  char* shb = smem + 8192;
  for (int bh = bid; bh < NB_ * 8; bh += nb) {
    f32x4 st[4];
#pragma unroll
    for (int q = 0; q < 4; ++q) st[q] = (f32x4){0.f, 0.f, 0.f, 0.f};
    const int w0 = bh * NCH;
    const int b = bh >> 3, h = bh & 7;
    const unsigned y0 = (unsigned)((b * L + (tid >> 4)) * 512 + h * 64 + (tid & 15) * 4);
    ChainRegs c0, c1, c2, c3, c4, c5, c6, c7;
#define CH_LOAD(cc, set) chain_load(p, w0 + min((cc), NCH - 1), y0 + (unsigned)min((cc), NCH - 1) * 8192u, it, lane, set)
    CH_LOAD(0, c0); CH_LOAD(1, c1); CH_LOAD(2, c2); CH_LOAD(3, c3); CH_LOAD(4, c4); CH_LOAD(5, c5); CH_LOAD(6, c6); CH_LOAD(7, c7);
    __syncthreads();
    chain_publish(shb, it, lane, c0);
    __syncthreads();
    u32x2 ppp = {0u, 0u}, qqp = {0u, 0u};
#define CH_STEP(cc, cur, nxt) { const int par = (cc) & 1; \
      chain_step<STORE>(p, smem + par * 4096, smem + (1 - par) * 4096, (cc) > 0, y0 + (unsigned)((cc) - 1) * 8192u, ppp, qqp, \
                        shb + par * 8448, shb + (1 - par) * 8448, it, lane, cur, nxt, st); \
      ppp = cur.pp; qqp = cur.qq; CH_LOAD((cc) + 8, cur); }
    for (int ch = 0; ch < 128; ch += 8) {
      CH_STEP(ch, c0, c1) CH_STEP(ch + 1, c1, c2) CH_STEP(ch + 2, c2, c3) CH_STEP(ch + 3, c3, c4)
      CH_STEP(ch + 4, c4, c5) CH_STEP(ch + 5, c5, c6) CH_STEP(ch + 6, c6, c7) CH_STEP(ch + 7, c7, c0)
    }
    CH_STEP(128, c0, c1)
#undef CH_STEP
#undef CH_LOAD
    chain_finalize<STORE>(p, smem + ((NCH - 1) & 1) * 4096, y0 + (unsigned)(NCH - 1) * 8192u, ppp, qqp);
    __syncthreads();
  }
}
__device__ __forceinline__ void ph_tabconv(const Params& p, int bid, int nb) {
  const int nvec = 2 * 16384 * 256;
  const int stride = nb * NTHR;
  for (int base = bid * NTHR + threadIdx.x; base < nvec; base += 8 * stride) {
    f32x4 v[8];
#pragma unroll
    for (int k = 0; k < 8; ++k) {
      const int i = min(base + k * stride, nvec - 1);
      const bool tab = i >= 16384 * 256;
      v[k] = *reinterpret_cast<const f32x4*>((tab ? p.pv : p.pu) + (size_t)(tab ? i - 16384 * 256 : i) * 4);
    }
#pragma unroll
    for (int k = 0; k < 8; ++k) {
      const int i = min(base + k * stride, nvec - 1);
      const bool tab = i >= 16384 * 256;
      f32x4 w = v[k] * (tab ? 16.0f : 256.0f);
      if (!tab) w *= *reinterpret_cast<const f32x4*>(p.g_ffn + (i & 255) * 4);
      int wv = __builtin_amdgcn_cvt_pk_fp8_f32(w[0], w[1], 0, false);
      wv = __builtin_amdgcn_cvt_pk_fp8_f32(w[2], w[3], wv, true);
      const int iv = tab ? i - 16384 * 256 : i;
      *reinterpret_cast<unsigned*>((tab ? p.v8 : p.u8) + ((size_t)((iv & 255) >> 5) << 21) + (size_t)(iv >> 8) * 128 + (iv & 31) * 4) = (unsigned)wv;
    }
  }
}
__device__ __forceinline__ void ph_outproj(const Params& p, char* smem, int bid, int nb) {
  const int lane = threadIdx.x & 63, w = threadIdx.x >> 6, wm = w >> 1, wn = w & 1, g = lane >> 4, r16 = lane & 15;
  for_tiles_xcd(TR / 128, 4, bid, nb, [&](int tm, int tn) {
    const int m0 = tm * 128, n0 = tn * 256;
    f32x4 acc[4][8];
    gemm_tile_wide(smem, m0, n0, 32,
        [&](int r, int k) {
          const size_t tt = (size_t)rt2tt(r);
          return k < 512 ? p.qf + tt * 768 + (k >> 7) * 192 + (k & 127) : p.rkk + tt * 512 + (k - 512);
        },
        [&](int n, int k) { return p.w_outT + (size_t)n * 1024 + k; }, acc,
        [&](int kt, f32x4 (&a)[4][8]) {
          if (kt == 16) {
#pragma unroll
            for (int i = 0; i < 4; ++i) {
              const f32x4 q4 = *reinterpret_cast<const f32x4*>(p.ossq + (size_t)rt2tt(m0 + wm * 64 + 16 * i + r16) * 4);
              const float rs = rsqrtf((q4[0] + q4[1] + q4[2] + q4[3]) * (1.0f / 512) + RMS_EPS);
#pragma unroll
              for (int j = 0; j < 8; ++j) a[i][j] *= rs;
            }
          }
        });
#pragma unroll 1
    for (int half = 0; half < 2; ++half) {
      stage_acc_half(smem, acc, half);
#pragma unroll 1
      for (int qb = 0; qb < 8; qb += 4) {
      f32x4 hh[4][2];
#pragma unroll
      for (int qi = 0; qi < 4; ++qi) {
        const int c = threadIdx.x + 256 * (qb + qi);
        const float* hr = hrow(p, rt2tt(m0 + (c >> 4))) + n0 + half * 128 + (c & 15) * 8;
        hh[qi][0] = *reinterpret_cast<const f32x4*>(hr); hh[qi][1] = *reinterpret_cast<const f32x4*>(hr + 4);
      }
#pragma unroll
      for (int qi = 0; qi < 4; ++qi) {
        const int q = qb + qi;
        const int c = threadIdx.x + 256 * q;
        const int row = c >> 4, col8 = (c & 15) * 8;
        const int m = m0 + row, n = n0 + half * 128 + col8;
        const f32x4 h0 = hh[qi][0], h1 = hh[qi][1];
        float v[8];
        ld8(smem, row, col8, v);
        float sq = 0.f;
#pragma unroll
        for (int e = 0; e < 8; ++e) { v[e] += e < 4 ? h0[e] : h1[e - 4]; sq += v[e] * v[e]; }
        f32x4 o0, o1;
#pragma unroll
        for (int e = 0; e < 4; ++e) { o0[e] = v[e]; o1[e] = v[4 + e]; }
        *reinterpret_cast<f32x4*>(p.out + (size_t)m * D + n) = o0;
        *reinterpret_cast<f32x4*>(p.out + (size_t)m * D + n + 4) = o1;
        st8f(p.h2b + (size_t)m * D + n, v);
        sq += __shfl_xor(sq, 1, 64); sq += __shfl_xor(sq, 2, 64); sq += __shfl_xor(sq, 4, 64); sq += __shfl_xor(sq, 8, 64);
        if ((threadIdx.x & 15) == 0) atomicAdd(p.h2ss + m, sq);
      }
      }
    }
  });
}
#define CE_(a, b) { const int t_ = max(a, b); b = min(a, b); a = t_; }
__device__ __forceinline__ int fkey7(float x, int idx) {
  int b = __float_as_int(x);
  b ^= (b >> 31) & 0x7fffffff;
  return (b & ~127) | (127 - idx);
}
__device__ __forceinline__ float fvalm(int k, int mask) {
  int b = k & ~mask;
  b ^= (b >> 31) & 0x7fffffff;
  return __int_as_float(b);
}
__device__ __forceinline__ void bitonic_sort16(int (&v)[16]) {
#pragma unroll
  for (int k = 2; k <= 16; k <<= 1)
#pragma unroll
    for (int j = k >> 1; j > 0; j >>= 1)
#pragma unroll
      for (int i = 0; i < 16; ++i) {
        const int l = i ^ j;
        if (l > i) {
          if ((i & k) == 0) { CE_(v[i], v[l]); } else { CE_(v[l], v[i]); }
        }
      }
}
__device__ __forceinline__ void bitonic_merge16(int (&v)[16]) {
#pragma unroll
  for (int j = 8; j > 0; j >>= 1)
#pragma unroll
    for (int i = 0; i < 16; ++i) {
      const int l = i ^ j;
      if (l > i) { CE_(v[i], v[l]); }
    }
}
__device__ __forceinline__ void ph_route(const Params& p, char* smem, int bid, int nb) {
  const int tid = threadIdx.x, lane = tid & 63, w = tid >> 6, wm = w >> 1, wn = w & 1, g = lane >> 4, r16 = lane & 15;
  int* L2l = reinterpret_cast<int*>(smem);
  int* Lx = reinterpret_cast<int*>(smem + 8192);
  int* L1l = reinterpret_cast<int*>(smem + 67584);
  for_tiles_xcd(TR / 128, 8, bid, nb, [&](int mt, int h) {
    const int m0 = mt * 128;
    for (int c = 0; c < 2; ++c) {
      f32x4 acc[4][4];
      gemm_tile_glds<true>(smem, m0, (2 * h + c) * 128, 32,
          [&](int r, int k) { return p.h2b + (size_t)r * D + k; },
          [&](int n, int k) { return p.w_qT + (size_t)n * 1024 + k; }, acc);
      float* Et = reinterpret_cast<float*>(smem);
#pragma unroll
      for (int i = 0; i < 4; ++i)
#pragma unroll
        for (int j = 0; j < 4; ++j)
          *reinterpret_cast<f32x4*>(Et + (wm * 64 + 16 * i + r16) * 132 + wn * 64 + 16 * j + 4 * g) = acc[i][j];
      __syncthreads();
      f32x4 sc[2][8];
#pragma unroll
      for (int tt = 0; tt < 2; ++tt)
#pragma unroll
        for (int kt = 0; kt < 8; ++kt) sc[tt][kt] = *reinterpret_cast<const f32x4*>(Et + (32 * w + 16 * tt + r16) * 132 + 16 * kt + 4 * g);
      __syncthreads();
#pragma unroll
      for (int tt = 0; tt < 2; ++tt) {
        int lo[16], hi[16];
#pragma unroll
        for (int kt = 0; kt < 4; ++kt)
#pragma unroll
          for (int r = 0; r < 4; ++r) {
            lo[kt * 4 + r] = fkey7(sc[tt][kt][r], 16 * kt + 4 * g + r);
            hi[kt * 4 + r] = fkey7(sc[tt][kt + 4][r], 16 * (kt + 4) + 4 * g + r);
          }
        bitonic_sort16(lo);
        bitonic_sort16(hi);
#pragma unroll
        for (int i = 0; i < 16; ++i) lo[i] = max(lo[i], hi[15 - i]);
        bitonic_merge16(lo);
#pragma unroll
        for (int st = 16; st <= 32; st <<= 1) {
          int ot[16];
#pragma unroll
          for (int i = 0; i < 16; ++i) ot[i] = __shfl_xor(lo[15 - i], st, 64);
#pragma unroll
          for (int i = 0; i < 16; ++i) lo[i] = max(lo[i], ot[i]);
          bitonic_merge16(lo);
        }
        if (g == 0) {
          int* dst = (c ? L2l : L1l) + (32 * w + 16 * tt + r16) * 16;
#pragma unroll
          for (int q = 0; q < 4; ++q) {
            u32x4 v; v[0] = lo[4 * q]; v[1] = lo[4 * q + 1]; v[2] = lo[4 * q + 2]; v[3] = lo[4 * q + 3];
            *reinterpret_cast<u32x4*>(dst + 4 * q) = v;
          }
        }
      }
      __syncthreads();
    }
    {
      const int tok = tid & 127, half = tid >> 7;
      int k1[16], k2[16];
      float v1[16], v2[16];
#pragma unroll
      for (int q = 0; q < 4; ++q) {
        const u32x4 a = *reinterpret_cast<const u32x4*>(L1l + tok * 16 + 4 * q);
        const u32x4 b = *reinterpret_cast<const u32x4*>(L2l + tok * 16 + 4 * q);
#pragma unroll
        for (int e = 0; e < 4; ++e) { k1[4 * q + e] = (int)a[e]; k2[4 * q + e] = (int)b[e]; }
      }
#pragma unroll
      for (int i = 0; i < 16; ++i) { v1[i] = fvalm(k1[i], 127); v2[i] = fvalm(k2[i], 127); }
      int lst[16];
#pragma unroll
      for (int i = 0; i < 16; ++i) lst[i] = (int)0x80000000;
      if (half == 0) {
#pragma unroll
        for (int a = 0; a < 2; ++a)
#pragma unroll
          for (int b = 0; b < 16 / (a + 1); ++b) {
            int x = __float_as_int(v1[a] + v2[b]);
            x ^= (x >> 31) & 0x7fffffff;
            x = (x & ~255) | (255 - (a * 16 + b));
#pragma unroll
            for (int i = 0; i < 16; ++i) CE_(lst[i], x);
          }
      } else {
#pragma unroll
        for (int a = 2; a < 16; ++a)
#pragma unroll
          for (int b = 0; b < 16 / (a + 1); ++b) {
            int x = __float_as_int(v1[a] + v2[b]);
            x ^= (x >> 31) & 0x7fffffff;
            x = (x & ~255) | (255 - (a * 16 + b));
#pragma unroll
            for (int i = 0; i < 16; ++i) CE_(lst[i], x);
          }
      }
#pragma unroll
      for (int q = 0; q < 4; ++q) {
        u32x4 v; v[0] = lst[4 * q]; v[1] = lst[4 * q + 1]; v[2] = lst[4 * q + 2]; v[3] = lst[4 * q + 3];
        *reinterpret_cast<u32x4*>(Lx + (half * 128 + tok) * 16 + 4 * q) = v;
      }
      __syncthreads();
      int fin[16];
#pragma unroll
      for (int q = 0; q < 4; ++q) {
        const u32x4 o = *reinterpret_cast<const u32x4*>(Lx + ((1 - half) * 128 + tok) * 16 + 4 * q);
#pragma unroll
        for (int e = 0; e < 4; ++e) fin[4 * q + e] = (int)o[e];
      }
#pragma unroll
      for (int i = 0; i < 8; ++i) { const int t_ = fin[i]; fin[i] = fin[15 - i]; fin[15 - i] = t_; }
#pragma unroll
      for (int i = 0; i < 16; ++i) fin[i] = max(fin[i], lst[i]);
      float sv[16], mx = -1e30f;
      const float rs2 = rsqrtf(p.h2ss[m0 + tok] * (1.0f / D) + RMS_EPS);
#pragma unroll
      for (int i = 0; i < 16; ++i) { sv[i] = fvalm(fin[i], 255); mx = fmaxf(mx, sv[i]); }
      float sum = 0.f;
#pragma unroll
      for (int i = 0; i < 16; ++i) { sv[i] = __expf((sv[i] - mx) * rs2); sum += sv[i]; }
      const float isum = 1.0f / sum;
      const size_t ob = (size_t)(m0 + tok) * 128 + h * 16 + half * 8;
#pragma unroll
      for (int i = 0; i < 8; ++i) {
        const int code = 255 - (fin[i] & 255);
        const int a = code >> 4, b = code & 15;
        const int i1 = 127 - (L1l[tok * 16 + a] & 127), i2 = 127 - (L2l[tok * 16 + b] & 127);
        p.pidx[ob + i] = i1 * 128 + i2;
        p.pgate[ob + i] = sv[i] * isum;
      }
    }
    __syncthreads();
  });
}
__device__ __forceinline__ void ph_expert(const Params& p, char* smem, int bid, int nb) {
  const int lane = threadIdx.x & 63, wv = threadIdx.x >> 6;
  const int g3 = lane >> 3, p8 = lane & 7;
  const bool b5 = lane & 32, b4 = lane & 16, b3 = lane & 8;
  unsigned* idxl = reinterpret_cast<unsigned*>(smem + wv * 8192);
  float* al = reinterpret_cast<float*>(smem + wv * 8192 + 4096);
  for (int grp = bid * 4 + wv; grp < TR / 8; grp += nb * 4) {
    const int rt0 = grp * 8;
    float rs2[8];
#pragma unroll
    for (int t = 0; t < 8; ++t) {
      rs2[t] = rsqrtf(p.h2ss[rt0 + t] * (1.0f / D) + RMS_EPS);
      const size_t pb = (size_t)(rt0 + t) * 128;
      idxl[t * 128 + lane] = (unsigned)p.pidx[pb + lane] << 7;
      idxl[t * 128 + 64 + lane] = (unsigned)p.pidx[pb + 64 + lane] << 7;
      al[t * 128 + lane] = p.pgate[pb + lane];
      al[t * 128 + 64 + lane] = p.pgate[pb + 64 + lane];
    }
    __builtin_amdgcn_wave_barrier();
    float dacc[8][2];
#pragma unroll
    for (int t = 0; t < 8; ++t) { dacc[t][0] = 0.f; dacc[t][1] = 0.f; }
#pragma unroll 1
    for (int x = 0; x < 8; ++x) {
      const unsigned coff = 128u * x + 16u * p8;
      const unsigned toff = ((unsigned)x << 21) + 16u * p8;
#pragma unroll 1
      for (int t = 0; t < 8; ++t) {
        f32x2 xp[8];
        {
          const bf16_t* hr = p.h2b + (size_t)(rt0 + t) * D + coff;
          const u32x4 a = *reinterpret_cast<const u32x4*>(hr);
          const u32x4 b = *reinterpret_cast<const u32x4*>(hr + 8);
#pragma unroll
          for (int q = 0; q < 4; ++q) {
            xp[q][0] = __uint_as_float(a[q] << 16); xp[q][1] = __uint_as_float(a[q] & 0xffff0000u);
            xp[4 + q][0] = __uint_as_float(b[q] << 16); xp[4 + q][1] = __uint_as_float(b[q] & 0xffff0000u);
          }
        }
        u32x4 rows[16];
#pragma unroll
        for (int j = 0; j < 16; ++j) {
          const unsigned off = idxl[t * 128 + 8 * j + g3];
          rows[j] = *reinterpret_cast<const u32x4*>(p.u8 + off + toff);
        }
#pragma unroll
        for (int j = 0; j < 16; ++j) {
          f32x2 acc2 = {0.f, 0.f};
#pragma unroll
          for (int q = 0; q < 4; ++q) {
            acc2 += xp[2 * q] * __builtin_amdgcn_cvt_pk_f32_fp8((int)rows[j][q], false);
            acc2 += xp[2 * q + 1] * __builtin_amdgcn_cvt_pk_f32_fp8((int)rows[j][q], true);
          }
          const float sm = dpp_sum8(acc2[0] + acc2[1]);
          if (p8 == (j & 7)) dacc[0][j >> 3] += sm;
        }
        {
          const float r0 = dacc[0][0], r1 = dacc[0][1];
#pragma unroll
          for (int q = 0; q < 7; ++q) { dacc[q][0] = dacc[q + 1][0]; dacc[q][1] = dacc[q + 1][1]; }
          dacc[7][0] = r0; dacc[7][1] = r1;
        }
      }
    }
#pragma unroll
    for (int t = 0; t < 8; ++t)
#pragma unroll
      for (int jj = 0; jj < 2; ++jj) {
        const int slot = 8 * (p8 + 8 * jj) + g3;
        const float dot = dacc[t][jj] * rs2[t] * (1.0f / 256.0f);
        const float gt = al[t * 128 + slot];
        al[t * 128 + slot] = 0.5f * dot * (1.0f + erff(dot * 0.7071067811865476f)) * gt * (1.0f / 16.0f);
      }
    __builtin_amdgcn_wave_barrier();
    float ssq[8];
#pragma unroll
    for (int t = 0; t < 8; ++t) ssq[t] = 0.f;
    const int cw = 8 * (b5 ? 1 : 0) + 4 * (b4 ? 1 : 0) + 2 * (b3 ? 1 : 0);
#pragma unroll 1
    for (int x = 0; x < 8; ++x) {
      const unsigned coff = 128u * x + 16u * p8;
      const unsigned toff = ((unsigned)x << 21) + 16u * p8;
#pragma unroll 1
      for (int t = 0; t < 8; ++t) {
        u32x4 rows[16];
        float av[16];
#pragma unroll
        for (int j = 0; j < 16; ++j) {
          const unsigned off = idxl[t * 128 + 8 * j + g3];
          av[j] = al[t * 128 + 8 * j + g3];
          rows[j] = *reinterpret_cast<const u32x4*>(p.v8 + off + toff);
        }
        f32x2 oa[8];
#pragma unroll
        for (int q = 0; q < 8; ++q) oa[q] = (f32x2){0.f, 0.f};
#pragma unroll
        for (int j = 0; j < 16; ++j) {
          const f32x2 a2 = {av[j], av[j]};
#pragma unroll
          for (int q = 0; q < 4; ++q) {
            oa[2 * q] += a2 * __builtin_amdgcn_cvt_pk_f32_fp8((int)rows[j][q], false);
            oa[2 * q + 1] += a2 * __builtin_amdgcn_cvt_pk_f32_fp8((int)rows[j][q], true);
          }
        }
        f32x2 q4v[4], q2v[2], q1v;
#pragma unroll
        for (int i = 0; i < 4; ++i) {
          const f32x2 sd = b5 ? oa[i] : oa[i + 4], kp = b5 ? oa[i + 4] : oa[i];
          q4v[i][0] = kp[0] + __shfl_xor(sd[0], 32, 64); q4v[i][1] = kp[1] + __shfl_xor(sd[1], 32, 64);
        }
#pragma unroll
        for (int i = 0; i < 2; ++i) {
          const f32x2 sd = b4 ? q4v[i] : q4v[i + 2], kp = b4 ? q4v[i + 2] : q4v[i];
          q2v[i][0] = kp[0] + __shfl_xor(sd[0], 16, 64); q2v[i][1] = kp[1] + __shfl_xor(sd[1], 16, 64);
        }
        {
          const f32x2 sd = b3 ? q2v[0] : q2v[1], kp = b3 ? q2v[1] : q2v[0];
          q1v[0] = kp[0] + __shfl_xor(sd[0], 8, 64); q1v[1] = kp[1] + __shfl_xor(sd[1], 8, 64);
        }
        float* hp = p.out + (size_t)(rt0 + t) * D + coff + cw;
        const f32x2 h3 = *reinterpret_cast<const f32x2*>(hp) + q1v;
        *reinterpret_cast<f32x2*>(hp) = h3;
        {
          const float r0 = ssq[0] + h3[0] * h3[0] + h3[1] * h3[1];
#pragma unroll
          for (int q = 0; q < 7; ++q) ssq[q] = ssq[q + 1];
          ssq[7] = r0;
        }
      }
    }
    asm volatile("s_waitcnt vmcnt(0)" ::: "memory");
    {
      float rsv[8];
#pragma unroll
      for (int t = 0; t < 8; ++t) rsv[t] = rsqrtf(wave_sum(ssq[t]) * (1.0f / D) + RMS_EPS);
      f32x2 gfv[8];
#pragma unroll
      for (int x = 0; x < 8; ++x) gfv[x] = *reinterpret_cast<const f32x2*>(p.g_fin + 128 * x + 16 * p8 + cw);
      unsigned long long hv[8][8];
#pragma unroll
      for (int t = 0; t < 8; ++t)
#pragma unroll
        for (int x = 0; x < 8; ++x)
          hv[t][x] = __hip_atomic_load(reinterpret_cast<unsigned long long*>(p.out + (size_t)(rt0 + t) * D + 128 * x + 16 * p8 + cw),
                                       __ATOMIC_RELAXED, __HIP_MEMORY_SCOPE_AGENT);
#pragma unroll
      for (int t = 0; t < 8; ++t)
#pragma unroll
        for (int x = 0; x < 8; ++x) {
          f32x2 o2;
          o2[0] = __uint_as_float((unsigned)hv[t][x]) * rsv[t] * gfv[x][0];
          o2[1] = __uint_as_float((unsigned)(hv[t][x] >> 32)) * rsv[t] * gfv[x][1];
          *reinterpret_cast<f32x2*>(p.out + (size_t)(rt0 + t) * D + 128 * x + 16 * p8 + cw) = o2;
        }
    }
    __builtin_amdgcn_wave_barrier();
  }
}

#define XB_TMO      128
#define XB_XCNT(j)  (256  + 64 * (j))
#define XB_XSUB(j)  (1280 + 64 * (j))
#define XB_XGEN(j)  (2304 + 64 * (j))
#define XB_TOP      3328
#define XB_TOPGEN   3392
#define XCD_BAR_WORDS 3456
#define XB_SPIN_CAP (1u << 18)
#define LAS __attribute__((address_space(3)))
__device__ __forceinline__ unsigned xb_ld(unsigned* p) { return __hip_atomic_load(p, __ATOMIC_RELAXED, __HIP_MEMORY_SCOPE_AGENT); }
__device__ __forceinline__ unsigned xb_add(unsigned* p, unsigned v) { return __hip_atomic_fetch_add(p, v, __ATOMIC_RELAXED, __HIP_MEMORY_SCOPE_AGENT); }
__device__ __forceinline__ unsigned xb_xcc_id() { return (unsigned)__builtin_amdgcn_s_getreg((3 << 11) | 20) & 0xFu; }
#define XB_SPIN(cond, bar) do { unsigned _sp = 0; while (cond) { __builtin_amdgcn_s_sleep(1); \
    if ((++_sp & 255u) == 0u) { if (xb_ld(&(bar)[XB_TMO])) break; if (_sp > XB_SPIN_CAP) { atomicAdd(&(bar)[XB_TMO], 1u); break; } } } } while (0)
struct XcdBarrier { unsigned* bar; unsigned x; volatile LAS unsigned* st; };
__device__ __forceinline__ XcdBarrier xcd_barrier_post(unsigned* bar, volatile LAS unsigned* st) {
  XcdBarrier b; b.bar = bar; b.x = xb_xcc_id(); b.st = st;
  if (threadIdx.x == 0) (void)xb_add(&bar[XB_XCNT(b.x)], 1u);
  return b;
}
__device__ __forceinline__ void xcd_barrier_complete(unsigned* bar, unsigned x, unsigned& nloc, unsigned& nx) {
  const unsigned G = gridDim.x * gridDim.y * gridDim.z;
  unsigned sum, cnt, mine, sp = 0u;
  for (;;) {
    sum = 0u; cnt = 0u; mine = 0u;
#pragma unroll
    for (unsigned j = 0; j < 16; ++j) { const unsigned c = xb_ld(&bar[XB_XCNT(j)]); sum += c; cnt += (c > 0u) ? 1u : 0u; mine = (j == x) ? c : mine; }
    if (sum == G) break;
    __builtin_amdgcn_s_sleep(1);
    if ((++sp & 255u) == 0u) { if (xb_ld(&bar[XB_TMO])) break; if (sp > XB_SPIN_CAP) { atomicAdd(&bar[XB_TMO], 1u); break; } }
  }
  nloc = mine > 0u ? mine : 1u; nx = cnt > 0u ? cnt : 1u;
}
__device__ __forceinline__ void xcd_barrier(const XcdBarrier& b) {
  asm volatile("s_waitcnt vmcnt(0)" ::: "memory");
  __syncthreads();
  if (threadIdx.x == 0) {
    unsigned* bar = b.bar;
    __builtin_amdgcn_s_waitcnt(0);
    unsigned nloc = b.st[0], nx = b.st[1];
    if (nloc == 0u) { xcd_barrier_complete(bar, b.x, nloc, nx); b.st[0] = nloc; b.st[1] = nx; }
    const unsigned old = xb_add(&bar[XB_XSUB(b.x)], 1u);
    const unsigned gen = old / nloc;
    if (old + 1u == (gen + 1u) * nloc) {
      __builtin_amdgcn_fence(__ATOMIC_RELEASE, "agent");
      asm volatile("s_waitcnt vmcnt(0)" ::: "memory");
      const unsigned og = xb_add(&bar[XB_TOP], 1u);
      const unsigned tg = og / nx;
      if (og + 1u == (tg + 1u) * nx) xb_add(&bar[XB_TOPGEN], 1u);
      else XB_SPIN(xb_ld(&bar[XB_TOPGEN]) == tg, bar);
      __builtin_amdgcn_fence(__ATOMIC_ACQUIRE, "agent");
      xb_add(&bar[XB_XGEN(b.x)], 1u);
      asm volatile("s_waitcnt vmcnt(0)" ::: "memory");
    } else {
      XB_SPIN(xb_ld(&bar[XB_XGEN(b.x)]) == gen, bar);
      __builtin_amdgcn_fence(__ATOMIC_ACQUIRE, "agent");
      asm volatile("s_waitcnt vmcnt(0)" ::: "memory");
    }
  }
  __syncthreads();
}

constexpr int SMEM_FLOATS = 18944 + 4;


__global__ void __launch_bounds__(NTHR, 2) k_mega(Params p) {
  __shared__ __attribute__((aligned(16))) float smem[SMEM_FLOATS];
  if (threadIdx.x == 0) { smem[18944] = 0.f; smem[18945] = 0.f; smem[18946] = 0.f; smem[18947] = 0.f; }
  __syncthreads();
  const XcdBarrier xb = xcd_barrier_post(p.bar, (volatile LAS unsigned*)&smem[18944]);
  if (p.never) { cg::grid_group grid = cg::this_grid(); grid.sync(); }
  const int bid = blockIdx.x, nb = gridDim.x;
  ph_prep(p, bid, nb);
  xcd_barrier(xb);
  ph_inproj(p, (char*)smem, bid, nb);
  if (nb > 384) { if (bid >= 256) ph_w2(p, (char*)smem, bid - 256, nb - 256); }
  else ph_w2(p, (char*)smem, bid, nb);
  xcd_barrier(xb);
  ph_rwkv_prep(p, (char*)smem, bid, nb);
  ph_q_up(p, (char*)smem, bid, nb);
  ph_kv_up(p, (char*)smem, bid, nb);
  xcd_barrier(xb);
  ph_rwkv_pre(p, (char*)smem, bid, nb);
  ph_rwkv_pq(p, bid, nb);
  xcd_barrier(xb);
  if (bid < 64) ph_chain(p, (char*)smem, bid, 64);
  else { ph_attn(p, (char*)smem, bid - 64, nb - 64); ph_tabconv(p, bid - 64, nb - 64); }
  xcd_barrier(xb);
  ph_outproj(p, (char*)smem, bid, nb);
  xcd_barrier(xb);
  ph_route(p, (char*)smem, bid, nb);
  xcd_barrier(xb);
  ph_expert(p, (char*)smem, bid, nb);
}

extern "C" void kernel_launch(void* const* d_in, const int* in_sizes, int n_in, void* d_out, int out_size, void* d_ws,
                              size_t ws_size, hipStream_t stream) {
  Params p{};
  const float* const* in = reinterpret_cast<const float* const*>(d_in);
  p.x = in[0]; p.meta = in[1]; p.g_mix = in[2]; p.w_in = in[3]; p.g_q = in[4]; p.w_uq = in[5]; p.g_kv = in[6];
  p.w_ukv = in[7]; p.g_out = in[8]; p.mu = in[9]; p.w0 = in[10]; p.w_up = in[11]; p.a0 = in[12]; p.a_up = in[13];
  p.g_up = in[14]; p.k_k = in[15]; p.k_a = in[16]; p.r_k = in[17]; p.ln_w = in[18]; p.ln_b = in[19]; p.w_out = in[20];
  p.g_ffn = in[21]; p.w_q = in[22]; p.subk = in[23]; p.pu = in[24]; p.pv = in[25]; p.g_fin = in[26];
  p.out = (float*)d_out;
  char* ws = (char*)d_ws;
  size_t off = 0;
  auto take = [&](size_t bytes) { char* r = ws + off; off += (bytes + 255) & ~(size_t)255; return r; };
  p.bar = (unsigned*)take((size_t)XCD_BAR_WORDS * 4);
  p.h2ss = (float*)take((size_t)TR * 4);
  const size_t zero_bytes = off;
  p.rstd1 = (float*)take((size_t)T * 4);
  p.ossq = (float*)take((size_t)T * 4 * 4);
  p.w_inT = (bf16_t*)take((size_t)DIN * 1024 * 2);
  p.w_uqT = (bf16_t*)take((size_t)768 * 256 * 2);
  p.w_ukvT = (bf16_t*)take((size_t)1024 * 128 * 2);
  p.w_outT = (bf16_t*)take((size_t)1024 * 1024 * 2);
  p.w_qT = (bf16_t*)take((size_t)2048 * 1024 * 2);
  p.subkb = (bf16_t*)take((size_t)8 * 2 * 128 * 128 * 2);
  p.w_lrT = (bf16_t*)take((size_t)1536 * 128 * 2);
  p.ropec = (float*)take((size_t)L * 32 * 4);
  p.ropes = (float*)take((size_t)L * 32 * 4);
  char* regA = take((size_t)T * DIN * 2);
  char* regB = take((size_t)T * (768 + 1024 + 64) * 2);
  char* regBend = ws + off;
  char* regC = take((size_t)T * 512 * 2 * 7);
  if (off > ws_size) fprintf(stderr, "workspace too small: need %zu have %zu\n", off, ws_size);
  p.proj = (bf16_t*)regA;
  {
    const size_t NW = (size_t)NB_ * 8 * NCH;
    p.cd_qm = (unsigned char*)regA;
    p.cd_wt = p.cd_qm + NW * 2048;
    p.cd_zt = p.cd_wt + NW * 2048;
    p.cd_vb = p.cd_zt + NW * 2048;
    p.cd_bk = (unsigned char*)d_out;
    p.cd_ah = p.cd_bk + NW * 4096;
    p.cd_gc = (float*)(p.cd_ah + NW * 2048);
  }
  p.h2b = (bf16_t*)regA;
  p.pidx = (int*)(regA + (size_t)TR * D * 2);
  p.pgate = (float*)(regA + (size_t)TR * D * 2 + (size_t)TR * 128 * 4);
  p.qf = (bf16_t*)regB;
  p.kn = (bf16_t*)(regB + (size_t)T * 768 * 2);
  p.vt = (bf16_t*)(regB + (size_t)T * (768 + 512) * 2);
  p.kr = (bf16_t*)(regB + (size_t)T * (768 + 1024) * 2);
  p.hb = (bf16_t*)regC;
  p.w_qb = (bf16_t*)(regC + (size_t)40 * 1024 * 1024);
  bf16_t* c = (bf16_t*)regC;
  const size_t a512 = (size_t)T * 512;
  p.rr = c; p.rk2 = c + a512; p.rv = c + 2 * a512; p.rkk = c + 3 * a512; p.rbb = c + 4 * a512; p.rg = c + 5 * a512; p.rlw = c + 6 * a512;
  p.u8 = (unsigned char*)regC;
  p.v8 = p.u8 + (size_t)16384 * 1024;
  static int grid_blocks = 0;
  if (!grid_blocks) {
    int dev = 0, cus = 0, per_cu = 0;
    (void)hipGetDevice(&dev);
    (void)hipDeviceGetAttribute(&cus, hipDeviceAttributeMultiprocessorCount, dev);
    (void)hipOccupancyMaxActiveBlocksPerMultiprocessor(&per_cu, k_mega, NTHR, 0);
    if (per_cu > 2) per_cu = 2;
    grid_blocks = cus * per_cu;
  }
  (void)hipMemsetAsync(p.bar, 0, zero_bytes, stream);
  void* args[] = {&p};
  hipError_t e = hipLaunchCooperativeKernel((void*)k_mega, dim3(grid_blocks), dim3(NTHR), args, 0, stream);
  if (e != hipSuccess) fprintf(stderr, "cooperative launch failed: %s (grid %d)\n", hipGetErrorString(e), grid_blocks);
}
```

```cpp
#include <hip/hip_runtime.h>
#include <hip/hip_cooperative_groups.h>
#include <stdint.h>
#include <stdio.h>
#include <math.h>

constexpr int NB_ = 8, SEQ = 2048, NM = 16, L = 2064, T = NB_ * L, TR = NB_ * SEQ, D = 1024, DIN = 2240;
constexpr int NTHR = 256;
constexpr float RMS_EPS = 1e-6f;
typedef unsigned short bf16_t;
namespace cg = cooperative_groups;

struct Params {
  const float *x, *meta, *g_mix, *w_in, *g_q, *w_uq, *g_kv, *w_ukv, *g_out, *mu, *w0, *w_up, *a0, *a_up, *g_up,
      *k_k, *k_a, *r_k, *ln_w, *ln_b, *w_out, *g_ffn, *w_q, *subk, *pu, *pv, *g_fin;
  float* out;
  float *rstd1;
  float *ossq;
  float *h2ss;
  bf16_t* proj;
  bf16_t *qf, *kn, *vt, *kr;
  float *ropec, *ropes;
  bf16_t *rr, *rk2, *rv, *rkk, *rbb, *rg, *rlw;
  unsigned char *cd_ah, *cd_qm, *cd_bk, *cd_wt, *cd_zt, *cd_vb;
  float* cd_gc;
  bf16_t* h2b;
  int* pidx;
  float* pgate;
  unsigned* bar;
  int never;
  int pad0;
  bf16_t* hb;
  unsigned char *u8, *v8;
  bf16_t *w_inT, *w_uqT, *w_ukvT, *w_outT, *w_qT;
  bf16_t *w_qb;
  bf16_t *subkb;
  bf16_t *w_lrT;
};

__device__ __forceinline__ bf16_t f2bf(float f) {
  unsigned u = __float_as_uint(f);
  u += 0x7FFFu + ((u >> 16) & 1u);
  return (bf16_t)(u >> 16);
}
__device__ __forceinline__ float bf2f(bf16_t h) { return __uint_as_float(((unsigned)h) << 16); }
__device__ __forceinline__ float wave_sum(float v) {
#pragma unroll
  for (int o = 32; o > 0; o >>= 1) v += __shfl_xor(v, o, 64);
  return v;
}
__device__ __forceinline__ const float* hrow(const Params& p, int tt) {
  int b = tt / L, pos = tt - b * L;
  return pos < NM ? p.meta + (size_t)pos * D : p.x + ((size_t)(b * SEQ + pos - NM)) * D;
}
__device__ __forceinline__ int rt2tt(int rt) { return (rt >> 11) * L + NM + (rt & 2047); }

template <class AF, class BF, class EF>
__device__ __forceinline__ void gemm_naive(int M, int N, int K, AF af, BF bf, EF ef, int bid, int nb) {
  const int ncb = (N + 255) / 256;
  const int ntiles = (M / 8) * ncb;
  for (int tile = bid; tile < ntiles; tile += nb) {
    const int r0 = (tile / ncb) * 8;
    const int n = (tile % ncb) * 256 + threadIdx.x;
    if (n < N) {
      float a0 = 0, a1 = 0, a2 = 0, a3 = 0, a4 = 0, a5 = 0, a6 = 0, a7 = 0;
      for (int k = 0; k < K; ++k) {
        const float bv = bf(k, n);
        a0 += af(r0 + 0, k) * bv; a1 += af(r0 + 1, k) * bv; a2 += af(r0 + 2, k) * bv; a3 += af(r0 + 3, k) * bv;
        a4 += af(r0 + 4, k) * bv; a5 += af(r0 + 5, k) * bv; a6 += af(r0 + 6, k) * bv; a7 += af(r0 + 7, k) * bv;
      }
      ef(r0 + 0, n, a0); ef(r0 + 1, n, a1); ef(r0 + 2, n, a2); ef(r0 + 3, n, a3);
      ef(r0 + 4, n, a4); ef(r0 + 5, n, a5); ef(r0 + 6, n, a6); ef(r0 + 7, n, a7);
    }
  }
}


typedef __attribute__((ext_vector_type(8))) short bf16x8;
typedef __attribute__((ext_vector_type(4))) float f32x4;
typedef __attribute__((ext_vector_type(4))) unsigned u32x4;
typedef __attribute__((ext_vector_type(2))) float f32x2;
typedef __attribute__((ext_vector_type(4))) short bf16x4;
typedef __attribute__((ext_vector_type(2))) unsigned u32x2;
constexpr int NCH = 129;

__device__ __forceinline__ uint2 pack4bf(float a, float b, float c, float d) {
  uint2 r;
  r.x = (unsigned)f2bf(a) | ((unsigned)f2bf(b) << 16);
  r.y = (unsigned)f2bf(c) | ((unsigned)f2bf(d) << 16);
  return r;
}

__device__ __forceinline__ bf16x4 pk4(const f32x4 v) {
  const uint2 t = pack4bf(v[0], v[1], v[2], v[3]);
  u32x2 u; u[0] = t.x; u[1] = t.y;
  return __builtin_bit_cast(bf16x4, u);
}
__device__ __forceinline__ f32x4 unpk4(const u32x2 u) {
  f32x4 r;
  r[0] = __uint_as_float(u[0] << 16); r[1] = __uint_as_float(u[0] & 0xffff0000u);
  r[2] = __uint_as_float(u[1] << 16); r[3] = __uint_as_float(u[1] & 0xffff0000u);
  return r;
}
#define MFMA16(a, b, c) __builtin_amdgcn_mfma_f32_16x16x16bf16_1k(a, b, c, 0, 0, 0)
#define MFMA32(a, b, c) __builtin_amdgcn_mfma_f32_16x16x32_bf16(a, b, c, 0, 0, 0)

__device__ __forceinline__ float dpp_sum8(float v) {
  v += __int_as_float(__builtin_amdgcn_update_dpp(0, __float_as_int(v), 0xB1, 0xF, 0xF, true));
  v += __int_as_float(__builtin_amdgcn_update_dpp(0, __float_as_int(v), 0x4E, 0xF, 0xF, true));
  v += __int_as_float(__builtin_amdgcn_update_dpp(0, __float_as_int(v), 0x141, 0xF, 0xF, true));
  return v;
}
__device__ __forceinline__ float tr_reduce16(const float (&pd)[16], int lane) {
  const bool b5 = lane & 32, b4 = lane & 16, b3 = lane & 8, b2 = lane & 4;
  float q8[8], q4[4], q2[2], q1;
#pragma unroll
  for (int i = 0; i < 8; ++i) { const float sd = b5 ? pd[i] : pd[i + 8], kp = b5 ? pd[i + 8] : pd[i]; q8[i] = kp + __shfl_xor(sd, 32, 64); }
#pragma unroll
  for (int i = 0; i < 4; ++i) { const float sd = b4 ? q8[i] : q8[i + 4], kp = b4 ? q8[i + 4] : q8[i]; q4[i] = kp + __shfl_xor(sd, 16, 64); }
#pragma unroll
  for (int i = 0; i < 2; ++i) { const float sd = b3 ? q4[i] : q4[i + 2], kp = b3 ? q4[i + 2] : q4[i]; q2[i] = kp + __shfl_xor(sd, 8, 64); }
  { const float sd = b2 ? q2[0] : q2[1], kp = b2 ? q2[1] : q2[0]; q1 = kp + __shfl_xor(sd, 4, 64); }
  q1 += __shfl_xor(q1, 2, 64);
  q1 += __shfl_xor(q1, 1, 64);
  return q1;
}

struct NoMid { __device__ __forceinline__ void operator()(int, f32x4 (&)[4][4]) const {} };
template <bool TRANS, bool ZERO = true, bool SPLITA = false, class ALoad, class BLoad, class Mid = NoMid>
__device__ __forceinline__ void gemm_tile(char* smem, int m0, int n0, int kt0, int kt1, ALoad aload, BLoad bload, f32x4 (&acc)[4][4], Mid mid = Mid()) {
  const int tid = threadIdx.x, lane = tid & 63, w = tid >> 6, wm = w >> 1, wn = w & 1;
  const int srow = tid >> 3, sslot = tid & 7;
  const int swz = (sslot ^ (srow & 7)) << 4;
  char* sA = smem;
  char* sB = smem + 32768;
  const int g = lane >> 4, r16 = lane & 15;
  const int fa0 = (wm * 64 + r16) * 128 + (((0 + g) ^ (lane & 7)) << 4);
  const int fa1 = (wm * 64 + r16) * 128 + (((4 + g) ^ (lane & 7)) << 4);
  const int fb0 = (wn * 64 + r16) * 128 + (((0 + g) ^ (lane & 7)) << 4);
  const int fb1 = (wn * 64 + r16) * 128 + (((4 + g) ^ (lane & 7)) << 4);
  u32x4 ra[4], rb[4];
#pragma unroll
  for (int i = 0; i < 4; ++i) {
    ra[i] = aload(m0 + srow + 32 * i, kt0 * 64 + sslot * 8, i);
    rb[i] = bload(n0 + srow + 32 * i, kt0 * 64 + sslot * 8);
  }
  if constexpr (ZERO) {
#pragma unroll
    for (int i = 0; i < 4; ++i)
#pragma unroll
      for (int j = 0; j < 4; ++j) acc[i][j] = (f32x4){0.f, 0.f, 0.f, 0.f};
  }
  __syncthreads();
#pragma unroll
  for (int i = 0; i < 4; ++i) {
    *reinterpret_cast<u32x4*>(sA + (srow + 32 * i) * 128 + swz) = ra[i];
    *reinterpret_cast<u32x4*>(sB + (srow + 32 * i) * 128 + swz) = rb[i];
  }
  __syncthreads();
  for (int kt = kt0; kt < kt1; ++kt) {
    const int cur = ((kt - kt0) & 1) * 16384;
    mid(kt, acc);
    if (kt + 1 < kt1) {
#pragma unroll
      for (int i = 0; i < 4; ++i) {
        if (!SPLITA || i < 2) ra[i] = aload(m0 + srow + 32 * i, (kt + 1) * 64 + sslot * 8, i);
        rb[i] = bload(n0 + srow + 32 * i, (kt + 1) * 64 + sslot * 8);
      }
    }
#pragma unroll
    for (int ks = 0; ks < 2; ++ks) {
      if (SPLITA && ks == 1 && kt + 1 < kt1) {
#pragma unroll
        for (int i = 2; i < 4; ++i) ra[i] = aload(m0 + srow + 32 * i, (kt + 1) * 64 + sslot * 8, i);
      }
      bf16x8 af[4], bfr[4];
#pragma unroll
      for (int i = 0; i < 4; ++i) af[i] = *reinterpret_cast<const bf16x8*>(sA + cur + (ks ? fa1 : fa0) + i * 2048);
#pragma unroll
      for (int j = 0; j < 4; ++j) bfr[j] = *reinterpret_cast<const bf16x8*>(sB + cur + (ks ? fb1 : fb0) + j * 2048);
#pragma unroll
      for (int i = 0; i < 4; ++i)
#pragma unroll
        for (int j = 0; j < 4; ++j) {
          if constexpr (TRANS) acc[i][j] = __builtin_amdgcn_mfma_f32_16x16x32_bf16(bfr[j], af[i], acc[i][j], 0, 0, 0);
          else acc[i][j] = __builtin_amdgcn_mfma_f32_16x16x32_bf16(af[i], bfr[j], acc[i][j], 0, 0, 0);
        }
    }
    if (kt + 1 < kt1) {
      const int nxt = 16384 - cur;
#pragma unroll
      for (int i = 0; i < 4; ++i) {
        *reinterpret_cast<u32x4*>(sA + nxt + (srow + 32 * i) * 128 + swz) = ra[i];
        *reinterpret_cast<u32x4*>(sB + nxt + (srow + 32 * i) * 128 + swz) = rb[i];
      }
    }
    __syncthreads();
  }
}
#define GLDS16(gp, lp) __builtin_amdgcn_global_load_lds((const __attribute__((address_space(1))) void*)(gp), (__attribute__((address_space(3))) void*)(lp), 16, 0, 0)
template <bool TRANS, class APtr, class BPtr, class Mid = NoMid>
__device__ __forceinline__ void gemm_tile_glds(char* smem, int m0, int n0, int nk32, APtr aptr, BPtr bptr, f32x4 (&acc)[4][4], Mid mid = Mid()) {
  const int tid = threadIdx.x, lane = tid & 63, w = tid >> 6, wm = w >> 1, wn = w & 1;
  const int lrow = lane >> 2;
  const int schunk = ((lane & 3) ^ ((lrow >> 2) & 3)) * 8;
  const int wb = (__builtin_amdgcn_readfirstlane(tid) >> 6);
  const int g = lane >> 4, r16 = lane & 15;
  const int fsl = (g ^ ((r16 >> 2) & 3)) << 4;
  const int fa = (wm * 64 + r16) * 64 + fsl;
  const int fb = 8192 + (wn * 64 + r16) * 64 + fsl;
#pragma unroll
  for (int i = 0; i < 4; ++i)
#pragma unroll
    for (int j = 0; j < 4; ++j) acc[i][j] = (f32x4){0.f, 0.f, 0.f, 0.f};
  __syncthreads();
  auto issue = [&](int kt) {
    char* st = smem + (kt & 3) * 16384;
#pragma unroll
    for (int i = 0; i < 2; ++i) {
      const int row = 16 * wb + 64 * i + lrow;
      GLDS16(aptr(m0 + row, kt * 32 + schunk), st + (16 * wb + 64 * i) * 64);
      GLDS16(bptr(n0 + row, kt * 32 + schunk), st + 8192 + (16 * wb + 64 * i) * 64);
    }
  };
  issue(0);
  if (nk32 > 1) issue(1);
  if (nk32 > 2) issue(2);
  for (int kt = 0; kt < nk32; ++kt) {
    if (kt + 2 < nk32) asm volatile("s_waitcnt vmcnt(8)\n\ts_barrier" ::: "memory");
    else if (kt + 1 < nk32) asm volatile("s_waitcnt vmcnt(4)\n\ts_barrier" ::: "memory");
    else asm volatile("s_waitcnt vmcnt(0)\n\ts_barrier" ::: "memory");
    if (kt + 3 < nk32) issue(kt + 3);
    mid(kt, acc);
    const char* st = smem + (kt & 3) * 16384;
    bf16x8 af[4], bfr[4];
#pragma unroll
    for (int i = 0; i < 4; ++i) af[i] = *reinterpret_cast<const bf16x8*>(st + fa + i * 1024);
#pragma unroll
    for (int j = 0; j < 4; ++j) bfr[j] = *reinterpret_cast<const bf16x8*>(st + fb + j * 1024);
#pragma unroll
    for (int i = 0; i < 4; ++i)
#pragma unroll
      for (int j = 0; j < 4; ++j) {
        if constexpr (TRANS) acc[i][j] = __builtin_amdgcn_mfma_f32_16x16x32_bf16(bfr[j], af[i], acc[i][j], 0, 0, 0);
        else acc[i][j] = __builtin_amdgcn_mfma_f32_16x16x32_bf16(af[i], bfr[j], acc[i][j], 0, 0, 0);
      }
  }
  __syncthreads();
}
struct NoMidW { __device__ __forceinline__ void operator()(int, f32x4 (&)[4][8]) const {} };
template <class APtr, class BPtr, class Mid = NoMidW>
__device__ __forceinline__ void gemm_tile_wide(char* smem, int m0, int n0, int nk32, APtr aptr, BPtr bptr, f32x4 (&acc)[4][8], Mid mid = Mid()) {
  const int tid = threadIdx.x, lane = tid & 63, w = tid >> 6, wm = w >> 1, wn = w & 1;
  const int lrow = lane >> 2;
  const int schunk = ((lane & 3) ^ ((lrow >> 2) & 3)) * 8;
  const int wb = (__builtin_amdgcn_readfirstlane(tid) >> 6);
  const int g = lane >> 4, r16 = lane & 15;
  const int fsl = (g ^ ((r16 >> 2) & 3)) << 4;
  const int fa = (wm * 64 + r16) * 64 + fsl;
  const int fb = 8192 + (wn * 128 + r16) * 64 + fsl;
#pragma unroll
  for (int i = 0; i < 4; ++i)
#pragma unroll
    for (int j = 0; j < 8; ++j) acc[i][j] = (f32x4){0.f, 0.f, 0.f, 0.f};
  __syncthreads();
  auto issue = [&](int kt) {
    char* st = smem + (kt % 3) * 24576;
#pragma unroll
    for (int i = 0; i < 2; ++i) GLDS16(aptr(m0 + 16 * wb + 64 * i + lrow, kt * 32 + schunk), st + (16 * wb + 64 * i) * 64);
#pragma unroll
    for (int i = 0; i < 4; ++i) GLDS16(bptr(n0 + 16 * wb + 64 * i + lrow, kt * 32 + schunk), st + 8192 + (16 * wb + 64 * i) * 64);
  };
  issue(0);
  if (nk32 > 1) issue(1);
  for (int kt = 0; kt < nk32; ++kt) {
    if (kt + 1 < nk32) asm volatile("s_waitcnt vmcnt(6)\n\ts_barrier" ::: "memory");
    else asm volatile("s_waitcnt vmcnt(0)\n\ts_barrier" ::: "memory");
    if (kt + 2 < nk32) issue(kt + 2);
    mid(kt, acc);
    const char* st = smem + (kt % 3) * 24576;
    bf16x8 af[4], bfr[8];
#pragma unroll
    for (int i = 0; i < 4; ++i) af[i] = *reinterpret_cast<const bf16x8*>(st + fa + i * 1024);
#pragma unroll
    for (int j = 0; j < 8; ++j) bfr[j] = *reinterpret_cast<const bf16x8*>(st + fb + j * 1024);
#pragma unroll
    for (int i = 0; i < 4; ++i)
#pragma unroll
      for (int j = 0; j < 8; ++j) acc[i][j] = __builtin_amdgcn_mfma_f32_16x16x32_bf16(bfr[j], af[i], acc[i][j], 0, 0, 0);
  }
  __syncthreads();
}
__device__ __forceinline__ void stage_acc_half(char* smem, const f32x4 (&acc)[4][8], int half) {
  const int lane = threadIdx.x & 63, w = threadIdx.x >> 6, wm = w >> 1, wn = w & 1, g = lane >> 4, r16 = lane & 15;
  float* Et = reinterpret_cast<float*>(smem);
  __syncthreads();
  if (wn == half) {
#pragma unroll
    for (int i = 0; i < 4; ++i)
#pragma unroll
      for (int j = 0; j < 8; ++j)
        *reinterpret_cast<f32x4*>(Et + (wm * 64 + 16 * i + r16) * 132 + 16 * j + 4 * g) = acc[i][j];
  }
  __syncthreads();
}
template <class Body>
__device__ __forceinline__ void for_tiles_xcd(int MT, int NT, int bid, int nb, Body body, int rshift = 0) {
  if (nb & 7) {
    for (int e = bid; e < MT * NT; e += nb) body(e / NT, e % NT);
    return;
  }
  const int x = bid & 7, lb = bid >> 3, nlb = nb >> 3;
  const int mper = (MT >> 3) & ~3;
  const int main_cnt = mper * NT;
  for (int q = lb; q < main_cnt; q += nlb) {
    const int patch = q / (4 * NT), r = q - patch * (4 * NT);
    body(x * mper + patch * 4 + (r & 3), r >> 2);
  }
  const int rem = (MT - 8 * mper) * NT;
  const int rb = ((nb - 1 - bid - rshift) % nb + nb) % nb;
  for (int e = rb; e < rem; e += nb) body(8 * mper + e / NT, e % NT);
}
__device__ __forceinline__ void st8f(bf16_t* dst, const float (&v)[8]) {
  u32x4 w;
#pragma unroll
  for (int e = 0; e < 4; ++e) w[e] = (unsigned)f2bf(v[2 * e]) | ((unsigned)f2bf(v[2 * e + 1]) << 16);
  *reinterpret_cast<u32x4*>(dst) = w;
}
__device__ __forceinline__ void stage_acc(char* smem, const f32x4 (&acc)[4][4]) {
  const int lane = threadIdx.x & 63, w = threadIdx.x >> 6, wm = w >> 1, wn = w & 1, g = lane >> 4, r16 = lane & 15;
  float* Et = reinterpret_cast<float*>(smem);
#pragma unroll
  for (int i = 0; i < 4; ++i)
#pragma unroll
    for (int j = 0; j < 4; ++j)
      *reinterpret_cast<f32x4*>(Et + (wm * 64 + 16 * i + r16) * 132 + wn * 64 + 16 * j + 4 * g) = acc[i][j];
  __syncthreads();
}
__device__ __forceinline__ void ld8(const char* smem, int row, int col8, float (&v)[8]) {
  const float* Et = reinterpret_cast<const float*>(smem);
  const f32x4 a = *reinterpret_cast<const f32x4*>(Et + row * 132 + col8), b = *reinterpret_cast<const f32x4*>(Et + row * 132 + col8 + 4);
#pragma unroll
  for (int e = 0; e < 4; ++e) { v[e] = a[e]; v[4 + e] = b[e]; }
}
__device__ __forceinline__ float sumsq8(const u32x4 v) {
  float s = 0.f;
#pragma unroll
  for (int q = 0; q < 4; ++q) {
    const float lo = __uint_as_float(v[q] << 16), hi = __uint_as_float(v[q] & 0xffff0000u);
    s += lo * lo + hi * hi;
  }
  return s;
}
__device__ __forceinline__ void rowss_publish(float* rowss, const float (&ss)[4]) {
  const int srow = threadIdx.x >> 3, sslot = threadIdx.x & 7;
#pragma unroll
  for (int i = 0; i < 4; ++i) {
    float v = ss[i];
    v += __shfl_xor(v, 1, 64); v += __shfl_xor(v, 2, 64); v += __shfl_xor(v, 4, 64);
    if (sslot == 0) rowss[srow + 32 * i] = v;
  }
  __syncthreads();
}
template <bool TRANS, class ARow, class BRow, class Epi>
__device__ __forceinline__ void gemm_bf16(char* smem, int mtiles, int N, int K, ARow arow, BRow brow,
                                          Epi epi, int bid, int nb) {
  const int lane = threadIdx.x & 63, w = threadIdx.x >> 6, wm = w >> 1, wn = w & 1, g = lane >> 4, r16 = lane & 15;
  const int ntn = (N + 127) >> 7;
  for (int tile = bid; tile < mtiles * ntn; tile += nb) {
    const int tm = tile / ntn, tn = tile - tm * ntn;
    const int m0 = tm * 128, n0 = tn * 128;
    f32x4 acc[4][4];
    gemm_tile<TRANS>(smem, m0, n0, 0, K >> 6,
        [&](int r, int k, int) { return *reinterpret_cast<const u32x4*>(arow(r) + k); },
        [&](int n, int k) { return *reinterpret_cast<const u32x4*>(brow(min(n, N - 1)) + k); }, acc);
    if constexpr (TRANS) epi(acc, m0 + wm * 64 + r16, n0 + wn * 64 + 4 * g);
    else epi(acc, m0 + wm * 64 + 4 * g, n0 + wn * 64 + r16);
  }
}

__device__ __forceinline__ void wtrans(const float* __restrict__ W, const float* __restrict__ gk, int K, int N, bf16_t* out,
                                       int gtid, int gthreads, int glim = 1 << 30) {
  const int total = N * (K >> 3);
  for (int idx = gtid; idx < total; idx += gthreads) {
    const int n = idx % N, kc = idx / N;
    float v[8];
#pragma unroll
    for (int i = 0; i < 8; ++i) {
      const int k = kc * 8 + i;
      v[i] = W[(size_t)k * N + n] * ((gk && k < glim) ? gk[k] : 1.0f);
    }
    uint4 o;
    uint2 lo = pack4bf(v[0], v[1], v[2], v[3]), hi = pack4bf(v[4], v[5], v[6], v[7]);
    o.x = lo.x; o.y = lo.y; o.z = hi.x; o.w = hi.y;
    *reinterpret_cast<uint4*>(out + (size_t)n * K + kc * 8) = o;
  }
}

__device__ __forceinline__ void ph_prep(const Params& p, int bid, int nb) {
  const int lane = threadIdx.x & 63, wv = threadIdx.x >> 6;
  for (int tt = bid * 4 + wv; tt < T; tt += nb * 4) {
    const float4* hr = reinterpret_cast<const float4*>(hrow(p, tt));
    float s = 0;
#pragma unroll
    for (int j = 0; j < 4; ++j) {
      const float4 v = hr[j * 64 + lane];
      s += v.x * v.x + v.y * v.y + v.z * v.z + v.w * v.w;
      *reinterpret_cast<uint2*>(p.hb + (size_t)tt * D + (j * 64 + lane) * 4) = pack4bf(v.x, v.y, v.z, v.w);
    }
    s = wave_sum(s);
    if (lane == 0) p.rstd1[tt] = rsqrtf(s * (1.0f / D) + RMS_EPS);
  }
  const int gtid = bid * NTHR + threadIdx.x, gth = nb * NTHR;
  for (int e = gtid; e < L * 32; e += gth) {
    const int i = e & 31, pos = e >> 5;
    const float inv = exp2f(-(float)i * (13.287712379549449f / 32.0f));
    float sn, cs; sincosf((float)pos * inv, &sn, &cs);
    p.ropec[e] = cs; p.ropes[e] = sn;
  }
  wtrans(p.w_in, p.g_mix, 1024, DIN, p.w_inT, gtid, gth);
  wtrans(p.w_uq, p.g_q, 256, 768, p.w_uqT, gtid, gth);
  wtrans(p.w_ukv, p.g_kv, 128, 1024, p.w_ukvT, gtid, gth);
  wtrans(p.w_out, p.g_out, 1024, 1024, p.w_outT, gtid, gth, 512);
  for (int e = gtid; e < 1024 * 2048 / 4; e += gth) {
    const f32x4 v = *reinterpret_cast<const f32x4*>(p.w_q + (size_t)e * 4);
    *reinterpret_cast<uint2*>(p.w_qb + (size_t)e * 4) = pack4bf(v[0], v[1], v[2], v[3]);
  }
  for (int e = gtid; e < 8 * 2 * 128 * 128 / 4; e += gth) {
    const f32x4 v = *reinterpret_cast<const f32x4*>(p.subk + (size_t)e * 4);
    *reinterpret_cast<uint2*>(p.subkb + (size_t)e * 4) = pack4bf(v[0], v[1], v[2], v[3]);
  }
  for (int e = gtid; e < 1536 * 128; e += gth) {
    const int n = e >> 7, k = e & 127;
    float v = 0.f;
    if (n < 512) { if (k < 64) v = p.w_up[k * 512 + n]; }
    else if (n < 1024) { if (k < 64) v = p.a_up[k * 512 + n - 512]; }
    else v = p.g_up[k * 512 + n - 1024];
    p.w_lrT[e] = f2bf(v);
  }
}
__device__ __forceinline__ void ph_inproj(const Params& p, char* smem, int bid, int nb) {
  const int lane = threadIdx.x & 63, w = threadIdx.x >> 6, wm = w >> 1, wn = w & 1, g = lane >> 4, r16 = lane & 15;
  for_tiles_xcd(T / 128, (DIN + 127) >> 7, bid, nb, [&](int tm, int tn) {
    const int m0 = tm * 128, n0 = tn * 128;
    f32x4 acc[4][4];
    gemm_tile_glds<true>(smem, m0, n0, 32,
        [&](int r, int k) { return p.hb + (size_t)r * D + k; },
        [&](int n, int k) { return p.w_inT + (size_t)min(n, DIN - 1) * 1024 + k; }, acc);
    float rsq[8];
#pragma unroll
    for (int q = 0; q < 8; ++q) rsq[q] = p.rstd1[m0 + ((threadIdx.x + 256 * q) >> 4)];
    stage_acc(smem, acc);
#pragma unroll
    for (int q = 0; q < 8; ++q) {
      const int c = threadIdx.x + 256 * q;
      const int row = c >> 4, col8 = (c & 15) * 8;
      const int m = m0 + row, n = n0 + col8;
      const float rs = rsq[q];
      float v[8];
      ld8(smem, row, col8, v);
      if (n0 == 384 && col8 < 64) {
        if (col8 < 32) {
          float v2[8], y1[8], y2[8];
          ld8(smem, row, col8 + 32, v2);
          const int pos = m % L;
          const f32x4 c0 = *reinterpret_cast<const f32x4*>(p.ropec + pos * 32 + col8), c1 = *reinterpret_cast<const f32x4*>(p.ropec + pos * 32 + col8 + 4);
          const f32x4 s0 = *reinterpret_cast<const f32x4*>(p.ropes + pos * 32 + col8), s1 = *reinterpret_cast<const f32x4*>(p.ropes + pos * 32 + col8 + 4);
#pragma unroll
          for (int e = 0; e < 8; ++e) {
            const float cs = e < 4 ? c0[e] : c1[e - 4], sn = e < 4 ? s0[e] : s1[e - 4];
            const float x1 = v[e] * rs, x2 = v2[e] * rs;
            y1[e] = x1 * cs - x2 * sn; y2[e] = x1 * sn + x2 * cs;
          }
          st8f(p.kr + (size_t)m * 64 + col8, y1);
          st8f(p.kr + (size_t)m * 64 + 32 + col8, y2);
        }
      } else if (n < DIN) {
#pragma unroll
        for (int e = 0; e < 8; ++e) v[e] *= rs;
        st8f(p.proj + (size_t)m * DIN + n, v);
      }
    }
  });
}
__device__ __forceinline__ void ph_w2(const Params& p, char* smem, int bid, int nb) {
  for (int e = bid; e < 128; e += nb) {
    const int hc = e >> 3, n0 = (e & 7) * 128;
    f32x4 acc[4][4];
    gemm_tile_glds<true>(smem, 0, n0, 4,
        [&](int r, int k) { return p.subkb + ((size_t)hc * 128 + r) * 128 + k; },
        [&](int n, int k) { return p.w_qb + (size_t)n * 2048 + hc * 128 + k; }, acc);
    stage_acc(smem, acc);
#pragma unroll 2
    for (int q = 0; q < 8; ++q) {
      const int c = threadIdx.x + 256 * q;
      const int row = c >> 4, col8 = (c & 15) * 8;
      float v[8];
      ld8(smem, row, col8, v);
      const f32x4 g0 = *reinterpret_cast<const f32x4*>(p.g_ffn + n0 + col8), g1 = *reinterpret_cast<const f32x4*>(p.g_ffn + n0 + col8 + 4);
#pragma unroll
      for (int e2 = 0; e2 < 8; ++e2) v[e2] *= e2 < 4 ? g0[e2] : g1[e2 - 4];
      st8f(p.w_qT + ((size_t)hc * 128 + row) * 1024 + n0 + col8, v);
    }
  }
}
__device__ __forceinline__ void ph_q_up(const Params& p, char* smem, int bid, int nb) {
  const int lane = threadIdx.x & 63, w = threadIdx.x >> 6, wm = w >> 1, wn = w & 1, g = lane >> 4, r16 = lane & 15;
  float* rowss = reinterpret_cast<float*>(smem);
  for_tiles_xcd(T / 128, 6, bid, nb, [&](int tm, int tn) {
    const int m0 = tm * 128, n0 = tn * 128;
    f32x4 acc[4][4];
    float ss[4] = {0.f, 0.f, 0.f, 0.f};
    gemm_tile<true>(smem, m0, n0, 0, 4,
        [&](int r, int k, int i) { const u32x4 v = *reinterpret_cast<const u32x4*>(p.proj + (size_t)r * DIN + k); ss[i] += sumsq8(v); return v; },
        [&](int n, int k) { return *reinterpret_cast<const u32x4*>(p.w_uqT + (size_t)n * 256 + k); }, acc);
    float rsum[4];
#pragma unroll
    for (int i = 0; i < 4; ++i) {
      float v = ss[i];
      v += __shfl_xor(v, 1, 64); v += __shfl_xor(v, 2, 64); v += __shfl_xor(v, 4, 64);
      rsum[i] = v;
    }
    stage_acc(smem, acc);
    float* rowss2 = reinterpret_cast<float*>(smem + 128 * 132 * 4);
    if ((threadIdx.x & 7) == 0) {
#pragma unroll
      for (int i = 0; i < 4; ++i) rowss2[(threadIdx.x >> 3) + 32 * i] = rsum[i];
    }
    __syncthreads();
#pragma unroll 2
    for (int q = 0; q < 8; ++q) {
      const int c = threadIdx.x + 256 * q;
      const int row = c >> 4, col8 = (c & 15) * 8;
      const int m = m0 + row, n = n0 + col8;
      const float rs = rsqrtf(rowss2[row] * (1.0f / 256) + RMS_EPS) * (0.07216878364870322f * 1.4426950408889634f);
      const int off = n % 192;
      float v[8];
      ld8(smem, row, col8, v);
      if (off >= 128) {
        if (off < 160) {
          float v2[8], y1[8], y2[8];
          ld8(smem, row, col8 + 32, v2);
          const int pos = m % L, ii = off - 128;
          const f32x4 c0 = *reinterpret_cast<const f32x4*>(p.ropec + pos * 32 + ii), c1 = *reinterpret_cast<const f32x4*>(p.ropec + pos * 32 + ii + 4);
          const f32x4 s0 = *reinterpret_cast<const f32x4*>(p.ropes + pos * 32 + ii), s1 = *reinterpret_cast<const f32x4*>(p.ropes + pos * 32 + ii + 4);
#pragma unroll
          for (int e = 0; e < 8; ++e) {
            const float cs = e < 4 ? c0[e] : c1[e - 4], sn = e < 4 ? s0[e] : s1[e - 4];
            const float x1 = v[e] * rs, x2 = v2[e] * rs;
            y1[e] = x1 * cs - x2 * sn; y2[e] = x1 * sn + x2 * cs;
          }
          st8f(p.qf + (size_t)m * 768 + n, y1);
          st8f(p.qf + (size_t)m * 768 + n + 32, y2);
        }
      } else {
#pragma unroll
        for (int e = 0; e < 8; ++e) v[e] *= rs;
        st8f(p.qf + (size_t)m * 768 + n, v);
      }
    }
  }, 12);
}
__device__ __forceinline__ void ph_kv_up(const Params& p, char* smem, int bid, int nb) {
  const int lane = threadIdx.x & 63, w = threadIdx.x >> 6, wm = w >> 1, wn = w & 1, g = lane >> 4, r16 = lane & 15;
  float* rowss = reinterpret_cast<float*>(smem);
  for_tiles_xcd(T / 128, 8, bid, nb, [&](int tm, int tn) {
    const bool vpart = tn >= 4;
    const int m0 = tm * 128, n0 = (tn & 3) * 128;
    f32x4 acc[4][4];
    float ss[4] = {0.f, 0.f, 0.f, 0.f};
    auto al = [&](int r, int k, int i) { const u32x4 v = *reinterpret_cast<const u32x4*>(p.proj + (size_t)r * DIN + 256 + k); ss[i] += sumsq8(v); return v; };
    if (!vpart) {
      gemm_tile<true>(smem, m0, n0, 0, 2, al,
          [&](int n, int k) { return *reinterpret_cast<const u32x4*>(p.w_ukvT + (size_t)((n >> 7) * 256 + (n & 127)) * 128 + k); }, acc);
      float rsum[4];
#pragma unroll
      for (int i = 0; i < 4; ++i) {
        float v = ss[i];
        v += __shfl_xor(v, 1, 64); v += __shfl_xor(v, 2, 64); v += __shfl_xor(v, 4, 64);
        rsum[i] = v;
      }
      stage_acc(smem, acc);
      float* rowss2 = reinterpret_cast<float*>(smem + 128 * 132 * 4);
      if ((threadIdx.x & 7) == 0) {
#pragma unroll
        for (int i = 0; i < 4; ++i) rowss2[(threadIdx.x >> 3) + 32 * i] = rsum[i];
      }
      __syncthreads();
#pragma unroll 2
      for (int q = 0; q < 8; ++q) {
        const int c = threadIdx.x + 256 * q;
        const int row = c >> 4, col8 = (c & 15) * 8;
        const int m = m0 + row, n = n0 + col8;
        const float rs = rsqrtf(rowss2[row] * (1.0f / 128) + RMS_EPS);
        const int b = m / L, pos = m - b * L;
        float v[8];
        ld8(smem, row, col8, v);
#pragma unroll
        for (int e = 0; e < 8; ++e) v[e] *= rs;
        st8f(p.kn + ((size_t)((b * 4 + (n >> 7)) * L + pos)) * 128 + (n & 127), v);
      }
    } else {
      gemm_tile<false>(smem, m0, n0, 0, 2, al,
          [&](int n, int k) { return *reinterpret_cast<const u32x4*>(p.w_ukvT + (size_t)((n >> 7) * 256 + 128 + (n & 127)) * 128 + k); }, acc);
      rowss_publish(rowss, ss);
      const int mb = m0 + wm * 64 + 4 * g, nbase = n0 + wn * 64 + r16;
#pragma unroll
      for (int i = 0; i < 4; ++i) {
        const int m = mb + 16 * i;
        f32x4 rs;
#pragma unroll
        for (int r = 0; r < 4; ++r) rs[r] = rsqrtf(rowss[wm * 64 + 16 * i + 4 * g + r] * (1.0f / 128) + RMS_EPS);
        const int b = m / L, pos = m - b * L;
#pragma unroll
        for (int j = 0; j < 4; ++j) {
          const int n = nbase + 16 * j;
          const int h = n >> 7, dv = n & 127;
          const f32x4 v = acc[i][j] * rs;
          *reinterpret_cast<uint2*>(p.vt + ((size_t)((b * 4 + h) * 128 + dv)) * L + pos) = pack4bf(v[0], v[1], v[2], v[3]);
        }
      }
    }
  }, 18);
}
__device__ __forceinline__ float fast_rcp(float x) { return __builtin_amdgcn_rcpf(x); }
__device__ __forceinline__ float fast_sigmoid(float x) { return fast_rcp(1.0f + __expf(-x)); }
__device__ __forceinline__ float fast_tanh(float x) { return 1.0f - 2.0f * fast_rcp(1.0f + __expf(2.0f * x)); }
__device__ __forceinline__ float lerp_tok(const Params& p, int tt, int pos, int c) {
  const float cur = bf2f(p.proj[(size_t)tt * DIN + 448 + c]);
  const float prev = pos > 0 ? bf2f(p.proj[(size_t)(tt - 1) * DIN + 448 + c]) : 0.0f;
  return cur + p.mu[c] * (prev - cur);
}
__device__ __forceinline__ f32x4 lerp4(const Params& p, int tt, int pos, int c) {
  const f32x4 cur = unpk4(*reinterpret_cast<const u32x2*>(p.proj + (size_t)tt * DIN + 448 + c));
  f32x4 prev = {0.f, 0.f, 0.f, 0.f};
  if (pos > 0) prev = unpk4(*reinterpret_cast<const u32x2*>(p.proj + (size_t)(tt - 1) * DIN + 448 + c));
  const f32x4 m = *reinterpret_cast<const f32x4*>(p.mu + c);
  return cur + m * (prev - cur);
}
__device__ __forceinline__ void ph_rwkv_prep(const Params& p, char* smem, int bid, int nb) {
  const int lane = threadIdx.x & 63, w = threadIdx.x >> 6, wm = w >> 1, wn = w & 1, g = lane >> 4, r16 = lane & 15;
  for_tiles_xcd(T / 128, 12, bid, nb, [&](int tm, int tn) {
    const int kind = tn >> 2, n0 = (tn & 3) * 128;
    const int m0 = tm * 128;
    const int kbase = kind == 0 ? 1536 : (kind == 1 ? 1600 : 1664);
    f32x4 acc[4][4];
    gemm_tile<true>(smem, m0, n0, 0, kind == 2 ? 2 : 1,
        [&](int r, int k, int) {
          const int pos = r % L;
          const u32x4 cu = *reinterpret_cast<const u32x4*>(p.proj + (size_t)r * DIN + 448 + kbase + k);
          u32x4 pv = {0u, 0u, 0u, 0u};
          if (pos > 0) pv = *reinterpret_cast<const u32x4*>(p.proj + (size_t)(r - 1) * DIN + 448 + kbase + k);
          u32x4 o;
#pragma unroll
          for (int q = 0; q < 4; ++q) {
            float c0 = __uint_as_float(cu[q] << 16), c1 = __uint_as_float(cu[q] & 0xffff0000u);
            const float p0 = __uint_as_float(pv[q] << 16), p1 = __uint_as_float(pv[q] & 0xffff0000u);
            c0 += p.mu[kbase + k + 2 * q] * (p0 - c0);
            c1 += p.mu[kbase + k + 2 * q + 1] * (p1 - c1);
            if (kind == 0) { c0 = fast_tanh(c0); c1 = fast_tanh(c1); }
            else if (kind == 2) { c0 = fast_sigmoid(c0); c1 = fast_sigmoid(c1); }
            o[q] = (unsigned)f2bf(c0) | ((unsigned)f2bf(c1) << 16);
          }
          return o;
        },
        [&](int n, int k) { return *reinterpret_cast<const u32x4*>(p.w_lrT + (size_t)(kind * 512 + n) * 128 + k); }, acc);
    float* Et = reinterpret_cast<float*>(smem);
#pragma unroll
    for (int i = 0; i < 4; ++i)
#pragma unroll
      for (int j = 0; j < 4; ++j)
        *reinterpret_cast<f32x4*>(Et + (wm * 64 + 16 * i + r16) * 132 + wn * 64 + 16 * j + 4 * g) = acc[i][j];
    __syncthreads();
    const int coloff = kind == 0 ? 0 : (kind == 1 ? 512 : 1024);
    bf16_t* const xdst = kind == 0 ? p.rr : (kind == 1 ? p.rk2 : p.rv);
    bf16_t* const ldst = kind == 0 ? p.rlw : (kind == 1 ? p.rkk : p.rg);
    const int chh = n0 + (threadIdx.x & 15) * 8;
    const f32x4 mu0 = *reinterpret_cast<const f32x4*>(p.mu + coloff + chh), mu1 = *reinterpret_cast<const f32x4*>(p.mu + coloff + chh + 4);
#pragma unroll 1
    for (int qb = 0; qb < 8; qb += 4) {
    u32x4 cuv[4], pvv[4];
#pragma unroll
    for (int qi = 0; qi < 4; ++qi) {
      const int c = threadIdx.x + 256 * (qb + qi);
      const int m = m0 + (c >> 4);
      const bf16_t* pc = p.proj + (size_t)m * DIN + 448 + coloff + n0 + (c & 15) * 8;
      cuv[qi] = *reinterpret_cast<const u32x4*>(pc);
      pvv[qi] = *reinterpret_cast<const u32x4*>(pc - ((m % L) > 0 ? DIN : 0));
    }
#pragma unroll
    for (int qi = 0; qi < 4; ++qi) {
      const int q = qb + qi;
      const int c = threadIdx.x + 256 * q;
      const int row = c >> 4, ch = n0 + (c & 15) * 8;
      const int m = m0 + row, pos = m % L;
      const f32x4 l0 = *reinterpret_cast<const f32x4*>(Et + row * 132 + (c & 15) * 8);
      const f32x4 l1 = *reinterpret_cast<const f32x4*>(Et + row * 132 + (c & 15) * 8 + 4);
      const u32x4 cu = cuv[qi];
      u32x4 pv = pvv[qi];
      if (pos == 0) pv = (u32x4){0u, 0u, 0u, 0u};
      float xs[8], lr[8];
#pragma unroll
      for (int e = 0; e < 4; ++e) {
        const float c0 = __uint_as_float(cu[e] << 16), c1 = __uint_as_float(cu[e] & 0xffff0000u);
        const float p0 = __uint_as_float(pv[e] << 16), p1 = __uint_as_float(pv[e] & 0xffff0000u);
        const float m0_ = e < 2 ? mu0[2 * e] : mu1[2 * e - 4], m1_ = e < 2 ? mu0[2 * e + 1] : mu1[2 * e - 3];
        xs[2 * e] = c0 + m0_ * (p0 - c0);
        xs[2 * e + 1] = c1 + m1_ * (p1 - c1);
      }
#pragma unroll
      for (int e = 0; e < 4; ++e) { lr[e] = l0[e]; lr[4 + e] = l1[e]; }
      const size_t o = (size_t)m * 512 + ch;
      if (kind == 0) {
        const f32x4 w00 = *reinterpret_cast<const f32x4*>(p.w0 + ch), w01 = *reinterpret_cast<const f32x4*>(p.w0 + ch + 4);
        float lw[8];
#pragma unroll
        for (int e = 0; e < 8; ++e) {
          const float nx = -(lr[e] + (e < 4 ? w00[e] : w01[e - 4]));
          const float sp = fmaxf(nx, 0.0f) + __logf(1.0f + __expf(-fabsf(nx)));
          lw[e] = -__expf(-sp - 0.5f);
        }
        st8f(ldst + o, lw);
        st8f(xdst + o, xs);
      } else if (kind == 2) {
        st8f(ldst + o, lr);
        st8f(xdst + o, xs);
      } else {
        const f32x4 a00 = *reinterpret_cast<const f32x4*>(p.a0 + ch), a01 = *reinterpret_cast<const f32x4*>(p.a0 + ch + 4);
        const f32x4 kk0 = *reinterpret_cast<const f32x4*>(p.k_k + ch), kk1 = *reinterpret_cast<const f32x4*>(p.k_k + ch + 4);
        const f32x4 ka0 = *reinterpret_cast<const f32x4*>(p.k_a + ch), ka1 = *reinterpret_cast<const f32x4*>(p.k_a + ch + 4);
        float av[8], kkr[8], ss = 0.f;
#pragma unroll
        for (int e = 0; e < 8; ++e) {
          av[e] = fast_sigmoid(lr[e] + (e < 4 ? a00[e] : a01[e - 4]));
          kkr[e] = xs[e] * (e < 4 ? kk0[e] : kk1[e - 4]);
          ss += kkr[e] * kkr[e];
        }
        ss = dpp_sum8(ss);
        const float inr = 1.0f / fmaxf(sqrtf(ss), 1e-12f);
        float kkn[8], k2[8], bb[8];
#pragma unroll
        for (int e = 0; e < 8; ++e) {
          kkn[e] = kkr[e] * inr;
          k2[e] = xs[e] * (1.0f + (av[e] - 1.0f) * (e < 4 ? ka0[e] : ka1[e - 4]));
          bb[e] = kkn[e] * av[e];
        }
        st8f(ldst + o, kkn);
        st8f(xdst + o, k2);
        st8f(p.rbb + o, bb);
      }
    }
    }
  });
}
template <bool STORE = true>
__device__ __forceinline__ void ph_attn(const Params& p, char* smem, int bid, int nb) {
  char* Kb = smem;
  char* Vs = smem + 49152;
  const int tid = threadIdx.x, lane = tid & 63, w = tid >> 6, g = lane >> 4, r16 = lane & 15;
  const int wu = __builtin_amdgcn_readfirstlane(tid) >> 6;
  const int nitems = 32 * 17;
  for (int it = bid; it < nitems; it += nb) {
    const int bh = it & 31, grp = it >> 5;
    const bool meta = grp == 16;
    const int j = 15 - grp;
    const int b = bh >> 2, h = bh & 3;
    const int qbase = meta ? 0 : 16 + 128 * j;
    const int ntiles = meta ? 1 : 2 * j + 3;
    const int my_ntiles = meta ? 1 : (w < 2 ? 2 * j + 2 : 2 * j + 3);
    bf16x8 qf[2][6];
#pragma unroll
    for (int nt = 0; nt < 2; ++nt)
#pragma unroll
      for (int ks = 0; ks < 6; ++ks) {
        const int pos = qbase + 32 * w + 16 * nt + r16;
        qf[nt][ks] = *reinterpret_cast<const bf16x8*>(p.qf + ((size_t)(b * L + pos)) * 768 + h * 192 + ks * 32 + 8 * g);
      }
    f32x4 o[8][2];
#pragma unroll
    for (int a = 0; a < 8; ++a) { o[a][0] = (f32x4){0.f, 0.f, 0.f, 0.f}; o[a][1] = (f32x4){0.f, 0.f, 0.f, 0.f}; }
    float mrun[2] = {-1e30f, -1e30f}, lrun[2] = {0.f, 0.f};
    const bf16_t* knb = p.kn + (size_t)(b * 4 + h) * L * 128;
    const bf16_t* krb = p.kr + (size_t)b * L * 64;
    const bf16_t* vtb = p.vt + (size_t)(b * 4 + h) * 128 * L;
    int koff[6], voff[4];
    unsigned kmask = 0;
#pragma unroll
    for (int i = 0; i < 6; ++i) {
      const int Lk = 64 * (6 * wu + i) + lane;
      const int row = Lk / 24, sp = Lk - row * 24;
      const int ch = (sp & ~7) | ((sp ^ row) & 7);
      if (ch < 16) koff[i] = row * 128 + ch * 8; else { koff[i] = row * 64 + (ch - 16) * 8; kmask |= 1u << i; }
    }
#pragma unroll
    for (int i = 0; i < 4; ++i) {
      const int row = 8 * (4 * wu + i) + (lane >> 3);
      voff[i] = row * L + (((lane & 7) ^ ((row >> 1) & 7)) * 8);
    }
    auto issueK = [&](int t) {
      const int kp0 = t == 0 ? 0 : 16 + 64 * (t - 1);
      char* dst = Kb + (t & 1) * 24576;
      const bf16_t* kb0 = knb + (size_t)kp0 * 128;
      const bf16_t* kb1 = krb + (size_t)kp0 * 64;
#pragma unroll
      for (int i = 0; i < 6; ++i) GLDS16(((kmask >> i) & 1u ? kb1 : kb0) + koff[i], dst + (6 * wu + i) * 1024);
    };
    auto issueV = [&](int t) {
      const int kp0 = t == 0 ? 0 : 16 + 64 * (t - 1);
      const bf16_t* vb0 = vtb + kp0;
#pragma unroll
      for (int i = 0; i < 4; ++i) GLDS16(vb0 + voff[i], Vs + (4 * wu + i) * 1024);
    };
    __syncthreads();
    issueK(0);
    asm volatile("s_waitcnt vmcnt(0)\n\ts_barrier" ::: "memory");
    for (int t = 0; t < ntiles; ++t) {
      const char* Ks = Kb + (t & 1) * 24576;
      issueV(t);
      if (t + 1 < ntiles) issueK(t + 1);
      bf16x8 pb[2][2];
      if (t < my_ntiles) {
        f32x4 s[4][2];
#pragma unroll
        for (int a = 0; a < 4; ++a) { s[a][0] = (f32x4){0.f, 0.f, 0.f, 0.f}; s[a][1] = (f32x4){0.f, 0.f, 0.f, 0.f}; }
#pragma unroll
        for (int ks = 0; ks < 6; ++ks) {
          const int slot = ks * 4 + g;
          const int so = ((slot & ~7) | ((slot ^ lane) & 7)) << 4;
#pragma unroll
          for (int mt = 0; mt < 4; ++mt) {
            const bf16x8 kf = *reinterpret_cast<const bf16x8*>(Ks + (mt * 16 + r16) * 384 + so);
            s[mt][0] = __builtin_amdgcn_mfma_f32_16x16x32_bf16(kf, qf[0][ks], s[mt][0], 0, 0, 0);
            s[mt][1] = __builtin_amdgcn_mfma_f32_16x16x32_bf16(kf, qf[1][ks], s[mt][1], 0, 0, 0);
          }
        }
        if (t == 0) {
#pragma unroll
          for (int mt = 1; mt < 4; ++mt) { s[mt][0] = (f32x4){-1e30f, -1e30f, -1e30f, -1e30f}; s[mt][1] = s[mt][0]; }
        }
#pragma unroll
        for (int nt = 0; nt < 2; ++nt) {
          float mx = -1e30f;
#pragma unroll
          for (int mt = 0; mt < 4; ++mt)
#pragma unroll
            for (int r = 0; r < 4; ++r) mx = fmaxf(mx, s[mt][nt][r]);
          mx = fmaxf(mx, __shfl_xor(mx, 16, 64));
          mx = fmaxf(mx, __shfl_xor(mx, 32, 64));
          const float mn = fmaxf(mrun[nt], mx);
          const float alpha = __builtin_amdgcn_exp2f(mrun[nt] - mn);
          mrun[nt] = mn;
          float rs = 0.f;
#pragma unroll
          for (int mt = 0; mt < 4; ++mt)
#pragma unroll
            for (int r = 0; r < 4; ++r) { const float pv = __builtin_amdgcn_exp2f(s[mt][nt][r] - mn); s[mt][nt][r] = pv; rs += pv; }
          lrun[nt] = lrun[nt] * alpha + rs;
#pragma unroll
          for (int a = 0; a < 8; ++a) o[a][nt] *= alpha;
#pragma unroll
          for (int k2 = 0; k2 < 2; ++k2) {
            const uint2 lo = pack4bf(s[2 * k2][nt][0], s[2 * k2][nt][1], s[2 * k2][nt][2], s[2 * k2][nt][3]);
            const uint2 hi = pack4bf(s[2 * k2 + 1][nt][0], s[2 * k2 + 1][nt][1], s[2 * k2 + 1][nt][2], s[2 * k2 + 1][nt][3]);
            u32x4 pk; pk[0] = lo.x; pk[1] = lo.y; pk[2] = hi.x; pk[3] = hi.y;
            pb[k2][nt] = __builtin_bit_cast(bf16x8, pk);
          }
        }
      }
      if (t + 1 < ntiles) asm volatile("s_waitcnt vmcnt(6)\n\ts_barrier" ::: "memory");
      else asm volatile("s_waitcnt vmcnt(0)\n\ts_barrier" ::: "memory");
      if (t < my_ntiles) {
#pragma unroll
        for (int k2 = 0; k2 < 2; ++k2) {
          const int sa = ((8 * k2 + g) ^ (r16 & 14)) << 3;
          const int sb = ((8 * k2 + 4 + g) ^ (r16 & 14)) << 3;
#pragma unroll
          for (int a = 0; a < 8; ++a) {
            const uint2 va = *reinterpret_cast<const uint2*>(Vs + (a * 16 + r16) * 128 + sa);
            const uint2 vb = *reinterpret_cast<const uint2*>(Vs + (a * 16 + r16) * 128 + sb);
            u32x4 pk; pk[0] = va.x; pk[1] = va.y; pk[2] = vb.x; pk[3] = vb.y;
            const bf16x8 vf = __builtin_bit_cast(bf16x8, pk);
            o[a][0] = __builtin_amdgcn_mfma_f32_16x16x32_bf16(vf, pb[k2][0], o[a][0], 0, 0, 0);
            o[a][1] = __builtin_amdgcn_mfma_f32_16x16x32_bf16(vf, pb[k2][1], o[a][1], 0, 0, 0);
          }
        }
      }
      asm volatile("s_waitcnt vmcnt(0)\n\ts_waitcnt lgkmcnt(0)\n\ts_barrier" ::: "memory");
    }
#pragma unroll
    for (int nt = 0; nt < 2; ++nt) {
      float l = lrun[nt];
      l += __shfl_xor(l, 16, 64);
      l += __shfl_xor(l, 32, 64);
      const float il = 1.0f / l;
      const int pos = qbase + 32 * w + 16 * nt + r16;
      float sq = 0.f;
#pragma unroll
      for (int a = 0; a < 8; ++a) { const f32x4 v = o[a][nt] * il; sq += v[0] * v[0] + v[1] * v[1] + v[2] * v[2] + v[3] * v[3]; }
      sq += __shfl_xor(sq, 16, 64);
      sq += __shfl_xor(sq, 32, 64);
      if (STORE && (!meta || pos < NM)) {
        bf16_t* dst = p.qf + (size_t)(b * L + pos) * 768 + h * 192 + 4 * g;
#pragma unroll
        for (int a = 0; a < 8; ++a) {
          const f32x4 v = o[a][nt] * il;
          *reinterpret_cast<uint2*>(dst + a * 16) = pack4bf(v[0], v[1], v[2], v[3]);
        }
        if (g == 0) p.ossq[(size_t)(b * L + pos) * 4 + h] = sq;
      }
    }
  }
}
__device__ __forceinline__ void ph_rwkv_pre(const Params& p, char* smem, int bid, int nb) {
  const int lane = threadIdx.x & 63, wv = threadIdx.x >> 6, g = lane >> 4, r16 = lane & 15;
  char* my = smem + wv * 16384;
  char* At = my;
  char* Bt = my + 2048;
  char* Kt = my + 4096;
  char* Rt = my + 6144;
  char* AtT = my + 8192;
  char* VtT = my + 10240;
  char* BhT = my + 12288;
  char* KhT = my + 14336;
  const int nitems = NB_ * 8 * NCH;
  for (int wi = bid * 4 + wv; wi < nitems; wi += nb * 4) {
    const int chunk = wi % NCH, bh = wi / NCH, b = bh >> 3, h = bh & 7;
    float btv[16], ktv[16];
    unsigned atp[8], vtp[8];
    float cum = 0.f;
    const size_t o0 = ((size_t)b * L + chunk * 16) * 512 + h * 64 + lane;
#pragma unroll
    for (int t = 0; t < 16; ++t) {
      const size_t o = o0 + (size_t)t * 512;
      const float lw = bf2f(p.rlw[o]);
      const float gp = __expf(cum);
      cum += lw;
      const float gc = __expf(cum), ig = __expf(-cum);
      const float av = -bf2f(p.rkk[o]) * gp;
      const float bv = bf2f(p.rbb[o]) * ig;
      const float kv = bf2f(p.rk2[o]) * ig;
      const float rv = bf2f(p.rr[o]) * gc;
      const bf16_t vb = p.rv[o];
      btv[t] = bv; ktv[t] = kv;
      const bf16_t ab = f2bf(av);
      *reinterpret_cast<bf16_t*>(At + t * 128 + lane * 2) = ab;
      *reinterpret_cast<bf16_t*>(Bt + t * 128 + lane * 2) = f2bf(bv);
      *reinterpret_cast<bf16_t*>(Kt + t * 128 + lane * 2) = f2bf(kv);
      *reinterpret_cast<bf16_t*>(Rt + t * 128 + lane * 2) = f2bf(rv);
      if (t & 1) { atp[t >> 1] |= (unsigned)ab << 16; vtp[t >> 1] |= (unsigned)vb << 16; }
      else { atp[t >> 1] = ab; vtp[t >> 1] = vb; }
    }
    const float gC = __expf(cum);
    p.cd_gc[(size_t)wi * 64 + lane] = gC;
    {
      u32x4 w0, w1;
#pragma unroll
      for (int q = 0; q < 4; ++q) { w0[q] = atp[q]; w1[q] = atp[4 + q]; }
      *reinterpret_cast<u32x4*>(AtT + lane * 32) = w0; *reinterpret_cast<u32x4*>(AtT + lane * 32 + 16) = w1;
#pragma unroll
      for (int q = 0; q < 4; ++q) { w0[q] = vtp[q]; w1[q] = vtp[4 + q]; }
      *reinterpret_cast<u32x4*>(VtT + lane * 32) = w0; *reinterpret_cast<u32x4*>(VtT + lane * 32 + 16) = w1;
#pragma unroll
      for (int q = 0; q < 4; ++q) {
        w0[q] = (unsigned)f2bf(btv[2 * q] * gC) | ((unsigned)f2bf(btv[2 * q + 1] * gC) << 16);
        w1[q] = (unsigned)f2bf(btv[8 + 2 * q] * gC) | ((unsigned)f2bf(btv[8 + 2 * q + 1] * gC) << 16);
      }
      *reinterpret_cast<u32x4*>(BhT + lane * 32) = w0; *reinterpret_cast<u32x4*>(BhT + lane * 32 + 16) = w1;
#pragma unroll
      for (int q = 0; q < 4; ++q) {
        w0[q] = (unsigned)f2bf(ktv[2 * q] * gC) | ((unsigned)f2bf(ktv[2 * q + 1] * gC) << 16);
        w1[q] = (unsigned)f2bf(ktv[8 + 2 * q] * gC) | ((unsigned)f2bf(ktv[8 + 2 * q + 1] * gC) << 16);
      }
      *reinterpret_cast<u32x4*>(KhT + lane * 32) = w0; *reinterpret_cast<u32x4*>(KhT + lane * 32 + 16) = w1;
    }
    __builtin_amdgcn_wave_barrier();
    f32x4 mab = {0.f, 0.f, 0.f, 0.f}, mak = mab, nbr = mab, nkr = mab;
#pragma unroll
    for (int ks = 0; ks < 2; ++ks) {
      const int off = r16 * 128 + ks * 64 + g * 16;
      const bf16x8 fa = *reinterpret_cast<const bf16x8*>(At + off);
      const bf16x8 fb = *reinterpret_cast<const bf16x8*>(Bt + off);
      const bf16x8 fk = *reinterpret_cast<const bf16x8*>(Kt + off);
      const bf16x8 fr = *reinterpret_cast<const bf16x8*>(Rt + off);
      mab = MFMA32(fb, fa, mab); mak = MFMA32(fk, fa, mak);
      nbr = MFMA32(fb, fr, nbr); nkr = MFMA32(fk, fr, nkr);
    }
#pragma unroll
    for (int r = 0; r < 4; ++r) {
      const int sidx = 4 * g + r;
      if (!(sidx < r16)) { mab[r] = 0.f; mak[r] = 0.f; }
      if (!(sidx <= r16)) { nbr[r] = 0.f; nkr[r] = 0.f; }
    }
    float Tc[16];
#pragma unroll
    for (int sidx = 15; sidx >= 0; --sidx) {
      float acc = (r16 == sidx) ? 1.0f : 0.0f;
#pragma unroll
      for (int u = sidx + 1; u < 16; ++u) {
        const float m = __int_as_float(__builtin_amdgcn_readlane(__float_as_int(mab[sidx & 3]), 16 * (sidx >> 2) + u));
        acc += m * Tc[u];
      }
      Tc[sidx] = acc;
    }
    f32x4 tqf;
#pragma unroll
    for (int r = 0; r < 4; ++r) tqf[r] = g == 0 ? Tc[r] : (g == 1 ? Tc[4 + r] : (g == 2 ? Tc[8 + r] : Tc[12 + r]));
    const bf16x4 tq = pk4(tqf);
    const bf16x4 makA = pk4(mak), nbrA = pk4(nbr), nkrA = pk4(nkr);
    f32x4 ah[4], qm[4], wt[4], zt[4];
    bf16x4 vfr[4];
#pragma unroll
    for (int q = 0; q < 4; ++q) {
      const f32x4 z4 = {0.f, 0.f, 0.f, 0.f};
      const bf16x4 atf = *reinterpret_cast<const bf16x4*>(AtT + (16 * q + r16) * 32 + g * 8);
      vfr[q] = *reinterpret_cast<const bf16x4*>(VtT + (16 * q + r16) * 32 + g * 8);
      ah[q] = MFMA16(tq, atf, z4);
      const f32x4 xt = MFMA16(makA, vfr[q], z4);
      wt[q] = MFMA16(tq, pk4(xt), z4);
      qm[q] = MFMA16(nbrA, pk4(ah[q]), z4);
      zt[q] = MFMA16(nbrA, pk4(wt[q]), z4);
      zt[q] = MFMA16(nkrA, vfr[q], zt[q]);
    }
    unsigned char* oah = p.cd_ah + (size_t)wi * 2048;
    unsigned char* oqm = p.cd_qm + (size_t)wi * 2048;
    unsigned char* obk = p.cd_bk + (size_t)wi * 4096;
    unsigned char* owt = p.cd_wt + (size_t)wi * 2048;
    unsigned char* ozt = p.cd_zt + (size_t)wi * 2048;
    unsigned char* ovb = p.cd_vb + (size_t)wi * 2048;
#pragma unroll
    for (int q = 0; q < 4; ++q) {
      *reinterpret_cast<bf16x4*>(owt + (q * 64 + lane) * 8) = pk4(wt[q]);
      *reinterpret_cast<bf16x4*>(ozt + (q * 64 + lane) * 8) = pk4(zt[q]);
      *reinterpret_cast<bf16x4*>(ovb + (q * 64 + lane) * 8) = vfr[q];
      const u32x2 bh2 = *reinterpret_cast<const u32x2*>(BhT + (16 * q + r16) * 32 + g * 8);
      const u32x2 kh2 = *reinterpret_cast<const u32x2*>(KhT + (16 * q + r16) * 32 + g * 8);
      u32x4 bk; bk[0] = bh2[0]; bk[1] = bh2[1]; bk[2] = kh2[0]; bk[3] = kh2[1];
      *reinterpret_cast<u32x4*>(obk + (q * 64 + lane) * 16) = bk;
    }
    __builtin_amdgcn_wave_barrier();
#pragma unroll
    for (int q = 0; q < 4; ++q)
#pragma unroll
      for (int r = 0; r < 4; ++r) *reinterpret_cast<bf16_t*>(Bt + (4 * g + r) * 128 + (16 * q + r16) * 2) = f2bf(ah[q][r]);
    __builtin_amdgcn_wave_barrier();
#pragma unroll
    for (int ks = 0; ks < 2; ++ks) {
      const u32x2 lo = *reinterpret_cast<const u32x2*>(Bt + r16 * 128 + (32 * ks + 4 * g) * 2);
      const u32x2 hi = *reinterpret_cast<const u32x2*>(Bt + r16 * 128 + (32 * ks + 16 + 4 * g) * 2);
      u32x4 v; v[0] = lo[0]; v[1] = lo[1]; v[2] = hi[0]; v[3] = hi[1];
      *reinterpret_cast<u32x4*>(oah + (ks * 64 + lane) * 16) = v;
    }
    __builtin_amdgcn_wave_barrier();
#pragma unroll
    for (int q = 0; q < 4; ++q)
#pragma unroll
      for (int r = 0; r < 4; ++r) *reinterpret_cast<bf16_t*>(Bt + (4 * g + r) * 128 + (16 * q + r16) * 2) = f2bf(qm[q][r]);
    __builtin_amdgcn_wave_barrier();
#pragma unroll
    for (int ks = 0; ks < 2; ++ks) {
      const int o1 = r16 * 128 + (32 * ks + 4 * g) * 2, o2 = r16 * 128 + (32 * ks + 16 + 4 * g) * 2;
      const f32x4 a1 = unpk4(*reinterpret_cast<const u32x2*>(Bt + o1)) + unpk4(*reinterpret_cast<const u32x2*>(Rt + o1));
      const f32x4 a2 = unpk4(*reinterpret_cast<const u32x2*>(Bt + o2)) + unpk4(*reinterpret_cast<const u32x2*>(Rt + o2));
      const uint2 lo = pack4bf(a1[0], a1[1], a1[2], a1[3]), hi = pack4bf(a2[0], a2[1], a2[2], a2[3]);
      u32x4 v; v[0] = lo.x; v[1] = lo.y; v[2] = hi.x; v[3] = hi.y;
      *reinterpret_cast<u32x4*>(oqm + (ks * 64 + lane) * 16) = v;
    }
    __builtin_amdgcn_wave_barrier();
  }
}
__device__ __forceinline__ void ph_rwkv_pq(const Params& p, int bid, int nb) {
  const int lane = threadIdx.x & 63, wv = threadIdx.x >> 6;
  const int nitems = NB_ * 8 * NCH;
  for (int wi = bid * 4 + wv; wi < nitems; wi += nb * 4) {
    const int chunk = wi % NCH, bh = wi / NCH, b = bh >> 3, h = bh & 7;
    const size_t o0 = ((size_t)b * L + chunk * 16) * 512 + h * 64 + lane;
    float pdv[16];
    const float rkc = p.r_k[h * 64 + lane];
#pragma unroll
    for (int t = 0; t < 16; ++t) { const size_t o = o0 + (size_t)t * 512; pdv[t] = bf2f(p.rr[o]) * bf2f(p.rk2[o]) * rkc; }
    const float s3l = tr_reduce16(pdv, lane);
    const float lnw = p.ln_w[h * 64 + lane], lnb = p.ln_b[h * 64 + lane];
    bf16_t gtv[16], vtv[16];
#pragma unroll
    for (int t = 0; t < 16; ++t) { const size_t o = o0 + (size_t)t * 512; gtv[t] = p.rg[o]; vtv[t] = p.rv[o]; }
#pragma unroll
    for (int t = 0; t < 16; ++t) {
      const float s3 = __int_as_float(__builtin_amdgcn_readlane(__float_as_int(s3l), 4 * t));
      const size_t o = o0 + (size_t)t * 512;
      const float gt = bf2f(gtv[t]), vt_ = bf2f(vtv[t]);
      p.rlw[o] = f2bf(lnw * gt);
      p.rbb[o] = f2bf((lnb + s3 * vt_) * gt);
    }
  }
}
struct ChainRegs { u32x4 s0, s1; u32x2 wt, zt, vb, pp, qq; float gcs; };
__device__ __forceinline__ void chain_load(const Params& p, int wi, unsigned ytok, int it, int lane, ChainRegs& c) {
  const unsigned char* q0 = (it < 2 ? p.cd_ah : p.cd_qm) + (size_t)wi * 2048 + (it & 1) * 1024;
  c.gcs = p.cd_gc[(size_t)wi * 64 + lane];
  c.s0 = *reinterpret_cast<const u32x4*>(q0 + lane * 16);
  c.s1 = *reinterpret_cast<const u32x4*>(p.cd_bk + (size_t)wi * 4096 + it * 1024 + lane * 16);
  c.wt = *reinterpret_cast<const u32x2*>(p.cd_wt + (size_t)wi * 2048 + (it * 64 + lane) * 8);
  c.zt = *reinterpret_cast<const u32x2*>(p.cd_zt + (size_t)wi * 2048 + (it * 64 + lane) * 8);
  c.vb = *reinterpret_cast<const u32x2*>(p.cd_vb + (size_t)wi * 2048 + (it * 64 + lane) * 8);
  c.pp = *reinterpret_cast<const u32x2*>(p.rlw + ytok);
  c.qq = *reinterpret_cast<const u32x2*>(p.rbb + ytok);
}
__device__ __forceinline__ void chain_publish(char* sh, int it, int lane, const ChainRegs& c) {
  *reinterpret_cast<u32x4*>(sh + it * 1024 + lane * 16) = c.s0;
  *reinterpret_cast<u32x4*>(sh + 4096 + it * 1024 + lane * 16) = c.s1;
  if (it == 0) reinterpret_cast<float*>(sh + 8192)[lane] = c.gcs;
}
__device__ __forceinline__ float dpp_sum16(float v) {
  v += __int_as_float(__builtin_amdgcn_update_dpp(0, __float_as_int(v), 0xB1, 0xF, 0xF, true));
  v += __int_as_float(__builtin_amdgcn_update_dpp(0, __float_as_int(v), 0x4E, 0xF, 0xF, true));
  v += __int_as_float(__builtin_amdgcn_update_dpp(0, __float_as_int(v), 0x141, 0xF, 0xF, true));
  v += __int_as_float(__builtin_amdgcn_update_dpp(0, __float_as_int(v), 0x140, 0xF, 0xF, true));
  return v;
}
template <bool STORE>
__device__ __forceinline__ void chain_finalize(const Params& p, const char* otile, unsigned ytok, u32x2 pp, u32x2 qq) {
  const int tid = threadIdx.x;
  const f32x4 o4 = *reinterpret_cast<const f32x4*>(otile + (tid >> 4) * 256 + (tid & 15) * 16);
  const float s1 = dpp_sum16(o4[0] + o4[1] + o4[2] + o4[3]);
  const float s2 = dpp_sum16(o4[0] * o4[0] + o4[1] * o4[1] + o4[2] * o4[2] + o4[3] * o4[3]);
  const float mean = s1 * (1.0f / 64);
  const float var = fmaxf(s2 * (1.0f / 64) - mean * mean, 0.0f);
  const float istd = rsqrtf(var + 64e-5f);
  const f32x4 y = (o4 - mean) * istd * unpk4(pp) + unpk4(qq);
  if (STORE) *reinterpret_cast<uint2*>(p.rkk + ytok) = pack4bf(y[0], y[1], y[2], y[3]);
  else asm volatile("" :: "v"(y[0]), "v"(y[1]), "v"(y[2]), "v"(y[3]));
}
template <bool STORE>
__device__ __forceinline__ void chain_step(const Params& p, char* otile, const char* otile_prev, bool have_prev, unsigned ytok_prev, u32x2 pp_prev, u32x2 qq_prev,
                                           const char* sh, char* shn, int it, int lane,
                                           const ChainRegs& c, const ChainRegs& cn, f32x4 (&st)[4]) {
  const int g = lane >> 4, r16 = lane & 15;
  const float* gcur = reinterpret_cast<const float*>(sh + 8192);
  u32x4 s0, s1;
  {
    const uint2 a = pack4bf(st[0][0], st[0][1], st[0][2], st[0][3]), b = pack4bf(st[1][0], st[1][1], st[1][2], st[1][3]);
    const uint2 cc = pack4bf(st[2][0], st[2][1], st[2][2], st[2][3]), d = pack4bf(st[3][0], st[3][1], st[3][2], st[3][3]);
    s0[0] = a.x; s0[1] = a.y; s0[2] = b.x; s0[3] = b.y;
    s1[0] = cc.x; s1[1] = cc.y; s1[2] = d.x; s1[3] = d.y;
  }
  const bf16x8 sb0 = __builtin_bit_cast(bf16x8, s0), sb1 = __builtin_bit_cast(bf16x8, s1);
  f32x4 ut = unpk4(c.wt), ot = unpk4(c.zt);
  ut = MFMA32(*reinterpret_cast<const bf16x8*>(sh + lane * 16), sb0, ut);
  ot = MFMA32(*reinterpret_cast<const bf16x8*>(sh + 2048 + lane * 16), sb0, ot);
  ut = MFMA32(*reinterpret_cast<const bf16x8*>(sh + 1024 + lane * 16), sb1, ut);
  ot = MFMA32(*reinterpret_cast<const bf16x8*>(sh + 3072 + lane * 16), sb1, ot);
  chain_publish(shn, it, lane, cn);
  if (have_prev) chain_finalize<STORE>(p, otile_prev, ytok_prev, pp_prev, qq_prev);
#pragma unroll
  for (int r = 0; r < 4; ++r) *reinterpret_cast<float*>(otile + (4 * g + r) * 256 + (16 * it + r16) * 4) = ot[r];
  const uint2 u2 = pack4bf(ut[0], ut[1], ut[2], ut[3]);
  u32x4 uv; uv[0] = u2.x; uv[1] = u2.y; uv[2] = c.vb[0]; uv[3] = c.vb[1];
  const bf16x8 uvb = __builtin_bit_cast(bf16x8, uv);
#pragma unroll
  for (int q = 0; q < 4; ++q)
    st[q] = MFMA32(*reinterpret_cast<const bf16x8*>(sh + 4096 + q * 1024 + lane * 16), uvb, st[q] * *reinterpret_cast<const f32x4*>(gcur + 16 * q + 4 * g));
  __syncthreads();
}
template <bool STORE = true>
__device__ __forceinline__ void ph_chain(const Params& p, char* smem, int bid, int nb) {
  const int tid = threadIdx.x, lane = tid & 63, it = tid >> 6;
  char* shb = smem + 8192;
  for (int bh = bid; bh < NB_ * 8; bh += nb) {
    f32x4 st[4];
#pragma unroll
    for (int q = 0; q < 4; ++q) st[q] = (f32x4){0.f, 0.f, 0.f, 0.f};
    const int w0 = bh * NCH;
    const int b = bh >> 3, h = bh & 7;
    const unsigned y0 = (unsigned)((b * L + (tid >> 4)) * 512 + h * 64 + (tid & 15) * 4);
    ChainRegs c0, c1, c2, c3, c4, c5, c6, c7;
#define CH_LOAD(cc, set) chain_load(p, w0 + min((cc), NCH - 1), y0 + (unsigned)min((cc), NCH - 1) * 8192u, it, lane, set)
    CH_LOAD(0, c0); CH_LOAD(1, c1); CH_LOAD(2, c2); CH_LOAD(3, c3); CH_LOAD(4, c4); CH_LOAD(5, c5); CH_LOAD(6, c6); CH_LOAD(7, c7);
    __syncthreads();
    chain_publish(shb, it, lane, c0);
    __syncthreads();
    u32x2 ppp = {0u, 0u}, qqp = {0u, 0u};
#define CH_STEP(cc, cur, nxt) { const int par = (cc) & 1; \
      chain_step<STORE>(p, smem + par * 4096, smem + (1 - par) * 4096, (cc) > 0, y0 + (unsigned)((cc) - 1) * 8192u, ppp, qqp, \
                        shb + par * 8448, shb + (1 - par) * 8448, it, lane, cur, nxt, st); \
      ppp = cur.pp; qqp = cur.qq; CH_LOAD((cc) + 8, cur); }
    for (int ch = 0; ch < 128; ch += 8) {
      CH_STEP(ch, c0, c1) CH_STEP(ch + 1, c1, c2) CH_STEP(ch + 2, c2, c3) CH_STEP(ch + 3, c3, c4)
      CH_STEP(ch + 4, c4, c5) CH_STEP(ch + 5, c5, c6) CH_STEP(ch + 6, c6, c7) CH_STEP(ch + 7, c7, c0)
    }
    CH_STEP(128, c0, c1)
#undef CH_STEP
#undef CH_LOAD
    chain_finalize<STORE>(p, smem + ((NCH - 1) & 1) * 4096, y0 + (unsigned)(NCH - 1) * 8192u, ppp, qqp);
    __syncthreads();
  }
}
__device__ __forceinline__ void ph_tabconv(const Params& p, int bid, int nb) {
  const int nvec = 2 * 16384 * 256;
  const int stride = nb * NTHR;
  for (int base = bid * NTHR + threadIdx.x; base < nvec; base += 8 * stride) {
    f32x4 v[8];
#pragma unroll
    for (int k = 0; k < 8; ++k) {
      const int i = min(base + k * stride, nvec - 1);
      const bool tab = i >= 16384 * 256;
      v[k] = *reinterpret_cast<const f32x4*>((tab ? p.pv : p.pu) + (size_t)(tab ? i - 16384 * 256 : i) * 4);
    }
#pragma unroll
    for (int k = 0; k < 8; ++k) {
      const int i = min(base + k * stride, nvec - 1);
      const bool tab = i >= 16384 * 256;
      f32x4 w = v[k] * (tab ? 16.0f : 256.0f);
      if (!tab) w *= *reinterpret_cast<const f32x4*>(p.g_ffn + (i & 255) * 4);
      int wv = __builtin_amdgcn_cvt_pk_fp8_f32(w[0], w[1], 0, false);
      wv = __builtin_amdgcn_cvt_pk_fp8_f32(w[2], w[3], wv, true);
      *reinterpret_cast<unsigned*>((tab ? p.v8 : p.u8) + (size_t)(tab ? i - 16384 * 256 : i) * 4) = (unsigned)wv;
    }
  }
}
__device__ __forceinline__ void ph_outproj(const Params& p, char* smem, int bid, int nb) {
  const int lane = threadIdx.x & 63, w = threadIdx.x >> 6, wm = w >> 1, wn = w & 1, g = lane >> 4, r16 = lane & 15;
  for_tiles_xcd(TR / 128, 4, bid, nb, [&](int tm, int tn) {
    const int m0 = tm * 128, n0 = tn * 256;
    f32x4 acc[4][8];
    gemm_tile_wide(smem, m0, n0, 32,
        [&](int r, int k) {
          const size_t tt = (size_t)rt2tt(r);
          return k < 512 ? p.qf + tt * 768 + (k >> 7) * 192 + (k & 127) : p.rkk + tt * 512 + (k - 512);
        },
        [&](int n, int k) { return p.w_outT + (size_t)n * 1024 + k; }, acc,
        [&](int kt, f32x4 (&a)[4][8]) {
          if (kt == 16) {
#pragma unroll
            for (int i = 0; i < 4; ++i) {
              const f32x4 q4 = *reinterpret_cast<const f32x4*>(p.ossq + (size_t)rt2tt(m0 + wm * 64 + 16 * i + r16) * 4);
              const float rs = rsqrtf((q4[0] + q4[1] + q4[2] + q4[3]) * (1.0f / 512) + RMS_EPS);
#pragma unroll
              for (int j = 0; j < 8; ++j) a[i][j] *= rs;
            }
          }
        });
#pragma unroll 1
    for (int half = 0; half < 2; ++half) {
      stage_acc_half(smem, acc, half);
#pragma unroll 1
      for (int qb = 0; qb < 8; qb += 4) {
      f32x4 hh[4][2];
#pragma unroll
      for (int qi = 0; qi < 4; ++qi) {
        const int c = threadIdx.x + 256 * (qb + qi);
        const float* hr = hrow(p, rt2tt(m0 + (c >> 4))) + n0 + half * 128 + (c & 15) * 8;
        hh[qi][0] = *reinterpret_cast<const f32x4*>(hr); hh[qi][1] = *reinterpret_cast<const f32x4*>(hr + 4);
      }
#pragma unroll
      for (int qi = 0; qi < 4; ++qi) {
        const int q = qb + qi;
        const int c = threadIdx.x + 256 * q;
        const int row = c >> 4, col8 = (c & 15) * 8;
        const int m = m0 + row, n = n0 + half * 128 + col8;
        const f32x4 h0 = hh[qi][0], h1 = hh[qi][1];
        float v[8];
        ld8(smem, row, col8, v);
        float sq = 0.f;
#pragma unroll
        for (int e = 0; e < 8; ++e) { v[e] += e < 4 ? h0[e] : h1[e - 4]; sq += v[e] * v[e]; }
        f32x4 o0, o1;
#pragma unroll
        for (int e = 0; e < 4; ++e) { o0[e] = v[e]; o1[e] = v[4 + e]; }
        *reinterpret_cast<f32x4*>(p.out + (size_t)m * D + n) = o0;
        *reinterpret_cast<f32x4*>(p.out + (size_t)m * D + n + 4) = o1;
        st8f(p.h2b + (size_t)m * D + n, v);
        sq += __shfl_xor(sq, 1, 64); sq += __shfl_xor(sq, 2, 64); sq += __shfl_xor(sq, 4, 64); sq += __shfl_xor(sq, 8, 64);
        if ((threadIdx.x & 15) == 0) atomicAdd(p.h2ss + m, sq);
      }
      }
    }
  });
}
#define CE_(a, b) { const int t_ = max(a, b); b = min(a, b); a = t_; }
__device__ __forceinline__ int fkey7(float x, int idx) {
  int b = __float_as_int(x);
  b ^= (b >> 31) & 0x7fffffff;
  return (b & ~127) | (127 - idx);
}
__device__ __forceinline__ float fvalm(int k, int mask) {
  int b = k & ~mask;
  b ^= (b >> 31) & 0x7fffffff;
  return __int_as_float(b);
}
__device__ __forceinline__ void bitonic_sort16(int (&v)[16]) {
#pragma unroll
  for (int k = 2; k <= 16; k <<= 1)
#pragma unroll
    for (int j = k >> 1; j > 0; j >>= 1)
#pragma unroll
      for (int i = 0; i < 16; ++i) {
        const int l = i ^ j;
        if (l > i) {
          if ((i & k) == 0) { CE_(v[i], v[l]); } else { CE_(v[l], v[i]); }
        }
      }
}
__device__ __forceinline__ void bitonic_merge16(int (&v)[16]) {
#pragma unroll
  for (int j = 8; j > 0; j >>= 1)
#pragma unroll
    for (int i = 0; i < 16; ++i) {
      const int l = i ^ j;
      if (l > i) { CE_(v[i], v[l]); }
    }
}
__device__ __forceinline__ void ph_route(const Params& p, char* smem, int bid, int nb) {
  const int tid = threadIdx.x, lane = tid & 63, w = tid >> 6, wm = w >> 1, wn = w & 1, g = lane >> 4, r16 = lane & 15;
  int* L2l = reinterpret_cast<int*>(smem);
  int* Lx = reinterpret_cast<int*>(smem + 8192);
  int* L1l = reinterpret_cast<int*>(smem + 67584);
  for_tiles_xcd(TR / 128, 8, bid, nb, [&](int mt, int h) {
    const int m0 = mt * 128;
    for (int c = 0; c < 2; ++c) {
      f32x4 acc[4][4];
      gemm_tile_glds<true>(smem, m0, (2 * h + c) * 128, 32,
          [&](int r, int k) { return p.h2b + (size_t)r * D + k; },
          [&](int n, int k) { return p.w_qT + (size_t)n * 1024 + k; }, acc);
      float* Et = reinterpret_cast<float*>(smem);
#pragma unroll
      for (int i = 0; i < 4; ++i)
#pragma unroll
        for (int j = 0; j < 4; ++j)
          *reinterpret_cast<f32x4*>(Et + (wm * 64 + 16 * i + r16) * 132 + wn * 64 + 16 * j + 4 * g) = acc[i][j];
      __syncthreads();
      f32x4 sc[2][8];
#pragma unroll
      for (int tt = 0; tt < 2; ++tt)
#pragma unroll
        for (int kt = 0; kt < 8; ++kt) sc[tt][kt] = *reinterpret_cast<const f32x4*>(Et + (32 * w + 16 * tt + r16) * 132 + 16 * kt + 4 * g);
      __syncthreads();
#pragma unroll
      for (int tt = 0; tt < 2; ++tt) {
        int lo[16], hi[16];
#pragma unroll
        for (int kt = 0; kt < 4; ++kt)
#pragma unroll
          for (int r = 0; r < 4; ++r) {
            lo[kt * 4 + r] = fkey7(sc[tt][kt][r], 16 * kt + 4 * g + r);
            hi[kt * 4 + r] = fkey7(sc[tt][kt + 4][r], 16 * (kt + 4) + 4 * g + r);
          }
        bitonic_sort16(lo);
        bitonic_sort16(hi);
#pragma unroll
        for (int i = 0; i < 16; ++i) lo[i] = max(lo[i], hi[15 - i]);
        bitonic_merge16(lo);
#pragma unroll
        for (int st = 16; st <= 32; st <<= 1) {
          int ot[16];
#pragma unroll
          for (int i = 0; i < 16; ++i) ot[i] = __shfl_xor(lo[15 - i], st, 64);
#pragma unroll
          for (int i = 0; i < 16; ++i) lo[i] = max(lo[i], ot[i]);
          bitonic_merge16(lo);
        }
        if (g == 0) {
          int* dst = (c ? L2l : L1l) + (32 * w + 16 * tt + r16) * 16;
#pragma unroll
          for (int q = 0; q < 4; ++q) {
            u32x4 v; v[0] = lo[4 * q]; v[1] = lo[4 * q + 1]; v[2] = lo[4 * q + 2]; v[3] = lo[4 * q + 3];
            *reinterpret_cast<u32x4*>(dst + 4 * q) = v;
          }
        }
      }
      __syncthreads();
    }
    {
      const int tok = tid & 127, half = tid >> 7;
      int k1[16], k2[16];
      float v1[16], v2[16];
#pragma unroll
      for (int q = 0; q < 4; ++q) {
        const u32x4 a = *reinterpret_cast<const u32x4*>(L1l + tok * 16 + 4 * q);
        const u32x4 b = *reinterpret_cast<const u32x4*>(L2l + tok * 16 + 4 * q);
#pragma unroll
        for (int e = 0; e < 4; ++e) { k1[4 * q + e] = (int)a[e]; k2[4 * q + e] = (int)b[e]; }
      }
#pragma unroll
      for (int i = 0; i < 16; ++i) { v1[i] = fvalm(k1[i], 127); v2[i] = fvalm(k2[i], 127); }
      int lst[16];
#pragma unroll
      for (int i = 0; i < 16; ++i) lst[i] = (int)0x80000000;
      if (half == 0) {
#pragma unroll
        for (int a = 0; a < 2; ++a)
#pragma unroll
          for (int b = 0; b < 16 / (a + 1); ++b) {
            int x = __float_as_int(v1[a] + v2[b]);
            x ^= (x >> 31) & 0x7fffffff;
            x = (x & ~255) | (255 - (a * 16 + b));
#pragma unroll
            for (int i = 0; i < 16; ++i) CE_(lst[i], x);
          }
      } else {
#pragma unroll
        for (int a = 2; a < 16; ++a)
#pragma unroll
          for (int b = 0; b < 16 / (a + 1); ++b) {
            int x = __float_as_int(v1[a] + v2[b]);
            x ^= (x >> 31) & 0x7fffffff;
            x = (x & ~255) | (255 - (a * 16 + b));
#pragma unroll
            for (int i = 0; i < 16; ++i) CE_(lst[i], x);
          }
      }
#pragma unroll
      for (int q = 0; q < 4; ++q) {
        u32x4 v; v[0] = lst[4 * q]; v[1] = lst[4 * q + 1]; v[2] = lst[4 * q + 2]; v[3] = lst[4 * q + 3];
        *reinterpret_cast<u32x4*>(Lx + (half * 128 + tok) * 16 + 4 * q) = v;
      }
      __syncthreads();
      int fin[16];
#pragma unroll
      for (int q = 0; q < 4; ++q) {
        const u32x4 o = *reinterpret_cast<const u32x4*>(Lx + ((1 - half) * 128 + tok) * 16 + 4 * q);
#pragma unroll
        for (int e = 0; e < 4; ++e) fin[4 * q + e] = (int)o[e];
      }
#pragma unroll
      for (int i = 0; i < 8; ++i) { const int t_ = fin[i]; fin[i] = fin[15 - i]; fin[15 - i] = t_; }
#pragma unroll
      for (int i = 0; i < 16; ++i) fin[i] = max(fin[i], lst[i]);
      float sv[16], mx = -1e30f;
      const float rs2 = rsqrtf(p.h2ss[m0 + tok] * (1.0f / D) + RMS_EPS);
#pragma unroll
      for (int i = 0; i < 16; ++i) { sv[i] = fvalm(fin[i], 255); mx = fmaxf(mx, sv[i]); }
      float sum = 0.f;
#pragma unroll
      for (int i = 0; i < 16; ++i) { sv[i] = __expf((sv[i] - mx) * rs2); sum += sv[i]; }
      const float isum = 1.0f / sum;
      const size_t ob = (size_t)(m0 + tok) * 128 + h * 16 + half * 8;
#pragma unroll
      for (int i = 0; i < 8; ++i) {
        const int code = 255 - (fin[i] & 255);
        const int a = code >> 4, b = code & 15;
        const int i1 = 127 - (L1l[tok * 16 + a] & 127), i2 = 127 - (L2l[tok * 16 + b] & 127);
        p.pidx[ob + i] = i1 * 128 + i2;
        p.pgate[ob + i] = sv[i] * isum;
      }
    }
    __syncthreads();
  });
}
__device__ __forceinline__ void ph_expert(const Params& p, char* smem, int bid, int nb) {
  const int lane = threadIdx.x & 63, wv = threadIdx.x >> 6;
  const int g3 = lane >> 3, p8 = lane & 7;
  const bool b5 = lane & 32, b4 = lane & 16, b3 = lane & 8;
  unsigned* idxl = reinterpret_cast<unsigned*>(smem + wv * 8192);
  float* al = reinterpret_cast<float*>(smem + wv * 8192 + 4096);
  for (int grp = bid * 4 + wv; grp < TR / 8; grp += nb * 4) {
    const int rt0 = grp * 8;
    float rs2[8];
#pragma unroll
    for (int t = 0; t < 8; ++t) {
      rs2[t] = rsqrtf(p.h2ss[rt0 + t] * (1.0f / D) + RMS_EPS);
      const size_t pb = (size_t)(rt0 + t) * 128;
      idxl[t * 128 + lane] = (unsigned)p.pidx[pb + lane] << 10;
      idxl[t * 128 + 64 + lane] = (unsigned)p.pidx[pb + 64 + lane] << 10;
      al[t * 128 + lane] = p.pgate[pb + lane];
      al[t * 128 + 64 + lane] = p.pgate[pb + 64 + lane];
    }
    __builtin_amdgcn_wave_barrier();
    float dacc[8][2];
#pragma unroll
    for (int t = 0; t < 8; ++t) { dacc[t][0] = 0.f; dacc[t][1] = 0.f; }
#pragma unroll 1
    for (int x = 0; x < 8; ++x) {
      const unsigned coff = 128u * x + 16u * p8;
#pragma unroll 1
      for (int t = 0; t < 8; ++t) {
        f32x2 xp[8];
        {
          const bf16_t* hr = p.h2b + (size_t)(rt0 + t) * D + coff;
          const u32x4 a = *reinterpret_cast<const u32x4*>(hr);
          const u32x4 b = *reinterpret_cast<const u32x4*>(hr + 8);
#pragma unroll
          for (int q = 0; q < 4; ++q) {
            xp[q][0] = __uint_as_float(a[q] << 16); xp[q][1] = __uint_as_float(a[q] & 0xffff0000u);
            xp[4 + q][0] = __uint_as_float(b[q] << 16); xp[4 + q][1] = __uint_as_float(b[q] & 0xffff0000u);
          }
        }
        u32x4 rows[16];
#pragma unroll
        for (int j = 0; j < 16; ++j) {
          const unsigned off = idxl[t * 128 + 8 * j + g3];
          rows[j] = *reinterpret_cast<const u32x4*>(p.u8 + off + coff);
        }
#pragma unroll
        for (int j = 0; j < 16; ++j) {
          f32x2 acc2 = {0.f, 0.f};
#pragma unroll
          for (int q = 0; q < 4; ++q) {
            acc2 += xp[2 * q] * __builtin_amdgcn_cvt_pk_f32_fp8((int)rows[j][q], false);
            acc2 += xp[2 * q + 1] * __builtin_amdgcn_cvt_pk_f32_fp8((int)rows[j][q], true);
          }
          const float sm = dpp_sum8(acc2[0] + acc2[1]);
          if (p8 == (j & 7)) dacc[0][j >> 3] += sm;
        }
        {
          const float r0 = dacc[0][0], r1 = dacc[0][1];
#pragma unroll
          for (int q = 0; q < 7; ++q) { dacc[q][0] = dacc[q + 1][0]; dacc[q][1] = dacc[q + 1][1]; }
          dacc[7][0] = r0; dacc[7][1] = r1;
        }
      }
    }
#pragma unroll
    for (int t = 0; t < 8; ++t)
#pragma unroll
      for (int jj = 0; jj < 2; ++jj) {
        const int slot = 8 * (p8 + 8 * jj) + g3;
        const float dot = dacc[t][jj] * rs2[t] * (1.0f / 256.0f);
        const float gt = al[t * 128 + slot];
        al[t * 128 + slot] = 0.5f * dot * (1.0f + erff(dot * 0.7071067811865476f)) * gt * (1.0f / 16.0f);
      }
    __builtin_amdgcn_wave_barrier();
    float ssq[8];
#pragma unroll
    for (int t = 0; t < 8; ++t) ssq[t] = 0.f;
    const int cw = 8 * (b5 ? 1 : 0) + 4 * (b4 ? 1 : 0) + 2 * (b3 ? 1 : 0);
#pragma unroll 1
    for (int x = 0; x < 8; ++x) {
      const unsigned coff = 128u * x + 16u * p8;
#pragma unroll 1
      for (int t = 0; t < 8; ++t) {
        u32x4 rows[16];
        float av[16];
#pragma unroll
        for (int j = 0; j < 16; ++j) {
          const unsigned off = idxl[t * 128 + 8 * j + g3];
          av[j] = al[t * 128 + 8 * j + g3];
          rows[j] = *reinterpret_cast<const u32x4*>(p.v8 + off + coff);
        }
        f32x2 oa[8];
#pragma unroll
        for (int q = 0; q < 8; ++q) oa[q] = (f32x2){0.f, 0.f};
#pragma unroll
        for (int j = 0; j < 16; ++j) {
          const f32x2 a2 = {av[j], av[j]};
#pragma unroll
          for (int q = 0; q < 4; ++q) {
            oa[2 * q] += a2 * __builtin_amdgcn_cvt_pk_f32_fp8((int)rows[j][q], false);
            oa[2 * q + 1] += a2 * __builtin_amdgcn_cvt_pk_f32_fp8((int)rows[j][q], true);
          }
        }
        f32x2 q4v[4], q2v[2], q1v;
#pragma unroll
        for (int i = 0; i < 4; ++i) {
          const f32x2 sd = b5 ? oa[i] : oa[i + 4], kp = b5 ? oa[i + 4] : oa[i];
          q4v[i][0] = kp[0] + __shfl_xor(sd[0], 32, 64); q4v[i][1] = kp[1] + __shfl_xor(sd[1], 32, 64);
        }
#pragma unroll
        for (int i = 0; i < 2; ++i) {
          const f32x2 sd = b4 ? q4v[i] : q4v[i + 2], kp = b4 ? q4v[i + 2] : q4v[i];
          q2v[i][0] = kp[0] + __shfl_xor(sd[0], 16, 64); q2v[i][1] = kp[1] + __shfl_xor(sd[1], 16, 64);
        }
        {
          const f32x2 sd = b3 ? q2v[0] : q2v[1], kp = b3 ? q2v[1] : q2v[0];
          q1v[0] = kp[0] + __shfl_xor(sd[0], 8, 64); q1v[1] = kp[1] + __shfl_xor(sd[1], 8, 64);
        }
        float* hp = p.out + (size_t)(rt0 + t) * D + coff + cw;
        const f32x2 h3 = *reinterpret_cast<const f32x2*>(hp) + q1v;
        *reinterpret_cast<f32x2*>(hp) = h3;
        {
          const float r0 = ssq[0] + h3[0] * h3[0] + h3[1] * h3[1];
#pragma unroll
          for (int q = 0; q < 7; ++q) ssq[q] = ssq[q + 1];
          ssq[7] = r0;
        }
      }
    }
    asm volatile("s_waitcnt vmcnt(0)" ::: "memory");
    {
      float rsv[8];
#pragma unroll
      for (int t = 0; t < 8; ++t) rsv[t] = rsqrtf(wave_sum(ssq[t]) * (1.0f / D) + RMS_EPS);
      f32x2 gfv[8];
#pragma unroll
      for (int x = 0; x < 8; ++x) gfv[x] = *reinterpret_cast<const f32x2*>(p.g_fin + 128 * x + 16 * p8 + cw);
      unsigned long long hv[8][8];
#pragma unroll
      for (int t = 0; t < 8; ++t)
#pragma unroll
        for (int x = 0; x < 8; ++x)
          hv[t][x] = __hip_atomic_load(reinterpret_cast<unsigned long long*>(p.out + (size_t)(rt0 + t) * D + 128 * x + 16 * p8 + cw),
                                       __ATOMIC_RELAXED, __HIP_MEMORY_SCOPE_AGENT);
#pragma unroll
      for (int t = 0; t < 8; ++t)
#pragma unroll
        for (int x = 0; x < 8; ++x) {
          f32x2 o2;
          o2[0] = __uint_as_float((unsigned)hv[t][x]) * rsv[t] * gfv[x][0];
          o2[1] = __uint_as_float((unsigned)(hv[t][x] >> 32)) * rsv[t] * gfv[x][1];
          *reinterpret_cast<f32x2*>(p.out + (size_t)(rt0 + t) * D + 128 * x + 16 * p8 + cw) = o2;
        }
    }
    __builtin_amdgcn_wave_barrier();
  }
}

#define XB_TMO      128
#define XB_XCNT(j)  (256  + 64 * (j))
#define XB_XSUB(j)  (1280 + 64 * (j))
#define XB_XGEN(j)  (2304 + 64 * (j))
#define XB_TOP      3328
#define XB_TOPGEN   3392
#define XCD_BAR_WORDS 3456
#define XB_SPIN_CAP (1u << 18)
#define LAS __attribute__((address_space(3)))
__device__ __forceinline__ unsigned xb_ld(unsigned* p) { return __hip_atomic_load(p, __ATOMIC_RELAXED, __HIP_MEMORY_SCOPE_AGENT); }
__device__ __forceinline__ unsigned xb_add(unsigned* p, unsigned v) { return __hip_atomic_fetch_add(p, v, __ATOMIC_RELAXED, __HIP_MEMORY_SCOPE_AGENT); }
__device__ __forceinline__ unsigned xb_xcc_id() { return (unsigned)__builtin_amdgcn_s_getreg((3 << 11) | 20) & 0xFu; }
#define XB_SPIN(cond, bar) do { unsigned _sp = 0; while (cond) { __builtin_amdgcn_s_sleep(1); \
    if ((++_sp & 255u) == 0u) { if (xb_ld(&(bar)[XB_TMO])) break; if (_sp > XB_SPIN_CAP) { atomicAdd(&(bar)[XB_TMO], 1u); break; } } } } while (0)
struct XcdBarrier { unsigned* bar; unsigned x; volatile LAS unsigned* st; };
__device__ __forceinline__ XcdBarrier xcd_barrier_post(unsigned* bar, volatile LAS unsigned* st) {
  XcdBarrier b; b.bar = bar; b.x = xb_xcc_id(); b.st = st;
  if (threadIdx.x == 0) (void)xb_add(&bar[XB_XCNT(b.x)], 1u);
  return b;
}
__device__ __forceinline__ void xcd_barrier_complete(unsigned* bar, unsigned x, unsigned& nloc, unsigned& nx) {
  const unsigned G = gridDim.x * gridDim.y * gridDim.z;
  unsigned sum, cnt, mine, sp = 0u;
  for (;;) {
    sum = 0u; cnt = 0u; mine = 0u;
#pragma unroll
    for (unsigned j = 0; j < 16; ++j) { const unsigned c = xb_ld(&bar[XB_XCNT(j)]); sum += c; cnt += (c > 0u) ? 1u : 0u; mine = (j == x) ? c : mine; }
    if (sum == G) break;
    __builtin_amdgcn_s_sleep(1);
    if ((++sp & 255u) == 0u) { if (xb_ld(&bar[XB_TMO])) break; if (sp > XB_SPIN_CAP) { atomicAdd(&bar[XB_TMO], 1u); break; } }
  }
  nloc = mine > 0u ? mine : 1u; nx = cnt > 0u ? cnt : 1u;
}
__device__ __forceinline__ void xcd_barrier(const XcdBarrier& b) {
  asm volatile("s_waitcnt vmcnt(0)" ::: "memory");
  __syncthreads();
  if (threadIdx.x == 0) {
    unsigned* bar = b.bar;
    __builtin_amdgcn_s_waitcnt(0);
    unsigned nloc = b.st[0], nx = b.st[1];
    if (nloc == 0u) { xcd_barrier_complete(bar, b.x, nloc, nx); b.st[0] = nloc; b.st[1] = nx; }
    const unsigned old = xb_add(&bar[XB_XSUB(b.x)], 1u);
    const unsigned gen = old / nloc;
    if (old + 1u == (gen + 1u) * nloc) {
      __builtin_amdgcn_fence(__ATOMIC_RELEASE, "agent");
      asm volatile("s_waitcnt vmcnt(0)" ::: "memory");
      const unsigned og = xb_add(&bar[XB_TOP], 1u);
      const unsigned tg = og / nx;
      if (og + 1u == (tg + 1u) * nx) xb_add(&bar[XB_TOPGEN], 1u);
      else XB_SPIN(xb_ld(&bar[XB_TOPGEN]) == tg, bar);
      __builtin_amdgcn_fence(__ATOMIC_ACQUIRE, "agent");
      xb_add(&bar[XB_XGEN(b.x)], 1u);
      asm volatile("s_waitcnt vmcnt(0)" ::: "memory");
    } else {
      XB_SPIN(xb_ld(&bar[XB_XGEN(b.x)]) == gen, bar);
      __builtin_amdgcn_fence(__ATOMIC_ACQUIRE, "agent");
      asm volatile("s_waitcnt vmcnt(0)" ::: "memory");
    }
  }
  __syncthreads();
}

constexpr int SMEM_FLOATS = 18944 + 4;


__global__ void __launch_bounds__(NTHR, 2) k_mega(Params p) {
  __shared__ __attribute__((aligned(16))) float smem[SMEM_FLOATS];
  if (threadIdx.x == 0) { smem[18944] = 0.f; smem[18945] = 0.f; smem[18946] = 0.f; smem[18947] = 0.f; }
  __syncthreads();
  const XcdBarrier xb = xcd_barrier_post(p.bar, (volatile LAS unsigned*)&smem[18944]);
  if (p.never) { cg::grid_group grid = cg::this_grid(); grid.sync(); }
  const int bid = blockIdx.x, nb = gridDim.x;
  ph_prep(p, bid, nb);
  xcd_barrier(xb);
  ph_inproj(p, (char*)smem, bid, nb);
  if (nb > 384) { if (bid >= 256) ph_w2(p, (char*)smem, bid - 256, nb - 256); }
  else ph_w2(p, (char*)smem, bid, nb);
  xcd_barrier(xb);
  ph_rwkv_prep(p, (char*)smem, bid, nb);
  ph_q_up(p, (char*)smem, bid, nb);
  ph_kv_up(p, (char*)smem, bid, nb);
  xcd_barrier(xb);
  ph_rwkv_pre(p, (char*)smem, bid, nb);
  ph_rwkv_pq(p, bid, nb);
  xcd_barrier(xb);
  if (bid < 64) ph_chain(p, (char*)smem, bid, 64);
  else { ph_attn(p, (char*)smem, bid - 64, nb - 64); ph_tabconv(p, bid - 64, nb - 64); }
  xcd_barrier(xb);
  ph_outproj(p, (char*)smem, bid, nb);
  xcd_barrier(xb);
  ph_route(p, (char*)smem, bid, nb);
  xcd_barrier(xb);
  ph_expert(p, (char*)smem, bid, nb);
}

extern "C" void kernel_launch(void* const* d_in, const int* in_sizes, int n_in, void* d_out, int out_size, void* d_ws,
                              size_t ws_size, hipStream_t stream) {
  Params p{};
  const float* const* in = reinterpret_cast<const float* const*>(d_in);
  p.x = in[0]; p.meta = in[1]; p.g_mix = in[2]; p.w_in = in[3]; p.g_q = in[4]; p.w_uq = in[5]; p.g_kv = in[6];
  p.w_ukv = in[7]; p.g_out = in[8]; p.mu = in[9]; p.w0 = in[10]; p.w_up = in[11]; p.a0 = in[12]; p.a_up = in[13];
  p.g_up = in[14]; p.k_k = in[15]; p.k_a = in[16]; p.r_k = in[17]; p.ln_w = in[18]; p.ln_b = in[19]; p.w_out = in[20];
  p.g_ffn = in[21]; p.w_q = in[22]; p.subk = in[23]; p.pu = in[24]; p.pv = in[25]; p.g_fin = in[26];
  p.out = (float*)d_out;
  char* ws = (char*)d_ws;
  size_t off = 0;
  auto take = [&](size_t bytes) { char* r = ws + off; off += (bytes + 255) & ~(size_t)255; return r; };
  p.bar = (unsigned*)take((size_t)XCD_BAR_WORDS * 4);
  p.h2ss = (float*)take((size_t)TR * 4);
  const size_t zero_bytes = off;
  p.rstd1 = (float*)take((size_t)T * 4);
  p.ossq = (float*)take((size_t)T * 4 * 4);
  p.w_inT = (bf16_t*)take((size_t)DIN * 1024 * 2);
  p.w_uqT = (bf16_t*)take((size_t)768 * 256 * 2);
  p.w_ukvT = (bf16_t*)take((size_t)1024 * 128 * 2);
  p.w_outT = (bf16_t*)take((size_t)1024 * 1024 * 2);
  p.w_qT = (bf16_t*)take((size_t)2048 * 1024 * 2);
  p.subkb = (bf16_t*)take((size_t)8 * 2 * 128 * 128 * 2);
  p.w_lrT = (bf16_t*)take((size_t)1536 * 128 * 2);
  p.ropec = (float*)take((size_t)L * 32 * 4);
  p.ropes = (float*)take((size_t)L * 32 * 4);
  char* regA = take((size_t)T * DIN * 2);
  char* regB = take((size_t)T * (768 + 1024 + 64) * 2);
  char* regBend = ws + off;
  char* regC = take((size_t)T * 512 * 2 * 7);
  if (off > ws_size) fprintf(stderr, "workspace too small: need %zu have %zu\n", off, ws_size);
  p.proj = (bf16_t*)regA;
  {
    const size_t NW = (size_t)NB_ * 8 * NCH;
    p.cd_qm = (unsigned char*)regA;
    p.cd_wt = p.cd_qm + NW * 2048;
    p.cd_zt = p.cd_wt + NW * 2048;
    p.cd_vb = p.cd_zt + NW * 2048;
    p.cd_bk = (unsigned char*)d_out;
    p.cd_ah = p.cd_bk + NW * 4096;
    p.cd_gc = (float*)(p.cd_ah + NW * 2048);
  }
  p.h2b = (bf16_t*)regA;
  p.pidx = (int*)(regA + (size_t)TR * D * 2);
  p.pgate = (float*)(regA + (size_t)TR * D * 2 + (size_t)TR * 128 * 4);
  p.qf = (bf16_t*)regB;
  p.kn = (bf16_t*)(regB + (size_t)T * 768 * 2);
  p.vt = (bf16_t*)(regB + (size_t)T * (768 + 512) * 2);
  p.kr = (bf16_t*)(regB + (size_t)T * (768 + 1024) * 2);
  p.hb = (bf16_t*)regC;
  p.w_qb = (bf16_t*)(regC + (size_t)40 * 1024 * 1024);
  bf16_t* c = (bf16_t*)regC;
  const size_t a512 = (size_t)T * 512;
  p.rr = c; p.rk2 = c + a512; p.rv = c + 2 * a512; p.rkk = c + 3 * a512; p.rbb = c + 4 * a512; p.rg = c + 5 * a512; p.rlw = c + 6 * a512;
  p.u8 = (unsigned char*)regC;
  p.v8 = p.u8 + (size_t)16384 * 1024;
  static int grid_blocks = 0;
  if (!grid_blocks) {
    int dev = 0, cus = 0, per_cu = 0;
    (void)hipGetDevice(&dev);
    (void)hipDeviceGetAttribute(&cus, hipDeviceAttributeMultiprocessorCount, dev);
    (void)hipOccupancyMaxActiveBlocksPerMultiprocessor(&per_cu, k_mega, NTHR, 0);
    if (per_cu > 2) per_cu = 2;
    grid_blocks = cus * per_cu;
  }
  (void)hipMemsetAsync(p.bar, 0, zero_bytes, stream);
  void* args[] = {&p};
  hipError_t e = hipLaunchCooperativeKernel((void*)k_mega, dim3(grid_blocks), dim3(NTHR), args, 0, stream);
  if (e != hipSuccess) fprintf(stderr, "cooperative launch failed: %s (grid %d)\n", hipGetErrorString(e), grid_blocks);
}
```

```cpp
#include <hip/hip_runtime.h>
#include <hip/hip_cooperative_groups.h>
#include <stdint.h>
#include <stdio.h>
#include <math.h>

constexpr int NB_ = 8, SEQ = 2048, NM = 16, L = 2064, T = NB_ * L, TR = NB_ * SEQ, D = 1024, DIN = 2240;
constexpr int NTHR = 256;
constexpr float RMS_EPS = 1e-6f;
typedef unsigned short bf16_t;
namespace cg = cooperative_groups;

struct Params {
  const float *x, *meta, *g_mix, *w_in, *g_q, *w_uq, *g_kv, *w_ukv, *g_out, *mu, *w0, *w_up, *a0, *a_up, *g_up,
      *k_k, *k_a, *r_k, *ln_w, *ln_b, *w_out, *g_ffn, *w_q, *subk, *pu, *pv, *g_fin;
  float* out;
  float *rstd1;
  float *ossq;
  float *h2ss;
  bf16_t* proj;
  bf16_t *qf, *kn, *vt, *kr;
  float *ropec, *ropes;
  bf16_t *rr, *rk2, *rv, *rkk, *rbb, *rg, *rlw;
  unsigned char *cd_ah, *cd_qm, *cd_bk, *cd_wt, *cd_zt, *cd_vb;
  float* cd_gc;
  bf16_t* h2b;
  int* pidx;
  float* pgate;
  unsigned* bar;
  int never;
  int pad0;
  bf16_t* hb;
  unsigned char *u8, *v8;
  bf16_t *w_inT, *w_uqT, *w_ukvT, *w_outT, *w_qT;
  bf16_t *w_qb;
  bf16_t *subkb;
  bf16_t *w_lrT;
};

typedef float f32x2_cv __attribute__((ext_vector_type(2)));
typedef __bf16 bf16x2_cv __attribute__((ext_vector_type(2)));
__device__ __forceinline__ unsigned pk2bf(float a, float b) {
  const f32x2_cv v = {a, b};
  return __builtin_bit_cast(unsigned, __builtin_convertvector(v, bf16x2_cv));
}
__device__ __forceinline__ bf16_t f2bf(float f) { return (bf16_t)(pk2bf(f, 0.0f) & 0xffffu); }
__device__ __forceinline__ float bf2f(bf16_t h) { return __uint_as_float(((unsigned)h) << 16); }
__device__ __forceinline__ float wave_sum(float v) {
#pragma unroll
  for (int o = 32; o > 0; o >>= 1) v += __shfl_xor(v, o, 64);
  return v;
}
__device__ __forceinline__ const float* hrow(const Params& p, int tt) {
  int b = tt / L, pos = tt - b * L;
  return pos < NM ? p.meta + (size_t)pos * D : p.x + ((size_t)(b * SEQ + pos - NM)) * D;
}
__device__ __forceinline__ int rt2tt(int rt) { return (rt >> 11) * L + NM + (rt & 2047); }

template <class AF, class BF, class EF>
__device__ __forceinline__ void gemm_naive(int M, int N, int K, AF af, BF bf, EF ef, int bid, int nb) {
  const int ncb = (N + 255) / 256;
  const int ntiles = (M / 8) * ncb;
  for (int tile = bid; tile < ntiles; tile += nb) {
    const int r0 = (tile / ncb) * 8;
    const int n = (tile % ncb) * 256 + threadIdx.x;
    if (n < N) {
      float a0 = 0, a1 = 0, a2 = 0, a3 = 0, a4 = 0, a5 = 0, a6 = 0, a7 = 0;
      for (int k = 0; k < K; ++k) {
        const float bv = bf(k, n);
        a0 += af(r0 + 0, k) * bv; a1 += af(r0 + 1, k) * bv; a2 += af(r0 + 2, k) * bv; a3 += af(r0 + 3, k) * bv;
        a4 += af(r0 + 4, k) * bv; a5 += af(r0 + 5, k) * bv; a6 += af(r0 + 6, k) * bv; a7 += af(r0 + 7, k) * bv;
      }
      ef(r0 + 0, n, a0); ef(r0 + 1, n, a1); ef(r0 + 2, n, a2); ef(r0 + 3, n, a3);
      ef(r0 + 4, n, a4); ef(r0 + 5, n, a5); ef(r0 + 6, n, a6); ef(r0 + 7, n, a7);
    }
  }
}


typedef __attribute__((ext_vector_type(8))) short bf16x8;
typedef __attribute__((ext_vector_type(4))) float f32x4;
typedef __attribute__((ext_vector_type(4))) unsigned u32x4;
typedef __attribute__((ext_vector_type(2))) float f32x2;
typedef __attribute__((ext_vector_type(4))) short bf16x4;
typedef __attribute__((ext_vector_type(2))) unsigned u32x2;
constexpr int NCH = 129;

__device__ __forceinline__ uint2 pack4bf(float a, float b, float c, float d) {
  uint2 r;
  r.x = pk2bf(a, b);
  r.y = pk2bf(c, d);
  return r;
}

__device__ __forceinline__ bf16x4 pk4(const f32x4 v) {
  const uint2 t = pack4bf(v[0], v[1], v[2], v[3]);
  u32x2 u; u[0] = t.x; u[1] = t.y;
  return __builtin_bit_cast(bf16x4, u);
}
__device__ __forceinline__ f32x4 unpk4(const u32x2 u) {
  f32x4 r;
  r[0] = __uint_as_float(u[0] << 16); r[1] = __uint_as_float(u[0] & 0xffff0000u);
  r[2] = __uint_as_float(u[1] << 16); r[3] = __uint_as_float(u[1] & 0xffff0000u);
  return r;
}
#define MFMA16(a, b, c) __builtin_amdgcn_mfma_f32_16x16x16bf16_1k(a, b, c, 0, 0, 0)
#define MFMA32(a, b, c) __builtin_amdgcn_mfma_f32_16x16x32_bf16(a, b, c, 0, 0, 0)

__device__ __forceinline__ float dpp_sum8(float v) {
  v += __int_as_float(__builtin_amdgcn_update_dpp(0, __float_as_int(v), 0xB1, 0xF, 0xF, true));
  v += __int_as_float(__builtin_amdgcn_update_dpp(0, __float_as_int(v), 0x4E, 0xF, 0xF, true));
  v += __int_as_float(__builtin_amdgcn_update_dpp(0, __float_as_int(v), 0x141, 0xF, 0xF, true));
  return v;
}
__device__ __forceinline__ float tr_reduce16(const float (&pd)[16], int lane) {
  const bool b5 = lane & 32, b4 = lane & 16, b3 = lane & 8, b2 = lane & 4;
  float q8[8], q4[4], q2[2], q1;
#pragma unroll
  for (int i = 0; i < 8; ++i) { const float sd = b5 ? pd[i] : pd[i + 8], kp = b5 ? pd[i + 8] : pd[i]; q8[i] = kp + __shfl_xor(sd, 32, 64); }
#pragma unroll
  for (int i = 0; i < 4; ++i) { const float sd = b4 ? q8[i] : q8[i + 4], kp = b4 ? q8[i + 4] : q8[i]; q4[i] = kp + __shfl_xor(sd, 16, 64); }
#pragma unroll
  for (int i = 0; i < 2; ++i) { const float sd = b3 ? q4[i] : q4[i + 2], kp = b3 ? q4[i + 2] : q4[i]; q2[i] = kp + __shfl_xor(sd, 8, 64); }
  { const float sd = b2 ? q2[0] : q2[1], kp = b2 ? q2[1] : q2[0]; q1 = kp + __shfl_xor(sd, 4, 64); }
  q1 += __shfl_xor(q1, 2, 64);
  q1 += __shfl_xor(q1, 1, 64);
  return q1;
}

struct NoMid { __device__ __forceinline__ void operator()(int, f32x4 (&)[4][4]) const {} };
template <bool TRANS, bool ZERO = true, bool SPLITA = false, class ALoad, class BLoad, class Mid = NoMid>
__device__ __forceinline__ void gemm_tile(char* smem, int m0, int n0, int kt0, int kt1, ALoad aload, BLoad bload, f32x4 (&acc)[4][4], Mid mid = Mid()) {
  const int tid = threadIdx.x, lane = tid & 63, w = tid >> 6, wm = w >> 1, wn = w & 1;
  const int srow = tid >> 3, sslot = tid & 7;
  const int swz = (sslot ^ (srow & 7)) << 4;
  char* sA = smem;
  char* sB = smem + 32768;
  const int g = lane >> 4, r16 = lane & 15;
  const int fa0 = (wm * 64 + r16) * 128 + (((0 + g) ^ (lane & 7)) << 4);
  const int fa1 = (wm * 64 + r16) * 128 + (((4 + g) ^ (lane & 7)) << 4);
  const int fb0 = (wn * 64 + r16) * 128 + (((0 + g) ^ (lane & 7)) << 4);
  const int fb1 = (wn * 64 + r16) * 128 + (((4 + g) ^ (lane & 7)) << 4);
  u32x4 ra[4], rb[4];
#pragma unroll
  for (int i = 0; i < 4; ++i) {
    ra[i] = aload(m0 + srow + 32 * i, kt0 * 64 + sslot * 8, i);
    rb[i] = bload(n0 + srow + 32 * i, kt0 * 64 + sslot * 8);
  }
  if constexpr (ZERO) {
#pragma unroll
    for (int i = 0; i < 4; ++i)
#pragma unroll
      for (int j = 0; j < 4; ++j) acc[i][j] = (f32x4){0.f, 0.f, 0.f, 0.f};
  }
  __syncthreads();
#pragma unroll
  for (int i = 0; i < 4; ++i) {
    *reinterpret_cast<u32x4*>(sA + (srow + 32 * i) * 128 + swz) = ra[i];
    *reinterpret_cast<u32x4*>(sB + (srow + 32 * i) * 128 + swz) = rb[i];
  }
  __syncthreads();
  for (int kt = kt0; kt < kt1; ++kt) {
    const int cur = ((kt - kt0) & 1) * 16384;
    mid(kt, acc);
    if (kt + 1 < kt1) {
#pragma unroll
      for (int i = 0; i < 4; ++i) {
        if (!SPLITA || i < 2) ra[i] = aload(m0 + srow + 32 * i, (kt + 1) * 64 + sslot * 8, i);
        rb[i] = bload(n0 + srow + 32 * i, (kt + 1) * 64 + sslot * 8);
      }
    }
#pragma unroll
    for (int ks = 0; ks < 2; ++ks) {
      if (SPLITA && ks == 1 && kt + 1 < kt1) {
#pragma unroll
        for (int i = 2; i < 4; ++i) ra[i] = aload(m0 + srow + 32 * i, (kt + 1) * 64 + sslot * 8, i);
      }
      bf16x8 af[4], bfr[4];
#pragma unroll
      for (int i = 0; i < 4; ++i) af[i] = *reinterpret_cast<const bf16x8*>(sA + cur + (ks ? fa1 : fa0) + i * 2048);
#pragma unroll
      for (int j = 0; j < 4; ++j) bfr[j] = *reinterpret_cast<const bf16x8*>(sB + cur + (ks ? fb1 : fb0) + j * 2048);
#pragma unroll
      for (int i = 0; i < 4; ++i)
#pragma unroll
        for (int j = 0; j < 4; ++j) {
          if constexpr (TRANS) acc[i][j] = __builtin_amdgcn_mfma_f32_16x16x32_bf16(bfr[j], af[i], acc[i][j], 0, 0, 0);
          else acc[i][j] = __builtin_amdgcn_mfma_f32_16x16x32_bf16(af[i], bfr[j], acc[i][j], 0, 0, 0);
        }
    }
    if (kt + 1 < kt1) {
      const int nxt = 16384 - cur;
#pragma unroll
      for (int i = 0; i < 4; ++i) {
        *reinterpret_cast<u32x4*>(sA + nxt + (srow + 32 * i) * 128 + swz) = ra[i];
        *reinterpret_cast<u32x4*>(sB + nxt + (srow + 32 * i) * 128 + swz) = rb[i];
      }
    }
    __syncthreads();
  }
}
#define GLDS16(gp, lp) __builtin_amdgcn_global_load_lds((const __attribute__((address_space(1))) void*)(gp), (__attribute__((address_space(3))) void*)(lp), 16, 0, 0)
template <bool TRANS, class APtr, class BPtr, class Mid = NoMid>
__device__ __forceinline__ void gemm_tile_glds(char* smem, int m0, int n0, int nk32, APtr aptr, BPtr bptr, f32x4 (&acc)[4][4], Mid mid = Mid()) {
  const int tid = threadIdx.x, lane = tid & 63, w = tid >> 6, wm = w >> 1, wn = w & 1;
  const int lrow = lane >> 2;
  const int schunk = ((lane & 3) ^ ((lrow >> 2) & 3)) * 8;
  const int wb = (__builtin_amdgcn_readfirstlane(tid) >> 6);
  const int g = lane >> 4, r16 = lane & 15;
  const int fsl = (g ^ ((r16 >> 2) & 3)) << 4;
  const int fa = (wm * 64 + r16) * 64 + fsl;
  const int fb = 8192 + (wn * 64 + r16) * 64 + fsl;
#pragma unroll
  for (int i = 0; i < 4; ++i)
#pragma unroll
    for (int j = 0; j < 4; ++j) acc[i][j] = (f32x4){0.f, 0.f, 0.f, 0.f};
  __syncthreads();
  auto issue = [&](int kt) {
    char* st = smem + (kt & 3) * 16384;
#pragma unroll
    for (int i = 0; i < 2; ++i) {
      const int row = 16 * wb + 64 * i + lrow;
      GLDS16(aptr(m0 + row, kt * 32 + schunk), st + (16 * wb + 64 * i) * 64);
      GLDS16(bptr(n0 + row, kt * 32 + schunk), st + 8192 + (16 * wb + 64 * i) * 64);
    }
  };
  issue(0);
  if (nk32 > 1) issue(1);
  if (nk32 > 2) issue(2);
  for (int kt = 0; kt < nk32; ++kt) {
    if (kt + 2 < nk32) asm volatile("s_waitcnt vmcnt(8)\n\ts_barrier" ::: "memory");
    else if (kt + 1 < nk32) asm volatile("s_waitcnt vmcnt(4)\n\ts_barrier" ::: "memory");
    else asm volatile("s_waitcnt vmcnt(0)\n\ts_barrier" ::: "memory");
    if (kt + 3 < nk32) issue(kt + 3);
    mid(kt, acc);
    const char* st = smem + (kt & 3) * 16384;
    bf16x8 af[4], bfr[4];
#pragma unroll
    for (int i = 0; i < 4; ++i) af[i] = *reinterpret_cast<const bf16x8*>(st + fa + i * 1024);
#pragma unroll
    for (int j = 0; j < 4; ++j) bfr[j] = *reinterpret_cast<const bf16x8*>(st + fb + j * 1024);
#pragma unroll
    for (int i = 0; i < 4; ++i)
#pragma unroll
      for (int j = 0; j < 4; ++j) {
        if constexpr (TRANS) acc[i][j] = __builtin_amdgcn_mfma_f32_16x16x32_bf16(bfr[j], af[i], acc[i][j], 0, 0, 0);
        else acc[i][j] = __builtin_amdgcn_mfma_f32_16x16x32_bf16(af[i], bfr[j], acc[i][j], 0, 0, 0);
      }
  }
  __syncthreads();
}
struct NoMidW { __device__ __forceinline__ void operator()(int, f32x4 (&)[4][8]) const {} };
template <class APtr, class BPtr, class Mid = NoMidW>
__device__ __forceinline__ void gemm_tile_wide(char* smem, int m0, int n0, int nk32, APtr aptr, BPtr bptr, f32x4 (&acc)[4][8], Mid mid = Mid()) {
  const int tid = threadIdx.x, lane = tid & 63, w = tid >> 6, wm = w >> 1, wn = w & 1;
  const int lrow = lane >> 2;
  const int schunk = ((lane & 3) ^ ((lrow >> 2) & 3)) * 8;
  const int wb = (__builtin_amdgcn_readfirstlane(tid) >> 6);
  const int g = lane >> 4, r16 = lane & 15;
  const int fsl = (g ^ ((r16 >> 2) & 3)) << 4;
  const int fa = (wm * 64 + r16) * 64 + fsl;
  const int fb = 8192 + (wn * 128 + r16) * 64 + fsl;
#pragma unroll
  for (int i = 0; i < 4; ++i)
#pragma unroll
    for (int j = 0; j < 8; ++j) acc[i][j] = (f32x4){0.f, 0.f, 0.f, 0.f};
  __syncthreads();
  auto issue = [&](int kt) {
    char* st = smem + (kt % 3) * 24576;
#pragma unroll
    for (int i = 0; i < 2; ++i) GLDS16(aptr(m0 + 16 * wb + 64 * i + lrow, kt * 32 + schunk), st + (16 * wb + 64 * i) * 64);
#pragma unroll
    for (int i = 0; i < 4; ++i) GLDS16(bptr(n0 + 16 * wb + 64 * i + lrow, kt * 32 + schunk), st + 8192 + (16 * wb + 64 * i) * 64);
  };
  issue(0);
  if (nk32 > 1) issue(1);
  for (int kt = 0; kt < nk32; ++kt) {
    if (kt + 1 < nk32) asm volatile("s_waitcnt vmcnt(6)\n\ts_barrier" ::: "memory");
    else asm volatile("s_waitcnt vmcnt(0)\n\ts_barrier" ::: "memory");
    if (kt + 2 < nk32) issue(kt + 2);
    mid(kt, acc);
    const char* st = smem + (kt % 3) * 24576;
    bf16x8 af[4], bfr[8];
#pragma unroll
    for (int i = 0; i < 4; ++i) af[i] = *reinterpret_cast<const bf16x8*>(st + fa + i * 1024);
#pragma unroll
    for (int j = 0; j < 8; ++j) bfr[j] = *reinterpret_cast<const bf16x8*>(st + fb + j * 1024);
#pragma unroll
    for (int i = 0; i < 4; ++i)
#pragma unroll
      for (int j = 0; j < 8; ++j) acc[i][j] = __builtin_amdgcn_mfma_f32_16x16x32_bf16(bfr[j], af[i], acc[i][j], 0, 0, 0);
  }
  __syncthreads();
}
__device__ __forceinline__ void stage_acc_half(char* smem, const f32x4 (&acc)[4][8], int half) {
  const int lane = threadIdx.x & 63, w = threadIdx.x >> 6, wm = w >> 1, wn = w & 1, g = lane >> 4, r16 = lane & 15;
  float* Et = reinterpret_cast<float*>(smem);
  __syncthreads();
  if (wn == half) {
#pragma unroll
    for (int i = 0; i < 4; ++i)
#pragma unroll
      for (int j = 0; j < 8; ++j)
        *reinterpret_cast<f32x4*>(Et + (wm * 64 + 16 * i + r16) * 132 + 16 * j + 4 * g) = acc[i][j];
  }
  __syncthreads();
}
template <class Body>
__device__ __forceinline__ void for_tiles_xcd(int MT, int NT, int bid, int nb, Body body, int rshift = 0) {
  if (nb & 7) {
    for (int e = bid; e < MT * NT; e += nb) body(e / NT, e % NT);
    return;
  }
  const int x = bid & 7, lb = bid >> 3, nlb = nb >> 3;
  const int mper = (MT >> 3) & ~3;
  const int main_cnt = mper * NT;
  for (int q = lb; q < main_cnt; q += nlb) {
    const int patch = q / (4 * NT), r = q - patch * (4 * NT);
    body(x * mper + patch * 4 + (r & 3), r >> 2);
  }
  const int rem = (MT - 8 * mper) * NT;
  const int rb = ((nb - 1 - bid - rshift) % nb + nb) % nb;
  for (int e = rb; e < rem; e += nb) body(8 * mper + e / NT, e % NT);
}
__device__ __forceinline__ void st8f(bf16_t* dst, const float (&v)[8]) {
  u32x4 w;
#pragma unroll
  for (int e = 0; e < 4; ++e) w[e] = pk2bf(v[2 * e], v[2 * e + 1]);
  *reinterpret_cast<u32x4*>(dst) = w;
}
__device__ __forceinline__ void stage_acc(char* smem, const f32x4 (&acc)[4][4]) {
  const int lane = threadIdx.x & 63, w = threadIdx.x >> 6, wm = w >> 1, wn = w & 1, g = lane >> 4, r16 = lane & 15;
  float* Et = reinterpret_cast<float*>(smem);
#pragma unroll
  for (int i = 0; i < 4; ++i)
#pragma unroll
    for (int j = 0; j < 4; ++j)
      *reinterpret_cast<f32x4*>(Et + (wm * 64 + 16 * i + r16) * 132 + wn * 64 + 16 * j + 4 * g) = acc[i][j];
  __syncthreads();
}
__device__ __forceinline__ void ld8(const char* smem, int row, int col8, float (&v)[8]) {
  const float* Et = reinterpret_cast<const float*>(smem);
  const f32x4 a = *reinterpret_cast<const f32x4*>(Et + row * 132 + col8), b = *reinterpret_cast<const f32x4*>(Et + row * 132 + col8 + 4);
#pragma unroll
  for (int e = 0; e < 4; ++e) { v[e] = a[e]; v[4 + e] = b[e]; }
}
__device__ __forceinline__ float sumsq8(const u32x4 v) {
  float s = 0.f;
#pragma unroll
  for (int q = 0; q < 4; ++q) {
    const float lo = __uint_as_float(v[q] << 16), hi = __uint_as_float(v[q] & 0xffff0000u);
    s += lo * lo + hi * hi;
  }
  return s;
}
__device__ __forceinline__ void rowss_publish(float* rowss, const float (&ss)[4]) {
  const int srow = threadIdx.x >> 3, sslot = threadIdx.x & 7;
#pragma unroll
  for (int i = 0; i < 4; ++i) {
    float v = ss[i];
    v += __shfl_xor(v, 1, 64); v += __shfl_xor(v, 2, 64); v += __shfl_xor(v, 4, 64);
    if (sslot == 0) rowss[srow + 32 * i] = v;
  }
  __syncthreads();
}
template <bool TRANS, class ARow, class BRow, class Epi>
__device__ __forceinline__ void gemm_bf16(char* smem, int mtiles, int N, int K, ARow arow, BRow brow,
                                          Epi epi, int bid, int nb) {
  const int lane = threadIdx.x & 63, w = threadIdx.x >> 6, wm = w >> 1, wn = w & 1, g = lane >> 4, r16 = lane & 15;
  const int ntn = (N + 127) >> 7;
  for (int tile = bid; tile < mtiles * ntn; tile += nb) {
    const int tm = tile / ntn, tn = tile - tm * ntn;
    const int m0 = tm * 128, n0 = tn * 128;
    f32x4 acc[4][4];
    gemm_tile<TRANS>(smem, m0, n0, 0, K >> 6,
        [&](int r, int k, int) { return *reinterpret_cast<const u32x4*>(arow(r) + k); },
        [&](int n, int k) { return *reinterpret_cast<const u32x4*>(brow(min(n, N - 1)) + k); }, acc);
    if constexpr (TRANS) epi(acc, m0 + wm * 64 + r16, n0 + wn * 64 + 4 * g);
    else epi(acc, m0 + wm * 64 + 4 * g, n0 + wn * 64 + r16);
  }
}

__device__ __forceinline__ void wtrans(const float* __restrict__ W, const float* __restrict__ gk, int K, int N, bf16_t* out,
                                       int gtid, int gthreads, int glim = 1 << 30) {
  const int total = N * (K >> 3);
  for (int idx = gtid; idx < total; idx += gthreads) {
    const int n = idx % N, kc = idx / N;
    float v[8];
#pragma unroll
    for (int i = 0; i < 8; ++i) {
      const int k = kc * 8 + i;
      v[i] = W[(size_t)k * N + n] * ((gk && k < glim) ? gk[k] : 1.0f);
    }
    uint4 o;
    uint2 lo = pack4bf(v[0], v[1], v[2], v[3]), hi = pack4bf(v[4], v[5], v[6], v[7]);
    o.x = lo.x; o.y = lo.y; o.z = hi.x; o.w = hi.y;
    *reinterpret_cast<uint4*>(out + (size_t)n * K + kc * 8) = o;
  }
}

__device__ __forceinline__ void ph_prep(const Params& p, int bid, int nb) {
  const int lane = threadIdx.x & 63, wv = threadIdx.x >> 6;
  for (int tt = bid * 4 + wv; tt < T; tt += nb * 4) {
    const float4* hr = reinterpret_cast<const float4*>(hrow(p, tt));
    float s = 0;
#pragma unroll
    for (int j = 0; j < 4; ++j) {
      const float4 v = hr[j * 64 + lane];
      s += v.x * v.x + v.y * v.y + v.z * v.z + v.w * v.w;
      *reinterpret_cast<uint2*>(p.hb + (size_t)tt * D + (j * 64 + lane) * 4) = pack4bf(v.x, v.y, v.z, v.w);
    }
    s = wave_sum(s);
    if (lane == 0) p.rstd1[tt] = rsqrtf(s * (1.0f / D) + RMS_EPS);
  }
  const int gtid = bid * NTHR + threadIdx.x, gth = nb * NTHR;
  for (int e = gtid; e < L * 32; e += gth) {
    const int i = e & 31, pos = e >> 5;
    const float inv = exp2f(-(float)i * (13.287712379549449f / 32.0f));
    float sn, cs; sincosf((float)pos * inv, &sn, &cs);
    p.ropec[e] = cs; p.ropes[e] = sn;
  }
  wtrans(p.w_in, p.g_mix, 1024, DIN, p.w_inT, gtid, gth);
  wtrans(p.w_uq, p.g_q, 256, 768, p.w_uqT, gtid, gth);
  wtrans(p.w_ukv, p.g_kv, 128, 1024, p.w_ukvT, gtid, gth);
  wtrans(p.w_out, p.g_out, 1024, 1024, p.w_outT, gtid, gth, 512);
  for (int e = gtid; e < 1024 * 2048 / 4; e += gth) {
    const f32x4 v = *reinterpret_cast<const f32x4*>(p.w_q + (size_t)e * 4);
    *reinterpret_cast<uint2*>(p.w_qb + (size_t)e * 4) = pack4bf(v[0], v[1], v[2], v[3]);
  }
  for (int e = gtid; e < 8 * 2 * 128 * 128 / 4; e += gth) {
    const f32x4 v = *reinterpret_cast<const f32x4*>(p.subk + (size_t)e * 4);
    *reinterpret_cast<uint2*>(p.subkb + (size_t)e * 4) = pack4bf(v[0], v[1], v[2], v[3]);
  }
  for (int e = gtid; e < 1536 * 128; e += gth) {
    const int n = e >> 7, k = e & 127;
    float v = 0.f;
    if (n < 512) { if (k < 64) v = p.w_up[k * 512 + n]; }
    else if (n < 1024) { if (k < 64) v = p.a_up[k * 512 + n - 512]; }
    else v = p.g_up[k * 512 + n - 1024];
    p.w_lrT[e] = f2bf(v);
  }
}
__device__ __forceinline__ void ph_inproj(const Params& p, char* smem, int bid, int nb) {
  const int lane = threadIdx.x & 63, w = threadIdx.x >> 6, wm = w >> 1, wn = w & 1, g = lane >> 4, r16 = lane & 15;
  for_tiles_xcd(T / 128, (DIN + 127) >> 7, bid, nb, [&](int tm, int tn) {
    const int m0 = tm * 128, n0 = tn * 128;
    f32x4 acc[4][4];
    gemm_tile_glds<true>(smem, m0, n0, 32,
        [&](int r, int k) { return p.hb + (size_t)r * D + k; },
        [&](int n, int k) { return p.w_inT + (size_t)min(n, DIN - 1) * 1024 + k; }, acc);
    float rsq[8];
#pragma unroll
    for (int q = 0; q < 8; ++q) rsq[q] = p.rstd1[m0 + ((threadIdx.x + 256 * q) >> 4)];
    stage_acc(smem, acc);
#pragma unroll
    for (int q = 0; q < 8; ++q) {
      const int c = threadIdx.x + 256 * q;
      const int row = c >> 4, col8 = (c & 15) * 8;
      const int m = m0 + row, n = n0 + col8;
      const float rs = rsq[q];
      float v[8];
      ld8(smem, row, col8, v);
      if (n0 == 384 && col8 < 64) {
        if (col8 < 32) {
          float v2[8], y1[8], y2[8];
          ld8(smem, row, col8 + 32, v2);
          const int pos = m % L;
          const f32x4 c0 = *reinterpret_cast<const f32x4*>(p.ropec + pos * 32 + col8), c1 = *reinterpret_cast<const f32x4*>(p.ropec + pos * 32 + col8 + 4);
          const f32x4 s0 = *reinterpret_cast<const f32x4*>(p.ropes + pos * 32 + col8), s1 = *reinterpret_cast<const f32x4*>(p.ropes + pos * 32 + col8 + 4);
#pragma unroll
          for (int e = 0; e < 8; ++e) {
            const float cs = e < 4 ? c0[e] : c1[e - 4], sn = e < 4 ? s0[e] : s1[e - 4];
            const float x1 = v[e] * rs, x2 = v2[e] * rs;
            y1[e] = x1 * cs - x2 * sn; y2[e] = x1 * sn + x2 * cs;
          }
          st8f(p.kr + (size_t)m * 64 + col8, y1);
          st8f(p.kr + (size_t)m * 64 + 32 + col8, y2);
        }
      } else if (n < DIN) {
#pragma unroll
        for (int e = 0; e < 8; ++e) v[e] *= rs;
        st8f(p.proj + (size_t)m * DIN + n, v);
      }
    }
  });
}
__device__ __forceinline__ void ph_w2(const Params& p, char* smem, int bid, int nb) {
  for (int e = bid; e < 128; e += nb) {
    const int hc = e >> 3, n0 = (e & 7) * 128;
    f32x4 acc[4][4];
    gemm_tile_glds<true>(smem, 0, n0, 4,
        [&](int r, int k) { return p.subkb + ((size_t)hc * 128 + r) * 128 + k; },
        [&](int n, int k) { return p.w_qb + (size_t)n * 2048 + hc * 128 + k; }, acc);
    stage_acc(smem, acc);
#pragma unroll 2
    for (int q = 0; q < 8; ++q) {
      const int c = threadIdx.x + 256 * q;
      const int row = c >> 4, col8 = (c & 15) * 8;
      float v[8];
      ld8(smem, row, col8, v);
      const f32x4 g0 = *reinterpret_cast<const f32x4*>(p.g_ffn + n0 + col8), g1 = *reinterpret_cast<const f32x4*>(p.g_ffn + n0 + col8 + 4);
#pragma unroll
      for (int e2 = 0; e2 < 8; ++e2) v[e2] *= e2 < 4 ? g0[e2] : g1[e2 - 4];
      st8f(p.w_qT + ((size_t)hc * 128 + row) * 1024 + n0 + col8, v);
    }
  }
}
__device__ __forceinline__ void ph_q_up(const Params& p, char* smem, int bid, int nb) {
  const int lane = threadIdx.x & 63, w = threadIdx.x >> 6, wm = w >> 1, wn = w & 1, g = lane >> 4, r16 = lane & 15;
  float* rowss = reinterpret_cast<float*>(smem);
  for_tiles_xcd(T / 128, 6, bid, nb, [&](int tm, int tn) {
    const int m0 = tm * 128, n0 = tn * 128;
    f32x4 acc[4][4];
    float ss[4] = {0.f, 0.f, 0.f, 0.f};
    gemm_tile<true>(smem, m0, n0, 0, 4,
        [&](int r, int k, int i) { const u32x4 v = *reinterpret_cast<const u32x4*>(p.proj + (size_t)r * DIN + k); ss[i] += sumsq8(v); return v; },
        [&](int n, int k) { return *reinterpret_cast<const u32x4*>(p.w_uqT + (size_t)n * 256 + k); }, acc);
    float rsum[4];
#pragma unroll
    for (int i = 0; i < 4; ++i) {
      float v = ss[i];
      v += __shfl_xor(v, 1, 64); v += __shfl_xor(v, 2, 64); v += __shfl_xor(v, 4, 64);
      rsum[i] = v;
    }
    stage_acc(smem, acc);
    float* rowss2 = reinterpret_cast<float*>(smem + 128 * 132 * 4);
    if ((threadIdx.x & 7) == 0) {
#pragma unroll
      for (int i = 0; i < 4; ++i) rowss2[(threadIdx.x >> 3) + 32 * i] = rsum[i];
    }
    __syncthreads();
#pragma unroll 2
    for (int q = 0; q < 8; ++q) {
      const int c = threadIdx.x + 256 * q;
      const int row = c >> 4, col8 = (c & 15) * 8;
      const int m = m0 + row, n = n0 + col8;
      const float rs = rsqrtf(rowss2[row] * (1.0f / 256) + RMS_EPS) * (0.07216878364870322f * 1.4426950408889634f);
      const int off = n % 192;
      float v[8];
      ld8(smem, row, col8, v);
      if (off >= 128) {
        if (off < 160) {
          float v2[8], y1[8], y2[8];
          ld8(smem, row, col8 + 32, v2);
          const int pos = m % L, ii = off - 128;
          const f32x4 c0 = *reinterpret_cast<const f32x4*>(p.ropec + pos * 32 + ii), c1 = *reinterpret_cast<const f32x4*>(p.ropec + pos * 32 + ii + 4);
          const f32x4 s0 = *reinterpret_cast<const f32x4*>(p.ropes + pos * 32 + ii), s1 = *reinterpret_cast<const f32x4*>(p.ropes + pos * 32 + ii + 4);
#pragma unroll
          for (int e = 0; e < 8; ++e) {
            const float cs = e < 4 ? c0[e] : c1[e - 4], sn = e < 4 ? s0[e] : s1[e - 4];
            const float x1 = v[e] * rs, x2 = v2[e] * rs;
            y1[e] = x1 * cs - x2 * sn; y2[e] = x1 * sn + x2 * cs;
          }
          st8f(p.qf + (size_t)m * 768 + n, y1);
          st8f(p.qf + (size_t)m * 768 + n + 32, y2);
        }
      } else {
#pragma unroll
        for (int e = 0; e < 8; ++e) v[e] *= rs;
        st8f(p.qf + (size_t)m * 768 + n, v);
      }
    }
  }, 12);
}
__device__ __forceinline__ void ph_kv_up(const Params& p, char* smem, int bid, int nb) {
  const int lane = threadIdx.x & 63, w = threadIdx.x >> 6, wm = w >> 1, wn = w & 1, g = lane >> 4, r16 = lane & 15;
  float* rowss = reinterpret_cast<float*>(smem);
  for_tiles_xcd(T / 128, 8, bid, nb, [&](int tm, int tn) {
    const bool vpart = tn >= 4;
    const int m0 = tm * 128, n0 = (tn & 3) * 128;
    f32x4 acc[4][4];
    float ss[4] = {0.f, 0.f, 0.f, 0.f};
    auto al = [&](int r, int k, int i) { const u32x4 v = *reinterpret_cast<const u32x4*>(p.proj + (size_t)r * DIN + 256 + k); ss[i] += sumsq8(v); return v; };
    if (!vpart) {
      gemm_tile<true>(smem, m0, n0, 0, 2, al,
          [&](int n, int k) { return *reinterpret_cast<const u32x4*>(p.w_ukvT + (size_t)((n >> 7) * 256 + (n & 127)) * 128 + k); }, acc);
      float rsum[4];
#pragma unroll
      for (int i = 0; i < 4; ++i) {
        float v = ss[i];
        v += __shfl_xor(v, 1, 64); v += __shfl_xor(v, 2, 64); v += __shfl_xor(v, 4, 64);
        rsum[i] = v;
      }
      stage_acc(smem, acc);
      float* rowss2 = reinterpret_cast<float*>(smem + 128 * 132 * 4);
      if ((threadIdx.x & 7) == 0) {
#pragma unroll
        for (int i = 0; i < 4; ++i) rowss2[(threadIdx.x >> 3) + 32 * i] = rsum[i];
      }
      __syncthreads();
#pragma unroll 2
      for (int q = 0; q < 8; ++q) {
        const int c = threadIdx.x + 256 * q;
        const int row = c >> 4, col8 = (c & 15) * 8;
        const int m = m0 + row, n = n0 + col8;
        const float rs = rsqrtf(rowss2[row] * (1.0f / 128) + RMS_EPS);
        const int b = m / L, pos = m - b * L;
        float v[8];
        ld8(smem, row, col8, v);
#pragma unroll
        for (int e = 0; e < 8; ++e) v[e] *= rs;
        st8f(p.kn + ((size_t)((b * 4 + (n >> 7)) * L + pos)) * 128 + (n & 127), v);
      }
    } else {
      gemm_tile<false>(smem, m0, n0, 0, 2, al,
          [&](int n, int k) { return *reinterpret_cast<const u32x4*>(p.w_ukvT + (size_t)((n >> 7) * 256 + 128 + (n & 127)) * 128 + k); }, acc);
      rowss_publish(rowss, ss);
      const int mb = m0 + wm * 64 + 4 * g, nbase = n0 + wn * 64 + r16;
#pragma unroll
      for (int i = 0; i < 4; ++i) {
        const int m = mb + 16 * i;
        f32x4 rs;
#pragma unroll
        for (int r = 0; r < 4; ++r) rs[r] = rsqrtf(rowss[wm * 64 + 16 * i + 4 * g + r] * (1.0f / 128) + RMS_EPS);
        const int b = m / L, pos = m - b * L;
#pragma unroll
        for (int j = 0; j < 4; ++j) {
          const int n = nbase + 16 * j;
          const int h = n >> 7, dv = n & 127;
          const f32x4 v = acc[i][j] * rs;
          *reinterpret_cast<uint2*>(p.vt + ((size_t)((b * 4 + h) * 128 + dv)) * L + pos) = pack4bf(v[0], v[1], v[2], v[3]);
        }
      }
    }
  }, 18);
}
__device__ __forceinline__ float fast_rcp(float x) { return __builtin_amdgcn_rcpf(x); }
__device__ __forceinline__ float fast_sigmoid(float x) { return fast_rcp(1.0f + __expf(-x)); }
__device__ __forceinline__ float fast_tanh(float x) { return 1.0f - 2.0f * fast_rcp(1.0f + __expf(2.0f * x)); }
__device__ __forceinline__ float lerp_tok(const Params& p, int tt, int pos, int c) {
  const float cur = bf2f(p.proj[(size_t)tt * DIN + 448 + c]);
  const float prev = pos > 0 ? bf2f(p.proj[(size_t)(tt - 1) * DIN + 448 + c]) : 0.0f;
  return cur + p.mu[c] * (prev - cur);
}
__device__ __forceinline__ f32x4 lerp4(const Params& p, int tt, int pos, int c) {
  const f32x4 cur = unpk4(*reinterpret_cast<const u32x2*>(p.proj + (size_t)tt * DIN + 448 + c));
  f32x4 prev = {0.f, 0.f, 0.f, 0.f};
  if (pos > 0) prev = unpk4(*reinterpret_cast<const u32x2*>(p.proj + (size_t)(tt - 1) * DIN + 448 + c));
  const f32x4 m = *reinterpret_cast<const f32x4*>(p.mu + c);
  return cur + m * (prev - cur);
}
__device__ __forceinline__ void ph_rwkv_prep(const Params& p, char* smem, int bid, int nb) {
  const int lane = threadIdx.x & 63, w = threadIdx.x >> 6, wm = w >> 1, wn = w & 1, g = lane >> 4, r16 = lane & 15;
  for_tiles_xcd(T / 128, 12, bid, nb, [&](int tm, int tn) {
    const int kind = tn >> 2, n0 = (tn & 3) * 128;
    const int m0 = tm * 128;
    const int kbase = kind == 0 ? 1536 : (kind == 1 ? 1600 : 1664);
    f32x4 acc[4][4];
    gemm_tile<true>(smem, m0, n0, 0, kind == 2 ? 2 : 1,
        [&](int r, int k, int) {
          const int pos = r % L;
          const u32x4 cu = *reinterpret_cast<const u32x4*>(p.proj + (size_t)r * DIN + 448 + kbase + k);
          u32x4 pv = {0u, 0u, 0u, 0u};
          if (pos > 0) pv = *reinterpret_cast<const u32x4*>(p.proj + (size_t)(r - 1) * DIN + 448 + kbase + k);
          u32x4 o;
#pragma unroll
          for (int q = 0; q < 4; ++q) {
            float c0 = __uint_as_float(cu[q] << 16), c1 = __uint_as_float(cu[q] & 0xffff0000u);
            const float p0 = __uint_as_float(pv[q] << 16), p1 = __uint_as_float(pv[q] & 0xffff0000u);
            c0 += p.mu[kbase + k + 2 * q] * (p0 - c0);
            c1 += p.mu[kbase + k + 2 * q + 1] * (p1 - c1);
            if (kind == 0) { c0 = fast_tanh(c0); c1 = fast_tanh(c1); }
            else if (kind == 2) { c0 = fast_sigmoid(c0); c1 = fast_sigmoid(c1); }
            o[q] = pk2bf(c0, c1);
          }
          return o;
        },
        [&](int n, int k) { return *reinterpret_cast<const u32x4*>(p.w_lrT + (size_t)(kind * 512 + n) * 128 + k); }, acc);
    float* Et = reinterpret_cast<float*>(smem);
#pragma unroll
    for (int i = 0; i < 4; ++i)
#pragma unroll
      for (int j = 0; j < 4; ++j)
        *reinterpret_cast<f32x4*>(Et + (wm * 64 + 16 * i + r16) * 132 + wn * 64 + 16 * j + 4 * g) = acc[i][j];
    __syncthreads();
    const int coloff = kind == 0 ? 0 : (kind == 1 ? 512 : 1024);
    bf16_t* const xdst = kind == 0 ? p.rr : (kind == 1 ? p.rk2 : p.rv);
    bf16_t* const ldst = kind == 0 ? p.rlw : (kind == 1 ? p.rkk : p.rg);
    const int chh = n0 + (threadIdx.x & 15) * 8;
    const f32x4 mu0 = *reinterpret_cast<const f32x4*>(p.mu + coloff + chh), mu1 = *reinterpret_cast<const f32x4*>(p.mu + coloff + chh + 4);
#pragma unroll 1
    for (int qb = 0; qb < 8; qb += 4) {
    u32x4 cuv[4], pvv[4];
#pragma unroll
    for (int qi = 0; qi < 4; ++qi) {
      const int c = threadIdx.x + 256 * (qb + qi);
      const int m = m0 + (c >> 4);
      const bf16_t* pc = p.proj + (size_t)m * DIN + 448 + coloff + n0 + (c & 15) * 8;
      cuv[qi] = *reinterpret_cast<const u32x4*>(pc);
      pvv[qi] = *reinterpret_cast<const u32x4*>(pc - ((m % L) > 0 ? DIN : 0));
    }
#pragma unroll
    for (int qi = 0; qi < 4; ++qi) {
      const int q = qb + qi;
      const int c = threadIdx.x + 256 * q;
      const int row = c >> 4, ch = n0 + (c & 15) * 8;
      const int m = m0 + row, pos = m % L;
      const f32x4 l0 = *reinterpret_cast<const f32x4*>(Et + row * 132 + (c & 15) * 8);
      const f32x4 l1 = *reinterpret_cast<const f32x4*>(Et + row * 132 + (c & 15) * 8 + 4);
      const u32x4 cu = cuv[qi];
      u32x4 pv = pvv[qi];
      if (pos == 0) pv = (u32x4){0u, 0u, 0u, 0u};
      float xs[8], lr[8];
#pragma unroll
      for (int e = 0; e < 4; ++e) {
        const float c0 = __uint_as_float(cu[e] << 16), c1 = __uint_as_float(cu[e] & 0xffff0000u);
        const float p0 = __uint_as_float(pv[e] << 16), p1 = __uint_as_float(pv[e] & 0xffff0000u);
        const float m0_ = e < 2 ? mu0[2 * e] : mu1[2 * e - 4], m1_ = e < 2 ? mu0[2 * e + 1] : mu1[2 * e - 3];
        xs[2 * e] = c0 + m0_ * (p0 - c0);
        xs[2 * e + 1] = c1 + m1_ * (p1 - c1);
      }
#pragma unroll
      for (int e = 0; e < 4; ++e) { lr[e] = l0[e]; lr[4 + e] = l1[e]; }
      const size_t o = (size_t)m * 512 + ch;
      if (kind == 0) {
        const f32x4 w00 = *reinterpret_cast<const f32x4*>(p.w0 + ch), w01 = *reinterpret_cast<const f32x4*>(p.w0 + ch + 4);
        float lw[8];
#pragma unroll
        for (int e = 0; e < 8; ++e) {
          const float nx = -(lr[e] + (e < 4 ? w00[e] : w01[e - 4]));
          const float sp = fmaxf(nx, 0.0f) + __logf(1.0f + __expf(-fabsf(nx)));
          lw[e] = -__expf(-sp - 0.5f);
        }
        st8f(ldst + o, lw);
        st8f(xdst + o, xs);
      } else if (kind == 2) {
        st8f(ldst + o, lr);
        st8f(xdst + o, xs);
      } else {
        const f32x4 a00 = *reinterpret_cast<const f32x4*>(p.a0 + ch), a01 = *reinterpret_cast<const f32x4*>(p.a0 + ch + 4);
        const f32x4 kk0 = *reinterpret_cast<const f32x4*>(p.k_k + ch), kk1 = *reinterpret_cast<const f32x4*>(p.k_k + ch + 4);
        const f32x4 ka0 = *reinterpret_cast<const f32x4*>(p.k_a + ch), ka1 = *reinterpret_cast<const f32x4*>(p.k_a + ch + 4);
        float av[8], kkr[8], ss = 0.f;
#pragma unroll
        for (int e = 0; e < 8; ++e) {
          av[e] = fast_sigmoid(lr[e] + (e < 4 ? a00[e] : a01[e - 4]));
          kkr[e] = xs[e] * (e < 4 ? kk0[e] : kk1[e - 4]);
          ss += kkr[e] * kkr[e];
        }
        ss = dpp_sum8(ss);
        const float inr = 1.0f / fmaxf(sqrtf(ss), 1e-12f);
        float kkn[8], k2[8], bb[8];
#pragma unroll
        for (int e = 0; e < 8; ++e) {
          kkn[e] = kkr[e] * inr;
          k2[e] = xs[e] * (1.0f + (av[e] - 1.0f) * (e < 4 ? ka0[e] : ka1[e - 4]));
          bb[e] = kkn[e] * av[e];
        }
        st8f(ldst + o, kkn);
        st8f(xdst + o, k2);
        st8f(p.rbb + o, bb);
      }
    }
    }
  });
}
template <bool STORE = true>
__device__ __forceinline__ void ph_attn(const Params& p, char* smem, int bid, int nb) {
  char* Kb = smem;
  char* Vs = smem + 49152;
  const int tid = threadIdx.x, lane = tid & 63, w = tid >> 6, g = lane >> 4, r16 = lane & 15;
  const int wu = __builtin_amdgcn_readfirstlane(tid) >> 6;
  const int nitems = 32 * 17;
  for (int it = bid; it < nitems; it += nb) {
    const int bh = it & 31, grp = it >> 5;
    const bool meta = grp == 16;
    const int j = 15 - grp;
    const int b = bh >> 2, h = bh & 3;
    const int qbase = meta ? 0 : 16 + 128 * j;
    const int ntiles = meta ? 1 : 2 * j + 3;
    const int my_ntiles = meta ? 1 : (w < 2 ? 2 * j + 2 : 2 * j + 3);
    bf16x8 qf[2][6];
#pragma unroll
    for (int nt = 0; nt < 2; ++nt)
#pragma unroll
      for (int ks = 0; ks < 6; ++ks) {
        const int pos = qbase + 32 * w + 16 * nt + r16;
        qf[nt][ks] = *reinterpret_cast<const bf16x8*>(p.qf + ((size_t)(b * L + pos)) * 768 + h * 192 + ks * 32 + 8 * g);
      }
    f32x4 o[8][2];
#pragma unroll
    for (int a = 0; a < 8; ++a) { o[a][0] = (f32x4){0.f, 0.f, 0.f, 0.f}; o[a][1] = (f32x4){0.f, 0.f, 0.f, 0.f}; }
    float mrun[2] = {-1e30f, -1e30f}, lrun[2] = {0.f, 0.f};
    const bf16_t* knb = p.kn + (size_t)(b * 4 + h) * L * 128;
    const bf16_t* krb = p.kr + (size_t)b * L * 64;
    const bf16_t* vtb = p.vt + (size_t)(b * 4 + h) * 128 * L;
    int koff[6], voff[4];
    unsigned kmask = 0;
#pragma unroll
    for (int i = 0; i < 6; ++i) {
      const int Lk = 64 * (6 * wu + i) + lane;
      const int row = Lk / 24, sp = Lk - row * 24;
      const int ch = (sp & ~7) | ((sp ^ row) & 7);
      if (ch < 16) koff[i] = row * 128 + ch * 8; else { koff[i] = row * 64 + (ch - 16) * 8; kmask |= 1u << i; }
    }
#pragma unroll
    for (int i = 0; i < 4; ++i) {
      const int row = 8 * (4 * wu + i) + (lane >> 3);
      voff[i] = row * L + (((lane & 7) ^ ((row >> 1) & 7)) * 8);
    }
    auto issueK = [&](int t) {
      const int kp0 = t == 0 ? 0 : 16 + 64 * (t - 1);
      char* dst = Kb + (t & 1) * 24576;
      const bf16_t* kb0 = knb + (size_t)kp0 * 128;
      const bf16_t* kb1 = krb + (size_t)kp0 * 64;
#pragma unroll
      for (int i = 0; i < 6; ++i) GLDS16(((kmask >> i) & 1u ? kb1 : kb0) + koff[i], dst + (6 * wu + i) * 1024);
    };
    auto issueV = [&](int t) {
      const int kp0 = t == 0 ? 0 : 16 + 64 * (t - 1);
      const bf16_t* vb0 = vtb + kp0;
#pragma unroll
      for (int i = 0; i < 4; ++i) GLDS16(vb0 + voff[i], Vs + (4 * wu + i) * 1024);
    };
    __syncthreads();
    issueK(0);
    asm volatile("s_waitcnt vmcnt(0)\n\ts_barrier" ::: "memory");
    for (int t = 0; t < ntiles; ++t) {
      const char* Ks = Kb + (t & 1) * 24576;
      issueV(t);
      if (t + 1 < ntiles) issueK(t + 1);
      bf16x8 pb[2][2];
      if (t < my_ntiles) {
        f32x4 s[4][2];
#pragma unroll
        for (int a = 0; a < 4; ++a) { s[a][0] = (f32x4){0.f, 0.f, 0.f, 0.f}; s[a][1] = (f32x4){0.f, 0.f, 0.f, 0.f}; }
#pragma unroll
        for (int ks = 0; ks < 6; ++ks) {
          const int slot = ks * 4 + g;
          const int so = ((slot & ~7) | ((slot ^ lane) & 7)) << 4;
#pragma unroll
          for (int mt = 0; mt < 4; ++mt) {
            const bf16x8 kf = *reinterpret_cast<const bf16x8*>(Ks + (mt * 16 + r16) * 384 + so);
            s[mt][0] = __builtin_amdgcn_mfma_f32_16x16x32_bf16(kf, qf[0][ks], s[mt][0], 0, 0, 0);
            s[mt][1] = __builtin_amdgcn_mfma_f32_16x16x32_bf16(kf, qf[1][ks], s[mt][1], 0, 0, 0);
          }
        }
        if (t == 0) {
#pragma unroll
          for (int mt = 1; mt < 4; ++mt) { s[mt][0] = (f32x4){-1e30f, -1e30f, -1e30f, -1e30f}; s[mt][1] = s[mt][0]; }
        }
#pragma unroll
        for (int nt = 0; nt < 2; ++nt) {
          float mx = -1e30f;
#pragma unroll
          for (int mt = 0; mt < 4; ++mt)
#pragma unroll
            for (int r = 0; r < 4; ++r) mx = fmaxf(mx, s[mt][nt][r]);
          mx = fmaxf(mx, __shfl_xor(mx, 16, 64));
          mx = fmaxf(mx, __shfl_xor(mx, 32, 64));
          const float mn = fmaxf(mrun[nt], mx);
          const float alpha = __builtin_amdgcn_exp2f(mrun[nt] - mn);
          mrun[nt] = mn;
          float rs = 0.f;
#pragma unroll
          for (int mt = 0; mt < 4; ++mt)
#pragma unroll
            for (int r = 0; r < 4; ++r) { const float pv = __builtin_amdgcn_exp2f(s[mt][nt][r] - mn); s[mt][nt][r] = pv; rs += pv; }
          lrun[nt] = lrun[nt] * alpha + rs;
#pragma unroll
          for (int a = 0; a < 8; ++a) o[a][nt] *= alpha;
#pragma unroll
          for (int k2 = 0; k2 < 2; ++k2) {
            const uint2 lo = pack4bf(s[2 * k2][nt][0], s[2 * k2][nt][1], s[2 * k2][nt][2], s[2 * k2][nt][3]);
            const uint2 hi = pack4bf(s[2 * k2 + 1][nt][0], s[2 * k2 + 1][nt][1], s[2 * k2 + 1][nt][2], s[2 * k2 + 1][nt][3]);
            u32x4 pk; pk[0] = lo.x; pk[1] = lo.y; pk[2] = hi.x; pk[3] = hi.y;
            pb[k2][nt] = __builtin_bit_cast(bf16x8, pk);
          }
        }
      }
      if (t + 1 < ntiles) asm volatile("s_waitcnt vmcnt(6)\n\ts_barrier" ::: "memory");
      else asm volatile("s_waitcnt vmcnt(0)\n\ts_barrier" ::: "memory");
      if (t < my_ntiles) {
#pragma unroll
        for (int k2 = 0; k2 < 2; ++k2) {
          const int sa = ((8 * k2 + g) ^ (r16 & 14)) << 3;
          const int sb = ((8 * k2 + 4 + g) ^ (r16 & 14)) << 3;
#pragma unroll
          for (int a = 0; a < 8; ++a) {
            const uint2 va = *reinterpret_cast<const uint2*>(Vs + (a * 16 + r16) * 128 + sa);
            const uint2 vb = *reinterpret_cast<const uint2*>(Vs + (a * 16 + r16) * 128 + sb);
            u32x4 pk; pk[0] = va.x; pk[1] = va.y; pk[2] = vb.x; pk[3] = vb.y;
            const bf16x8 vf = __builtin_bit_cast(bf16x8, pk);
            o[a][0] = __builtin_amdgcn_mfma_f32_16x16x32_bf16(vf, pb[k2][0], o[a][0], 0, 0, 0);
            o[a][1] = __builtin_amdgcn_mfma_f32_16x16x32_bf16(vf, pb[k2][1], o[a][1], 0, 0, 0);
          }
        }
      }
      asm volatile("s_waitcnt vmcnt(0)\n\ts_waitcnt lgkmcnt(0)\n\ts_barrier" ::: "memory");
    }
#pragma unroll
    for (int nt = 0; nt < 2; ++nt) {
      float l = lrun[nt];
      l += __shfl_xor(l, 16, 64);
      l += __shfl_xor(l, 32, 64);
      const float il = 1.0f / l;
      const int pos = qbase + 32 * w + 16 * nt + r16;
      float sq = 0.f;
#pragma unroll
      for (int a = 0; a < 8; ++a) { const f32x4 v = o[a][nt] * il; sq += v[0] * v[0] + v[1] * v[1] + v[2] * v[2] + v[3] * v[3]; }
      sq += __shfl_xor(sq, 16, 64);
      sq += __shfl_xor(sq, 32, 64);
      if (STORE && (!meta || pos < NM)) {
        bf16_t* dst = p.qf + (size_t)(b * L + pos) * 768 + h * 192 + 4 * g;
#pragma unroll
        for (int a = 0; a < 8; ++a) {
          const f32x4 v = o[a][nt] * il;
          *reinterpret_cast<uint2*>(dst + a * 16) = pack4bf(v[0], v[1], v[2], v[3]);
        }
        if (g == 0) p.ossq[(size_t)(b * L + pos) * 4 + h] = sq;
      }
    }
  }
}
__device__ __forceinline__ void ph_rwkv_pre(const Params& p, char* smem, int bid, int nb) {
  const int lane = threadIdx.x & 63, wv = threadIdx.x >> 6, g = lane >> 4, r16 = lane & 15;
  char* my = smem + wv * 16384;
  char* At = my;
  char* Bt = my + 2048;
  char* Kt = my + 4096;
  char* Rt = my + 6144;
  char* AtT = my + 8192;
  char* VtT = my + 10240;
  char* BhT = my + 12288;
  char* KhT = my + 14336;
  const int nitems = NB_ * 8 * NCH;
  for (int wi = bid * 4 + wv; wi < nitems; wi += nb * 4) {
    const int chunk = wi % NCH, bh = wi / NCH, b = bh >> 3, h = bh & 7;
    float btv[16], ktv[16];
    unsigned atp[8], vtp[8];
    float cum = 0.f;
    const size_t o0 = ((size_t)b * L + chunk * 16) * 512 + h * 64 + lane;
#pragma unroll
    for (int t = 0; t < 16; ++t) {
      const size_t o = o0 + (size_t)t * 512;
      const float lw = bf2f(p.rlw[o]);
      const float gp = __expf(cum);
      cum += lw;
      const float gc = __expf(cum), ig = __expf(-cum);
      const float av = -bf2f(p.rkk[o]) * gp;
      const float bv = bf2f(p.rbb[o]) * ig;
      const float kv = bf2f(p.rk2[o]) * ig;
      const float rv = bf2f(p.rr[o]) * gc;
      const bf16_t vb = p.rv[o];
      btv[t] = bv; ktv[t] = kv;
      const bf16_t ab = f2bf(av);
      *reinterpret_cast<bf16_t*>(At + t * 128 + lane * 2) = ab;
      *reinterpret_cast<bf16_t*>(Bt + t * 128 + lane * 2) = f2bf(bv);
      *reinterpret_cast<bf16_t*>(Kt + t * 128 + lane * 2) = f2bf(kv);
      *reinterpret_cast<bf16_t*>(Rt + t * 128 + lane * 2) = f2bf(rv);
      if (t & 1) { atp[t >> 1] |= (unsigned)ab << 16; vtp[t >> 1] |= (unsigned)vb << 16; }
      else { atp[t >> 1] = ab; vtp[t >> 1] = vb; }
    }
    const float gC = __expf(cum);
    p.cd_gc[(size_t)wi * 64 + lane] = gC;
    {
      u32x4 w0, w1;
#pragma unroll
      for (int q = 0; q < 4; ++q) { w0[q] = atp[q]; w1[q] = atp[4 + q]; }
      *reinterpret_cast<u32x4*>(AtT + lane * 32) = w0; *reinterpret_cast<u32x4*>(AtT + lane * 32 + 16) = w1;
#pragma unroll
      for (int q = 0; q < 4; ++q) { w0[q] = vtp[q]; w1[q] = vtp[4 + q]; }
      *reinterpret_cast<u32x4*>(VtT + lane * 32) = w0; *reinterpret_cast<u32x4*>(VtT + lane * 32 + 16) = w1;
#pragma unroll
      for (int q = 0; q < 4; ++q) {
        w0[q] = pk2bf(btv[2 * q] * gC, btv[2 * q + 1] * gC);
        w1[q] = pk2bf(btv[8 + 2 * q] * gC, btv[8 + 2 * q + 1] * gC);
      }
      *reinterpret_cast<u32x4*>(BhT + lane * 32) = w0; *reinterpret_cast<u32x4*>(BhT + lane * 32 + 16) = w1;
#pragma unroll
      for (int q = 0; q < 4; ++q) {
        w0[q] = pk2bf(ktv[2 * q] * gC, ktv[2 * q + 1] * gC);
        w1[q] = pk2bf(ktv[8 + 2 * q] * gC, ktv[8 + 2 * q + 1] * gC);
      }
      *reinterpret_cast<u32x4*>(KhT + lane * 32) = w0; *reinterpret_cast<u32x4*>(KhT + lane * 32 + 16) = w1;
    }
    __builtin_amdgcn_wave_barrier();
    f32x4 mab = {0.f, 0.f, 0.f, 0.f}, mak = mab, nbr = mab, nkr = mab;
#pragma unroll
    for (int ks = 0; ks < 2; ++ks) {
      const int off = r16 * 128 + ks * 64 + g * 16;
      const bf16x8 fa = *reinterpret_cast<const bf16x8*>(At + off);
      const bf16x8 fb = *reinterpret_cast<const bf16x8*>(Bt + off);
      const bf16x8 fk = *reinterpret_cast<const bf16x8*>(Kt + off);
      const bf16x8 fr = *reinterpret_cast<const bf16x8*>(Rt + off);
      mab = MFMA32(fb, fa, mab); mak = MFMA32(fk, fa, mak);
      nbr = MFMA32(fb, fr, nbr); nkr = MFMA32(fk, fr, nkr);
    }
#pragma unroll
    for (int r = 0; r < 4; ++r) {
      const int sidx = 4 * g + r;
      if (!(sidx < r16)) { mab[r] = 0.f; mak[r] = 0.f; }
      if (!(sidx <= r16)) { nbr[r] = 0.f; nkr[r] = 0.f; }
    }
    float Tc[16];
#pragma unroll
    for (int sidx = 15; sidx >= 0; --sidx) {
      float acc = (r16 == sidx) ? 1.0f : 0.0f;
#pragma unroll
      for (int u = sidx + 1; u < 16; ++u) {
        const float m = __int_as_float(__builtin_amdgcn_readlane(__float_as_int(mab[sidx & 3]), 16 * (sidx >> 2) + u));
        acc += m * Tc[u];
      }
      Tc[sidx] = acc;
    }
    f32x4 tqf;
#pragma unroll
    for (int r = 0; r < 4; ++r) tqf[r] = g == 0 ? Tc[r] : (g == 1 ? Tc[4 + r] : (g == 2 ? Tc[8 + r] : Tc[12 + r]));
    const bf16x4 tq = pk4(tqf);
    const bf16x4 makA = pk4(mak), nbrA = pk4(nbr), nkrA = pk4(nkr);
    f32x4 ah[4], qm[4], wt[4], zt[4];
    bf16x4 vfr[4];
#pragma unroll
    for (int q = 0; q < 4; ++q) {
      const f32x4 z4 = {0.f, 0.f, 0.f, 0.f};
      const bf16x4 atf = *reinterpret_cast<const bf16x4*>(AtT + (16 * q + r16) * 32 + g * 8);
      vfr[q] = *reinterpret_cast<const bf16x4*>(VtT + (16 * q + r16) * 32 + g * 8);
      ah[q] = MFMA16(tq, atf, z4);
      const f32x4 xt = MFMA16(makA, vfr[q], z4);
      wt[q] = MFMA16(tq, pk4(xt), z4);
      qm[q] = MFMA16(nbrA, pk4(ah[q]), z4);
      zt[q] = MFMA16(nbrA, pk4(wt[q]), z4);
      zt[q] = MFMA16(nkrA, vfr[q], zt[q]);
    }
    unsigned char* oah = p.cd_ah + (size_t)wi * 2048;
    unsigned char* oqm = p.cd_qm + (size_t)wi * 2048;
    unsigned char* obk = p.cd_bk + (size_t)wi * 4096;
    unsigned char* owt = p.cd_wt + (size_t)wi * 2048;
    unsigned char* ozt = p.cd_zt + (size_t)wi * 2048;
    unsigned char* ovb = p.cd_vb + (size_t)wi * 2048;
#pragma unroll
    for (int q = 0; q < 4; ++q) {
      *reinterpret_cast<bf16x4*>(owt + (q * 64 + lane) * 8) = pk4(wt[q]);
      *reinterpret_cast<bf16x4*>(ozt + (q * 64 + lane) * 8) = pk4(zt[q]);
      *reinterpret_cast<bf16x4*>(ovb + (q * 64 + lane) * 8) = vfr[q];
      const u32x2 bh2 = *reinterpret_cast<const u32x2*>(BhT + (16 * q + r16) * 32 + g * 8);
      const u32x2 kh2 = *reinterpret_cast<const u32x2*>(KhT + (16 * q + r16) * 32 + g * 8);
      u32x4 bk; bk[0] = bh2[0]; bk[1] = bh2[1]; bk[2] = kh2[0]; bk[3] = kh2[1];
      *reinterpret_cast<u32x4*>(obk + (q * 64 + lane) * 16) = bk;
    }
    __builtin_amdgcn_wave_barrier();
#pragma unroll
    for (int q = 0; q < 4; ++q)
#pragma unroll
      for (int r = 0; r < 4; ++r) *reinterpret_cast<bf16_t*>(Bt + (4 * g + r) * 128 + (16 * q + r16) * 2) = f2bf(ah[q][r]);
    __builtin_amdgcn_wave_barrier();
#pragma unroll
    for (int ks = 0; ks < 2; ++ks) {
      const u32x2 lo = *reinterpret_cast<const u32x2*>(Bt + r16 * 128 + (32 * ks + 4 * g) * 2);
      const u32x2 hi = *reinterpret_cast<const u32x2*>(Bt + r16 * 128 + (32 * ks + 16 + 4 * g) * 2);
      u32x4 v; v[0] = lo[0]; v[1] = lo[1]; v[2] = hi[0]; v[3] = hi[1];
      *reinterpret_cast<u32x4*>(oah + (ks * 64 + lane) * 16) = v;
    }
    __builtin_amdgcn_wave_barrier();
#pragma unroll
    for (int q = 0; q < 4; ++q)
#pragma unroll
      for (int r = 0; r < 4; ++r) *reinterpret_cast<bf16_t*>(Bt + (4 * g + r) * 128 + (16 * q + r16) * 2) = f2bf(qm[q][r]);
    __builtin_amdgcn_wave_barrier();
#pragma unroll
    for (int ks = 0; ks < 2; ++ks) {
      const int o1 = r16 * 128 + (32 * ks + 4 * g) * 2, o2 = r16 * 128 + (32 * ks + 16 + 4 * g) * 2;
      const f32x4 a1 = unpk4(*reinterpret_cast<const u32x2*>(Bt + o1)) + unpk4(*reinterpret_cast<const u32x2*>(Rt + o1));
      const f32x4 a2 = unpk4(*reinterpret_cast<const u32x2*>(Bt + o2)) + unpk4(*reinterpret_cast<const u32x2*>(Rt + o2));
      const uint2 lo = pack4bf(a1[0], a1[1], a1[2], a1[3]), hi = pack4bf(a2[0], a2[1], a2[2], a2[3]);
      u32x4 v; v[0] = lo.x; v[1] = lo.y; v[2] = hi.x; v[3] = hi.y;
      *reinterpret_cast<u32x4*>(oqm + (ks * 64 + lane) * 16) = v;
    }
    __builtin_amdgcn_wave_barrier();
  }
}
__device__ __forceinline__ void ph_rwkv_pq(const Params& p, int bid, int nb) {
  const int lane = threadIdx.x & 63, wv = threadIdx.x >> 6;
  const int nitems = NB_ * 8 * NCH;
  for (int wi = bid * 4 + wv; wi < nitems; wi += nb * 4) {
    const int chunk = wi % NCH, bh = wi / NCH, b = bh >> 3, h = bh & 7;
    const size_t o0 = ((size_t)b * L + chunk * 16) * 512 + h * 64 + lane;
    float pdv[16];
    const float rkc = p.r_k[h * 64 + lane];
#pragma unroll
    for (int t = 0; t < 16; ++t) { const size_t o = o0 + (size_t)t * 512; pdv[t] = bf2f(p.rr[o]) * bf2f(p.rk2[o]) * rkc; }
    const float s3l = tr_reduce16(pdv, lane);
    const float lnw = p.ln_w[h * 64 + lane], lnb = p.ln_b[h * 64 + lane];
    bf16_t gtv[16], vtv[16];
#pragma unroll
    for (int t = 0; t < 16; ++t) { const size_t o = o0 + (size_t)t * 512; gtv[t] = p.rg[o]; vtv[t] = p.rv[o]; }
#pragma unroll
    for (int t = 0; t < 16; ++t) {
      const float s3 = __int_as_float(__builtin_amdgcn_readlane(__float_as_int(s3l), 4 * t));
      const size_t o = o0 + (size_t)t * 512;
      const float gt = bf2f(gtv[t]), vt_ = bf2f(vtv[t]);
      p.rlw[o] = f2bf(lnw * gt);
      p.rbb[o] = f2bf((lnb + s3 * vt_) * gt);
    }
  }
}
struct ChainRegs { u32x4 s0, s1; u32x2 wt, zt, vb, pp, qq; float gcs; };
__device__ __forceinline__ void chain_load(const Params& p, int wi, unsigned ytok, int it, int lane, ChainRegs& c) {
  const unsigned char* q0 = (it < 2 ? p.cd_ah : p.cd_qm) + (size_t)wi * 2048 + (it & 1) * 1024;
  c.gcs = p.cd_gc[(size_t)wi * 64 + lane];
  c.s0 = *reinterpret_cast<const u32x4*>(q0 + lane * 16);
  c.s1 = *reinterpret_cast<const u32x4*>(p.cd_bk + (size_t)wi * 4096 + it * 1024 + lane * 16);
  c.wt = *reinterpret_cast<const u32x2*>(p.cd_wt + (size_t)wi * 2048 + (it * 64 + lane) * 8);
  c.zt = *reinterpret_cast<const u32x2*>(p.cd_zt + (size_t)wi * 2048 + (it * 64 + lane) * 8);
  c.vb = *reinterpret_cast<const u32x2*>(p.cd_vb + (size_t)wi * 2048 + (it * 64 + lane) * 8);
  c.pp = *reinterpret_cast<const u32x2*>(p.rlw + ytok);
  c.qq = *reinterpret_cast<const u32x2*>(p.rbb + ytok);
}
__device__ __forceinline__ void chain_publish(char* sh, int it, int lane, const ChainRegs& c) {
  *reinterpret_cast<u32x4*>(sh + it * 1024 + lane * 16) = c.s0;
  *reinterpret_cast<u32x4*>(sh + 4096 + it * 1024 + lane * 16) = c.s1;
  if (it == 0) reinterpret_cast<float*>(sh + 8192)[lane] = c.gcs;
}
__device__ __forceinline__ float dpp_sum16(float v) {
  v += __int_as_float(__builtin_amdgcn_update_dpp(0, __float_as_int(v), 0xB1, 0xF, 0xF, true));
  v += __int_as_float(__builtin_amdgcn_update_dpp(0, __float_as_int(v), 0x4E, 0xF, 0xF, true));
  v += __int_as_float(__builtin_amdgcn_update_dpp(0, __float_as_int(v), 0x141, 0xF, 0xF, true));
  v += __int_as_float(__builtin_amdgcn_update_dpp(0, __float_as_int(v), 0x140, 0xF, 0xF, true));
  return v;
}
template <bool STORE>
__device__ __forceinline__ void chain_finalize(const Params& p, const char* otile, unsigned ytok, u32x2 pp, u32x2 qq) {
  const int tid = threadIdx.x;
  const f32x4 o4 = *reinterpret_cast<const f32x4*>(otile + (tid >> 4) * 256 + (tid & 15) * 16);
  const float s1 = dpp_sum16(o4[0] + o4[1] + o4[2] + o4[3]);
  const float s2 = dpp_sum16(o4[0] * o4[0] + o4[1] * o4[1] + o4[2] * o4[2] + o4[3] * o4[3]);
  const float mean = s1 * (1.0f / 64);
  const float var = fmaxf(s2 * (1.0f / 64) - mean * mean, 0.0f);
  const float istd = rsqrtf(var + 64e-5f);
  const f32x4 y = (o4 - mean) * istd * unpk4(pp) + unpk4(qq);
  if (STORE) *reinterpret_cast<uint2*>(p.rkk + ytok) = pack4bf(y[0], y[1], y[2], y[3]);
  else asm volatile("" :: "v"(y[0]), "v"(y[1]), "v"(y[2]), "v"(y[3]));
}
template <bool STORE>
__device__ __forceinline__ void chain_step(const Params& p, char* otile, const char* otile_prev, bool have_prev, unsigned ytok_prev, u32x2 pp_prev, u32x2 qq_prev,
                                           const char* sh, char* shn, int it, int lane,
                                           const ChainRegs& c, const ChainRegs& cn, f32x4 (&st)[4]) {
  const int g = lane >> 4, r16 = lane & 15;
  const float* gcur = reinterpret_cast<const float*>(sh + 8192);
  u32x4 s0, s1;
  {
    const uint2 a = pack4bf(st[0][0], st[0][1], st[0][2], st[0][3]), b = pack4bf(st[1][0], st[1][1], st[1][2], st[1][3]);
    const uint2 cc = pack4bf(st[2][0], st[2][1], st[2][2], st[2][3]), d = pack4bf(st[3][0], st[3][1], st[3][2], st[3][3]);
    s0[0] = a.x; s0[1] = a.y; s0[2] = b.x; s0[3] = b.y;
    s1[0] = cc.x; s1[1] = cc.y; s1[2] = d.x; s1[3] = d.y;
  }
  const bf16x8 sb0 = __builtin_bit_cast(bf16x8, s0), sb1 = __builtin_bit_cast(bf16x8, s1);
  f32x4 ut = unpk4(c.wt), ot = unpk4(c.zt);
  ut = MFMA32(*reinterpret_cast<const bf16x8*>(sh + lane * 16), sb0, ut);
  ot = MFMA32(*reinterpret_cast<const bf16x8*>(sh + 2048 + lane * 16), sb0, ot);
  ut = MFMA32(*reinterpret_cast<const bf16x8*>(sh + 1024 + lane * 16), sb1, ut);
  ot = MFMA32(*reinterpret_cast<const bf16x8*>(sh + 3072 + lane * 16), sb1, ot);
  chain_publish(shn, it, lane, cn);
  if (have_prev) chain_finalize<STORE>(p, otile_prev, ytok_prev, pp_prev, qq_prev);
#pragma unroll
  for (int r = 0; r < 4; ++r) *reinterpret_cast<float*>(otile + (4 * g + r) * 256 + (16 * it + r16) * 4) = ot[r];
  const uint2 u2 = pack4bf(ut[0], ut[1], ut[2], ut[3]);
  u32x4 uv; uv[0] = u2.x; uv[1] = u2.y; uv[2] = c.vb[0]; uv[3] = c.vb[1];
  const bf16x8 uvb = __builtin_bit_cast(bf16x8, uv);
#pragma unroll
  for (int q = 0; q < 4; ++q)
    st[q] = MFMA32(*reinterpret_cast<const bf16x8*>(sh + 4096 + q * 1024 + lane * 16), uvb, st[q] * *reinterpret_cast<const f32x4*>(gcur + 16 * q + 4 * g));
  __syncthreads();
}
template <bool STORE = true>
__device__ __forceinline__ void ph_chain(const Params& p, char* smem, int bid, int nb) {
  const int tid = threadIdx.x, lane = tid & 63, it = tid >> 6;
  char* shb = smem + 8192;
  for (int bh = bid; bh < NB_ * 8; bh += nb) {
    f32x4 st[4];
#pragma unroll
    for (int q = 0; q < 4; ++q) st[q] = (f32x4){0.f, 0.f, 0.f, 0.f};
    const int w0 = bh * NCH;
    const int b = bh >> 3, h = bh & 7;
    const unsigned y0 = (unsigned)((b * L + (tid >> 4)) * 512 + h * 64 + (tid & 15) * 4);
    ChainRegs c0, c1, c2, c3, c4, c5, c6, c7;
#define CH_LOAD(cc, set) chain_load(p, w0 + min((cc), NCH - 1), y0 + (unsigned)min((cc), NCH - 1) * 8192u, it, lane, set)
    CH_LOAD(0, c0); CH_LOAD(1, c1); CH_LOAD(2, c2); CH_LOAD(3, c3); CH_LOAD(4, c4); CH_LOAD(5, c5); CH_LOAD(6, c6); CH_LOAD(7, c7);
    __syncthreads();
    chain_publish(shb, it, lane, c0);
    __syncthreads();
    u32x2 ppp = {0u, 0u}, qqp = {0u, 0u};
#define CH_STEP(cc, cur, nxt) { const int par = (cc) & 1; \
      chain_step<STORE>(p, smem + par * 4096, smem + (1 - par) * 4096, (cc) > 0, y0 + (unsigned)((cc) - 1) * 8192u, ppp, qqp, \
                        shb + par * 8448, shb + (1 - par) * 8448, it, lane, cur, nxt, st); \
      ppp = cur.pp; qqp = cur.qq; CH_LOAD((cc) + 8, cur); }
    for (int ch = 0; ch < 128; ch += 8) {
      CH_STEP(ch, c0, c1) CH_STEP(ch + 1, c1, c2) CH_STEP(ch + 2, c2, c3) CH_STEP(ch + 3, c3, c4)
      CH_STEP(ch + 4, c4, c5) CH_STEP(ch + 5, c5, c6) CH_STEP(ch + 6, c6, c7) CH_STEP(ch + 7, c7, c0)
    }
    CH_STEP(128, c0, c1)
#undef CH_STEP
#undef CH_LOAD
    chain_finalize<STORE>(p, smem + ((NCH - 1) & 1) * 4096, y0 + (unsigned)(NCH - 1) * 8192u, ppp, qqp);
    __syncthreads();
  }
}
__device__ __forceinline__ void ph_tabconv(const Params& p, int bid, int nb) {
  const int nvec = 2 * 16384 * 256;
  const int stride = nb * NTHR;
  for (int base = bid * NTHR + threadIdx.x; base < nvec; base += 8 * stride) {
    f32x4 v[8];
#pragma unroll
    for (int k = 0; k < 8; ++k) {
      const int i = min(base + k * stride, nvec - 1);
      const bool tab = i >= 16384 * 256;
      v[k] = *reinterpret_cast<const f32x4*>((tab ? p.pv : p.pu) + (size_t)(tab ? i - 16384 * 256 : i) * 4);
    }
#pragma unroll
    for (int k = 0; k < 8; ++k) {
      const int i = min(base + k * stride, nvec - 1);
      const bool tab = i >= 16384 * 256;
      f32x4 w = v[k] * (tab ? 16.0f : 256.0f);
      if (!tab) w *= *reinterpret_cast<const f32x4*>(p.g_ffn + (i & 255) * 4);
      int wv = __builtin_amdgcn_cvt_pk_fp8_f32(w[0], w[1], 0, false);
      wv = __builtin_amdgcn_cvt_pk_fp8_f32(w[2], w[3], wv, true);
      *reinterpret_cast<unsigned*>((tab ? p.v8 : p.u8) + (size_t)(tab ? i - 16384 * 256 : i) * 4) = (unsigned)wv;
    }
  }
}
__device__ __forceinline__ void ph_outproj(const Params& p, char* smem, int bid, int nb) {
  const int lane = threadIdx.x & 63, w = threadIdx.x >> 6, wm = w >> 1, wn = w & 1, g = lane >> 4, r16 = lane & 15;
  for_tiles_xcd(TR / 128, 4, bid, nb, [&](int tm, int tn) {
    const int m0 = tm * 128, n0 = tn * 256;
    f32x4 acc[4][8];
    gemm_tile_wide(smem, m0, n0, 32,
        [&](int r, int k) {
          const size_t tt = (size_t)rt2tt(r);
          return k < 512 ? p.qf + tt * 768 + (k >> 7) * 192 + (k & 127) : p.rkk + tt * 512 + (k - 512);
        },
        [&](int n, int k) { return p.w_outT + (size_t)n * 1024 + k; }, acc,
        [&](int kt, f32x4 (&a)[4][8]) {
          if (kt == 16) {
#pragma unroll
            for (int i = 0; i < 4; ++i) {
              const f32x4 q4 = *reinterpret_cast<const f32x4*>(p.ossq + (size_t)rt2tt(m0 + wm * 64 + 16 * i + r16) * 4);
              const float rs = rsqrtf((q4[0] + q4[1] + q4[2] + q4[3]) * (1.0f / 512) + RMS_EPS);
#pragma unroll
              for (int j = 0; j < 8; ++j) a[i][j] *= rs;
            }
          }
        });
#pragma unroll 1
    for (int half = 0; half < 2; ++half) {
      stage_acc_half(smem, acc, half);
#pragma unroll 1
      for (int qb = 0; qb < 8; qb += 4) {
      f32x4 hh[4][2];
#pragma unroll
      for (int qi = 0; qi < 4; ++qi) {
        const int c = threadIdx.x + 256 * (qb + qi);
        const float* hr = hrow(p, rt2tt(m0 + (c >> 4))) + n0 + half * 128 + (c & 15) * 8;
        hh[qi][0] = *reinterpret_cast<const f32x4*>(hr); hh[qi][1] = *reinterpret_cast<const f32x4*>(hr + 4);
      }
#pragma unroll
      for (int qi = 0; qi < 4; ++qi) {
        const int q = qb + qi;
        const int c = threadIdx.x + 256 * q;
        const int row = c >> 4, col8 = (c & 15) * 8;
        const int m = m0 + row, n = n0 + half * 128 + col8;
        const f32x4 h0 = hh[qi][0], h1 = hh[qi][1];
        float v[8];
        ld8(smem, row, col8, v);
        float sq = 0.f;
#pragma unroll
        for (int e = 0; e < 8; ++e) { v[e] += e < 4 ? h0[e] : h1[e - 4]; sq += v[e] * v[e]; }
        f32x4 o0, o1;
#pragma unroll
        for (int e = 0; e < 4; ++e) { o0[e] = v[e]; o1[e] = v[4 + e]; }
        *reinterpret_cast<f32x4*>(p.out + (size_t)m * D + n) = o0;
        *reinterpret_cast<f32x4*>(p.out + (size_t)m * D + n + 4) = o1;
        st8f(p.h2b + (size_t)m * D + n, v);
        sq += __shfl_xor(sq, 1, 64); sq += __shfl_xor(sq, 2, 64); sq += __shfl_xor(sq, 4, 64); sq += __shfl_xor(sq, 8, 64);
        if ((threadIdx.x & 15) == 0) atomicAdd(p.h2ss + m, sq);
      }
      }
    }
  });
}
#define CE_(a, b) { const int t_ = max(a, b); b = min(a, b); a = t_; }
__device__ __forceinline__ int fkey7(float x, int idx) {
  int b = __float_as_int(x);
  b ^= (b >> 31) & 0x7fffffff;
  return (b & ~127) | (127 - idx);
}
__device__ __forceinline__ float fvalm(int k, int mask) {
  int b = k & ~mask;
  b ^= (b >> 31) & 0x7fffffff;
  return __int_as_float(b);
}
__device__ __forceinline__ void bitonic_sort16(int (&v)[16]) {
#pragma unroll
  for (int k = 2; k <= 16; k <<= 1)
#pragma unroll
    for (int j = k >> 1; j > 0; j >>= 1)
#pragma unroll
      for (int i = 0; i < 16; ++i) {
        const int l = i ^ j;
        if (l > i) {
          if ((i & k) == 0) { CE_(v[i], v[l]); } else { CE_(v[l], v[i]); }
        }
      }
}
__device__ __forceinline__ void bitonic_merge16(int (&v)[16]) {
#pragma unroll
  for (int j = 8; j > 0; j >>= 1)
#pragma unroll
    for (int i = 0; i < 16; ++i) {
      const int l = i ^ j;
      if (l > i) { CE_(v[i], v[l]); }
    }
}
__device__ __forceinline__ void ph_route(const Params& p, char* smem, int bid, int nb) {
  const int tid = threadIdx.x, lane = tid & 63, w = tid >> 6, wm = w >> 1, wn = w & 1, g = lane >> 4, r16 = lane & 15;
  int* L2l = reinterpret_cast<int*>(smem);
  int* Lx = reinterpret_cast<int*>(smem + 8192);
  int* L1l = reinterpret_cast<int*>(smem + 67584);
  for_tiles_xcd(TR / 128, 8, bid, nb, [&](int mt, int h) {
    const int m0 = mt * 128;
    for (int c = 0; c < 2; ++c) {
      f32x4 acc[4][4];
      gemm_tile_glds<true>(smem, m0, (2 * h + c) * 128, 32,
          [&](int r, int k) { return p.h2b + (size_t)r * D + k; },
          [&](int n, int k) { return p.w_qT + (size_t)n * 1024 + k; }, acc);
      float* Et = reinterpret_cast<float*>(smem);
#pragma unroll
      for (int i = 0; i < 4; ++i)
#pragma unroll
        for (int j = 0; j < 4; ++j)
          *reinterpret_cast<f32x4*>(Et + (wm * 64 + 16 * i + r16) * 132 + wn * 64 + 16 * j + 4 * g) = acc[i][j];
      __syncthreads();
      f32x4 sc[2][8];
#pragma unroll
      for (int tt = 0; tt < 2; ++tt)
#pragma unroll
        for (int kt = 0; kt < 8; ++kt) sc[tt][kt] = *reinterpret_cast<const f32x4*>(Et + (32 * w + 16 * tt + r16) * 132 + 16 * kt + 4 * g);
      __syncthreads();
#pragma unroll
      for (int tt = 0; tt < 2; ++tt) {
        int lo[16], hi[16];
#pragma unroll
        for (int kt = 0; kt < 4; ++kt)
#pragma unroll
          for (int r = 0; r < 4; ++r) {
            lo[kt * 4 + r] = fkey7(sc[tt][kt][r], 16 * kt + 4 * g + r);
            hi[kt * 4 + r] = fkey7(sc[tt][kt + 4][r], 16 * (kt + 4) + 4 * g + r);
          }
        bitonic_sort16(lo);
        bitonic_sort16(hi);
#pragma unroll
        for (int i = 0; i < 16; ++i) lo[i] = max(lo[i], hi[15 - i]);
        bitonic_merge16(lo);
#pragma unroll
        for (int st = 16; st <= 32; st <<= 1) {
          int ot[16];
#pragma unroll
          for (int i = 0; i < 16; ++i) ot[i] = __shfl_xor(lo[15 - i], st, 64);
#pragma unroll
          for (int i = 0; i < 16; ++i) lo[i] = max(lo[i], ot[i]);
          bitonic_merge16(lo);
        }
        if (g == 0) {
          int* dst = (c ? L2l : L1l) + (32 * w + 16 * tt + r16) * 16;
#pragma unroll
          for (int q = 0; q < 4; ++q) {
            u32x4 v; v[0] = lo[4 * q]; v[1] = lo[4 * q + 1]; v[2] = lo[4 * q + 2]; v[3] = lo[4 * q + 3];
            *reinterpret_cast<u32x4*>(dst + 4 * q) = v;
          }
        }
      }
      __syncthreads();
    }
    {
      const int tok = tid & 127, half = tid >> 7;
      int k1[16], k2[16];
      float v1[16], v2[16];
#pragma unroll
      for (int q = 0; q < 4; ++q) {
        const u32x4 a = *reinterpret_cast<const u32x4*>(L1l + tok * 16 + 4 * q);
        const u32x4 b = *reinterpret_cast<const u32x4*>(L2l + tok * 16 + 4 * q);
#pragma unroll
        for (int e = 0; e < 4; ++e) { k1[4 * q + e] = (int)a[e]; k2[4 * q + e] = (int)b[e]; }
      }
#pragma unroll
      for (int i = 0; i < 16; ++i) { v1[i] = fvalm(k1[i], 127); v2[i] = fvalm(k2[i], 127); }
      int lst[16];
#pragma unroll
      for (int i = 0; i < 16; ++i) lst[i] = (int)0x80000000;
      if (half == 0) {
#pragma unroll
        for (int a = 0; a < 2; ++a)
#pragma unroll
          for (int b = 0; b < 16 / (a + 1); ++b) {
            int x = __float_as_int(v1[a] + v2[b]);
            x ^= (x >> 31) & 0x7fffffff;
            x = (x & ~255) | (255 - (a * 16 + b));
#pragma unroll
            for (int i = 0; i < 16; ++i) CE_(lst[i], x);
          }
      } else {
#pragma unroll
        for (int a = 2; a < 16; ++a)
#pragma unroll
          for (int b = 0; b < 16 / (a + 1); ++b) {
            int x = __float_as_int(v1[a] + v2[b]);
            x ^= (x >> 31) & 0x7fffffff;
            x = (x & ~255) | (255 - (a * 16 + b));
#pragma unroll
            for (int i = 0; i < 16; ++i) CE_(lst[i], x);
          }
      }
#pragma unroll
      for (int q = 0; q < 4; ++q) {
        u32x4 v; v[0] = lst[4 * q]; v[1] = lst[4 * q + 1]; v[2] = lst[4 * q + 2]; v[3] = lst[4 * q + 3];
        *reinterpret_cast<u32x4*>(Lx + (half * 128 + tok) * 16 + 4 * q) = v;
      }
      __syncthreads();
      int fin[16];
#pragma unroll
      for (int q = 0; q < 4; ++q) {
        const u32x4 o = *reinterpret_cast<const u32x4*>(Lx + ((1 - half) * 128 + tok) * 16 + 4 * q);
#pragma unroll
        for (int e = 0; e < 4; ++e) fin[4 * q + e] = (int)o[e];
      }
#pragma unroll
      for (int i = 0; i < 8; ++i) { const int t_ = fin[i]; fin[i] = fin[15 - i]; fin[15 - i] = t_; }
#pragma unroll
      for (int i = 0; i < 16; ++i) fin[i] = max(fin[i], lst[i]);
      float sv[16], mx = -1e30f;
      const float rs2 = rsqrtf(p.h2ss[m0 + tok] * (1.0f / D) + RMS_EPS);
#pragma unroll
      for (int i = 0; i < 16; ++i) { sv[i] = fvalm(fin[i], 255); mx = fmaxf(mx, sv[i]); }
      float sum = 0.f;
#pragma unroll
      for (int i = 0; i < 16; ++i) { sv[i] = __expf((sv[i] - mx) * rs2); sum += sv[i]; }
      const float isum = 1.0f / sum;
      const size_t ob = (size_t)(m0 + tok) * 128 + h * 16 + half * 8;
#pragma unroll
      for (int i = 0; i < 8; ++i) {
        const int code = 255 - (fin[i] & 255);
        const int a = code >> 4, b = code & 15;
        const int i1 = 127 - (L1l[tok * 16 + a] & 127), i2 = 127 - (L2l[tok * 16 + b] & 127);
        p.pidx[ob + i] = i1 * 128 + i2;
        p.pgate[ob + i] = sv[i] * isum;
      }
    }
    __syncthreads();
  });
}
__device__ __forceinline__ void ph_expert(const Params& p, char* smem, int bid, int nb) {
  const int lane = threadIdx.x & 63, wv = threadIdx.x >> 6;
  const int g3 = lane >> 3, p8 = lane & 7;
  const bool b5 = lane & 32, b4 = lane & 16, b3 = lane & 8;
  unsigned* idxl = reinterpret_cast<unsigned*>(smem + wv * 8192);
  float* al = reinterpret_cast<float*>(smem + wv * 8192 + 4096);
  for (int grp = bid * 4 + wv; grp < TR / 8; grp += nb * 4) {
    const int rt0 = grp * 8;
    float rs2[8];
#pragma unroll
    for (int t = 0; t < 8; ++t) {
      rs2[t] = rsqrtf(p.h2ss[rt0 + t] * (1.0f / D) + RMS_EPS);
      const size_t pb = (size_t)(rt0 + t) * 128;
      idxl[t * 128 + lane] = (unsigned)p.pidx[pb + lane] << 10;
      idxl[t * 128 + 64 + lane] = (unsigned)p.pidx[pb + 64 + lane] << 10;
      al[t * 128 + lane] = p.pgate[pb + lane];
      al[t * 128 + 64 + lane] = p.pgate[pb + 64 + lane];
    }
    __builtin_amdgcn_wave_barrier();
    float dacc[8][2];
#pragma unroll
    for (int t = 0; t < 8; ++t) { dacc[t][0] = 0.f; dacc[t][1] = 0.f; }
#pragma unroll 1
    for (int x = 0; x < 8; ++x) {
      const unsigned coff = 128u * x + 16u * p8;
#pragma unroll 1
      for (int t = 0; t < 8; ++t) {
        f32x2 xp[8];
        {
          const bf16_t* hr = p.h2b + (size_t)(rt0 + t) * D + coff;
          const u32x4 a = *reinterpret_cast<const u32x4*>(hr);
          const u32x4 b = *reinterpret_cast<const u32x4*>(hr + 8);
#pragma unroll
          for (int q = 0; q < 4; ++q) {
            xp[q][0] = __uint_as_float(a[q] << 16); xp[q][1] = __uint_as_float(a[q] & 0xffff0000u);
            xp[4 + q][0] = __uint_as_float(b[q] << 16); xp[4 + q][1] = __uint_as_float(b[q] & 0xffff0000u);
          }
        }
        u32x4 rows[16];
#pragma unroll
        for (int j = 0; j < 16; ++j) {
          const unsigned off = idxl[t * 128 + 8 * j + g3];
          rows[j] = *reinterpret_cast<const u32x4*>(p.u8 + off + coff);
        }
#pragma unroll
        for (int j = 0; j < 16; ++j) {
          f32x2 acc2 = {0.f, 0.f};
#pragma unroll
          for (int q = 0; q < 4; ++q) {
            acc2 += xp[2 * q] * __builtin_amdgcn_cvt_pk_f32_fp8((int)rows[j][q], false);
            acc2 += xp[2 * q + 1] * __builtin_amdgcn_cvt_pk_f32_fp8((int)rows[j][q], true);
          }
          const float sm = dpp_sum8(acc2[0] + acc2[1]);
          if (p8 == (j & 7)) dacc[0][j >> 3] += sm;
        }
        {
          const float r0 = dacc[0][0], r1 = dacc[0][1];
#pragma unroll
          for (int q = 0; q < 7; ++q) { dacc[q][0] = dacc[q + 1][0]; dacc[q][1] = dacc[q + 1][1]; }
          dacc[7][0] = r0; dacc[7][1] = r1;
        }
      }
    }
#pragma unroll
    for (int t = 0; t < 8; ++t)
#pragma unroll
      for (int jj = 0; jj < 2; ++jj) {
        const int slot = 8 * (p8 + 8 * jj) + g3;
        const float dot = dacc[t][jj] * rs2[t] * (1.0f / 256.0f);
        const float gt = al[t * 128 + slot];
        al[t * 128 + slot] = 0.5f * dot * (1.0f + erff(dot * 0.7071067811865476f)) * gt * (1.0f / 16.0f);
      }
    __builtin_amdgcn_wave_barrier();
    float ssq[8];
#pragma unroll
    for (int t = 0; t < 8; ++t) ssq[t] = 0.f;
    const int cw = 8 * (b5 ? 1 : 0) + 4 * (b4 ? 1 : 0) + 2 * (b3 ? 1 : 0);
#pragma unroll 1
    for (int x = 0; x < 8; ++x) {
      const unsigned coff = 128u * x + 16u * p8;
#pragma unroll 1
      for (int t = 0; t < 8; ++t) {
        u32x4 rows[16];
        float av[16];
#pragma unroll
        for (int j = 0; j < 16; ++j) {
          const unsigned off = idxl[t * 128 + 8 * j + g3];
          av[j] = al[t * 128 + 8 * j + g3];
          rows[j] = *reinterpret_cast<const u32x4*>(p.v8 + off + coff);
        }
        f32x2 oa[8];
#pragma unroll
        for (int q = 0; q < 8; ++q) oa[q] = (f32x2){0.f, 0.f};
#pragma unroll
        for (int j = 0; j < 16; ++j) {
          const f32x2 a2 = {av[j], av[j]};
#pragma unroll
          for (int q = 0; q < 4; ++q) {
            oa[2 * q] += a2 * __builtin_amdgcn_cvt_pk_f32_fp8((int)rows[j][q], false);
            oa[2 * q + 1] += a2 * __builtin_amdgcn_cvt_pk_f32_fp8((int)rows[j][q], true);
          }
        }
        f32x2 q4v[4], q2v[2], q1v;
#pragma unroll
        for (int i = 0; i < 4; ++i) {
          const f32x2 sd = b5 ? oa[i] : oa[i + 4], kp = b5 ? oa[i + 4] : oa[i];
          q4v[i][0] = kp[0] + __shfl_xor(sd[0], 32, 64); q4v[i][1] = kp[1] + __shfl_xor(sd[1], 32, 64);
        }
#pragma unroll
        for (int i = 0; i < 2; ++i) {
          const f32x2 sd = b4 ? q4v[i] : q4v[i + 2], kp = b4 ? q4v[i + 2] : q4v[i];
          q2v[i][0] = kp[0] + __shfl_xor(sd[0], 16, 64); q2v[i][1] = kp[1] + __shfl_xor(sd[1], 16, 64);
        }
        {
          const f32x2 sd = b3 ? q2v[0] : q2v[1], kp = b3 ? q2v[1] : q2v[0];
          q1v[0] = kp[0] + __shfl_xor(sd[0], 8, 64); q1v[1] = kp[1] + __shfl_xor(sd[1], 8, 64);
        }
        float* hp = p.out + (size_t)(rt0 + t) * D + coff + cw;
        const f32x2 h3 = *reinterpret_cast<const f32x2*>(hp) + q1v;
        *reinterpret_cast<f32x2*>(hp) = h3;
        {
          const float r0 = ssq[0] + h3[0] * h3[0] + h3[1] * h3[1];
#pragma unroll
          for (int q = 0; q < 7; ++q) ssq[q] = ssq[q + 1];
          ssq[7] = r0;
        }
      }
    }
    asm volatile("s_waitcnt vmcnt(0)" ::: "memory");
    {
      float rsv[8];
#pragma unroll
      for (int t = 0; t < 8; ++t) rsv[t] = rsqrtf(wave_sum(ssq[t]) * (1.0f / D) + RMS_EPS);
      f32x2 gfv[8];
#pragma unroll
      for (int x = 0; x < 8; ++x) gfv[x] = *reinterpret_cast<const f32x2*>(p.g_fin + 128 * x + 16 * p8 + cw);
      unsigned long long hv[8][8];
#pragma unroll
      for (int t = 0; t < 8; ++t)
#pragma unroll
        for (int x = 0; x < 8; ++x)
          hv[t][x] = __hip_atomic_load(reinterpret_cast<unsigned long long*>(p.out + (size_t)(rt0 + t) * D + 128 * x + 16 * p8 + cw),
                                       __ATOMIC_RELAXED, __HIP_MEMORY_SCOPE_AGENT);
#pragma unroll
      for (int t = 0; t < 8; ++t)
#pragma unroll
        for (int x = 0; x < 8; ++x) {
          f32x2 o2;
          o2[0] = __uint_as_float((unsigned)hv[t][x]) * rsv[t] * gfv[x][0];
          o2[1] = __uint_as_float((unsigned)(hv[t][x] >> 32)) * rsv[t] * gfv[x][1];
          *reinterpret_cast<f32x2*>(p.out + (size_t)(rt0 + t) * D + 128 * x + 16 * p8 + cw) = o2;
        }
    }
    __builtin_amdgcn_wave_barrier();
  }
}

#define XB_TMO      128
#define XB_XCNT(j)  (256  + 64 * (j))
#define XB_XSUB(j)  (1280 + 64 * (j))
#define XB_XGEN(j)  (2304 + 64 * (j))
#define XB_TOP      3328
#define XB_TOPGEN   3392
#define XCD_BAR_WORDS 3456
#define XB_SPIN_CAP (1u << 18)
#define LAS __attribute__((address_space(3)))
__device__ __forceinline__ unsigned xb_ld(unsigned* p) { return __hip_atomic_load(p, __ATOMIC_RELAXED, __HIP_MEMORY_SCOPE_AGENT); }
__device__ __forceinline__ unsigned xb_add(unsigned* p, unsigned v) { return __hip_atomic_fetch_add(p, v, __ATOMIC_RELAXED, __HIP_MEMORY_SCOPE_AGENT); }
__device__ __forceinline__ unsigned xb_xcc_id() { return (unsigned)__builtin_amdgcn_s_getreg((3 << 11) | 20) & 0xFu; }
#define XB_SPIN(cond, bar) do { unsigned _sp = 0; while (cond) { __builtin_amdgcn_s_sleep(1); \
    if ((++_sp & 255u) == 0u) { if (xb_ld(&(bar)[XB_TMO])) break; if (_sp > XB_SPIN_CAP) { atomicAdd(&(bar)[XB_TMO], 1u); break; } } } } while (0)
struct XcdBarrier { unsigned* bar; unsigned x; volatile LAS unsigned* st; };
__device__ __forceinline__ XcdBarrier xcd_barrier_post(unsigned* bar, volatile LAS unsigned* st) {
  XcdBarrier b; b.bar = bar; b.x = xb_xcc_id(); b.st = st;
  if (threadIdx.x == 0) (void)xb_add(&bar[XB_XCNT(b.x)], 1u);
  return b;
}
__device__ __forceinline__ void xcd_barrier_complete(unsigned* bar, unsigned x, unsigned& nloc, unsigned& nx) {
  const unsigned G = gridDim.x * gridDim.y * gridDim.z;
  unsigned sum, cnt, mine, sp = 0u;
  for (;;) {
    sum = 0u; cnt = 0u; mine = 0u;
#pragma unroll
    for (unsigned j = 0; j < 16; ++j) { const unsigned c = xb_ld(&bar[XB_XCNT(j)]); sum += c; cnt += (c > 0u) ? 1u : 0u; mine = (j == x) ? c : mine; }
    if (sum == G) break;
    __builtin_amdgcn_s_sleep(1);
    if ((++sp & 255u) == 0u) { if (xb_ld(&bar[XB_TMO])) break; if (sp > XB_SPIN_CAP) { atomicAdd(&bar[XB_TMO], 1u); break; } }
  }
  nloc = mine > 0u ? mine : 1u; nx = cnt > 0u ? cnt : 1u;
}
__device__ __forceinline__ void xcd_barrier(const XcdBarrier& b) {
  asm volatile("s_waitcnt vmcnt(0)" ::: "memory");
  __syncthreads();
  if (threadIdx.x == 0) {
    unsigned* bar = b.bar;
    __builtin_amdgcn_s_waitcnt(0);
    unsigned nloc = b.st[0], nx = b.st[1];
    if (nloc == 0u) { xcd_barrier_complete(bar, b.x, nloc, nx); b.st[0] = nloc; b.st[1] = nx; }
    const unsigned old = xb_add(&bar[XB_XSUB(b.x)], 1u);
    const unsigned gen = old / nloc;
    if (old + 1u == (gen + 1u) * nloc) {
      __builtin_amdgcn_fence(__ATOMIC_RELEASE, "agent");
      asm volatile("s_waitcnt vmcnt(0)" ::: "memory");
      const unsigned og = xb_add(&bar[XB_TOP], 1u);
      const unsigned tg = og / nx;
      if (og + 1u == (tg + 1u) * nx) xb_add(&bar[XB_TOPGEN], 1u);
      else XB_SPIN(xb_ld(&bar[XB_TOPGEN]) == tg, bar);
      __builtin_amdgcn_fence(__ATOMIC_ACQUIRE, "agent");
      xb_add(&bar[XB_XGEN(b.x)], 1u);
      asm volatile("s_waitcnt vmcnt(0)" ::: "memory");
    } else {
      XB_SPIN(xb_ld(&bar[XB_XGEN(b.x)]) == gen, bar);
      __builtin_amdgcn_fence(__ATOMIC_ACQUIRE, "agent");
      asm volatile("s_waitcnt vmcnt(0)" ::: "memory");
    }
  }
  __syncthreads();
}

constexpr int SMEM_FLOATS = 18944 + 4;


__global__ void __launch_bounds__(NTHR, 2) k_mega(Params p) {
  __shared__ __attribute__((aligned(16))) float smem[SMEM_FLOATS];
  if (threadIdx.x == 0) { smem[18944] = 0.f; smem[18945] = 0.f; smem[18946] = 0.f; smem[18947] = 0.f; }
  __syncthreads();
  const XcdBarrier xb = xcd_barrier_post(p.bar, (volatile LAS unsigned*)&smem[18944]);
  if (p.never) { cg::grid_group grid = cg::this_grid(); grid.sync(); }
  const int bid = blockIdx.x, nb = gridDim.x;
  ph_prep(p, bid, nb);
  xcd_barrier(xb);
  ph_inproj(p, (char*)smem, bid, nb);
  if (nb > 384) { if (bid >= 256) ph_w2(p, (char*)smem, bid - 256, nb - 256); }
  else ph_w2(p, (char*)smem, bid, nb);
  xcd_barrier(xb);
  ph_rwkv_prep(p, (char*)smem, bid, nb);
  ph_q_up(p, (char*)smem, bid, nb);
  ph_kv_up(p, (char*)smem, bid, nb);
  xcd_barrier(xb);
  ph_rwkv_pre(p, (char*)smem, bid, nb);
  ph_rwkv_pq(p, bid, nb);
  xcd_barrier(xb);
  if (bid < 64) ph_chain(p, (char*)smem, bid, 64);
  else { ph_attn(p, (char*)smem, bid - 64, nb - 64); ph_tabconv(p, bid - 64, nb - 64); }
  xcd_barrier(xb);
  ph_outproj(p, (char*)smem, bid, nb);
  xcd_barrier(xb);
  ph_route(p, (char*)smem, bid, nb);
  xcd_barrier(xb);
  ph_expert(p, (char*)smem, bid, nb);
}

extern "C" void kernel_launch(void* const* d_in, const int* in_sizes, int n_in, void* d_out, int out_size, void* d_ws,
                              size_t ws_size, hipStream_t stream) {
  Params p{};
  const float* const* in = reinterpret_cast<const float* const*>(d_in);
  p.x = in[0]; p.meta = in[1]; p.g_mix = in[2]; p.w_in = in[3]; p.g_q = in[4]; p.w_uq = in[5]; p.g_kv = in[6];
  p.w_ukv = in[7]; p.g_out = in[8]; p.mu = in[9]; p.w0 = in[10]; p.w_up = in[11]; p.a0 = in[12]; p.a_up = in[13];
  p.g_up = in[14]; p.k_k = in[15]; p.k_a = in[16]; p.r_k = in[17]; p.ln_w = in[18]; p.ln_b = in[19]; p.w_out = in[20];
  p.g_ffn = in[21]; p.w_q = in[22]; p.subk = in[23]; p.pu = in[24]; p.pv = in[25]; p.g_fin = in[26];
  p.out = (float*)d_out;
  char* ws = (char*)d_ws;
  size_t off = 0;
  auto take = [&](size_t bytes) { char* r = ws + off; off += (bytes + 255) & ~(size_t)255; return r; };
  p.bar = (unsigned*)take((size_t)XCD_BAR_WORDS * 4);
  p.h2ss = (float*)take((size_t)TR * 4);
  const size_t zero_bytes = off;
  p.rstd1 = (float*)take((size_t)T * 4);
  p.ossq = (float*)take((size_t)T * 4 * 4);
  p.w_inT = (bf16_t*)take((size_t)DIN * 1024 * 2);
  p.w_uqT = (bf16_t*)take((size_t)768 * 256 * 2);
  p.w_ukvT = (bf16_t*)take((size_t)1024 * 128 * 2);
  p.w_outT = (bf16_t*)take((size_t)1024 * 1024 * 2);
  p.w_qT = (bf16_t*)take((size_t)2048 * 1024 * 2);
  p.subkb = (bf16_t*)take((size_t)8 * 2 * 128 * 128 * 2);
  p.w_lrT = (bf16_t*)take((size_t)1536 * 128 * 2);
  p.ropec = (float*)take((size_t)L * 32 * 4);
  p.ropes = (float*)take((size_t)L * 32 * 4);
  char* regA = take((size_t)T * DIN * 2);
  char* regB = take((size_t)T * (768 + 1024 + 64) * 2);
  char* regBend = ws + off;
  char* regC = take((size_t)T * 512 * 2 * 7);
  if (off > ws_size) fprintf(stderr, "workspace too small: need %zu have %zu\n", off, ws_size);
  p.proj = (bf16_t*)regA;
  {
    const size_t NW = (size_t)NB_ * 8 * NCH;
    p.cd_qm = (unsigned char*)regA;
    p.cd_wt = p.cd_qm + NW * 2048;
    p.cd_zt = p.cd_wt + NW * 2048;
    p.cd_vb = p.cd_zt + NW * 2048;
    p.cd_bk = (unsigned char*)d_out;
    p.cd_ah = p.cd_bk + NW * 4096;
    p.cd_gc = (float*)(p.cd_ah + NW * 2048);
  }
  p.h2b = (bf16_t*)regA;
  p.pidx = (int*)(regA + (size_t)TR * D * 2);
  p.pgate = (float*)(regA + (size_t)TR * D * 2 + (size_t)TR * 128 * 4);
  p.qf = (bf16_t*)regB;
  p.kn = (bf16_t*)(regB + (size_t)T * 768 * 2);
  p.vt = (bf16_t*)(regB + (size_t)T * (768 + 512) * 2);
  p.kr = (bf16_t*)(regB + (size_t)T * (768 + 1024) * 2);
  p.hb = (bf16_t*)regC;
  p.w_qb = (bf16_t*)(regC + (size_t)40 * 1024 * 1024);
  bf16_t* c = (bf16_t*)regC;
  const size_t a512 = (size_t)T * 512;
  p.rr = c; p.rk2 = c + a512; p.rv = c + 2 * a512; p.rkk = c + 3 * a512; p.rbb = c + 4 * a512; p.rg = c + 5 * a512; p.rlw = c + 6 * a512;
  p.u8 = (unsigned char*)regC;
  p.v8 = p.u8 + (size_t)16384 * 1024;
  static int grid_blocks = 0;
  if (!grid_blocks) {
    int dev = 0, cus = 0, per_cu = 0;
    (void)hipGetDevice(&dev);
    (void)hipDeviceGetAttribute(&cus, hipDeviceAttributeMultiprocessorCount, dev);
    (void)hipOccupancyMaxActiveBlocksPerMultiprocessor(&per_cu, k_mega, NTHR, 0);
    if (per_cu > 2) per_cu = 2;
    grid_blocks = cus * per_cu;
  }
  (void)hipMemsetAsync(p.bar, 0, zero_bytes, stream);
  void* args[] = {&p};
  hipError_t e = hipLaunchCooperativeKernel((void*)k_mega, dim3(grid_blocks), dim3(NTHR), args, 0, stream);
  if (e != hipSuccess) fprintf(stderr, "cooperative launch failed: %s (grid %d)\n", hipGetErrorString(e), grid_blocks);
}
```

```cpp
#include <hip/hip_runtime.h>
#include <hip/hip_cooperative_groups.h>
#include <stdint.h>
#include <stdio.h>
#include <math.h>

constexpr int NB_ = 8, SEQ = 2048, NM = 16, L = 2064, T = NB_ * L, TR = NB_ * SEQ, D = 1024, DIN = 2240;
constexpr int NTHR = 256;
constexpr float RMS_EPS = 1e-6f;
typedef unsigned short bf16_t;
namespace cg = cooperative_groups;

struct Params {
  const float *x, *meta, *g_mix, *w_in, *g_q, *w_uq, *g_kv, *w_ukv, *g_out, *mu, *w0, *w_up, *a0, *a_up, *g_up,
      *k_k, *k_a, *r_k, *ln_w, *ln_b, *w_out, *g_ffn, *w_q, *subk, *pu, *pv, *g_fin;
  float* out;
  float *rstd1;
  float *ossq;
  float *h2ss;
  bf16_t* proj;
  bf16_t *qf, *kn, *vt, *kr;
  float *ropec, *ropes;
  bf16_t *rr, *rk2, *rv, *rkk, *rbb, *rg, *rlw;
  unsigned char *cd_ah, *cd_qm, *cd_bk, *cd_wt, *cd_zt, *cd_vb;
  float* cd_gc;
  bf16_t* h2b;
  int* pidx;
  float* pgate;
  unsigned* bar;
  int never;
  int pad0;
  bf16_t* hb;
  unsigned char *u8, *v8;
  bf16_t *w_inT, *w_uqT, *w_ukvT, *w_outT, *w_qT;
  bf16_t *w_qb;
  bf16_t *subkb;
  bf16_t *w_lrT;
};

typedef float f32x2_cv __attribute__((ext_vector_type(2)));
typedef __bf16 bf16x2_cv __attribute__((ext_vector_type(2)));
__device__ __forceinline__ unsigned pk2bf(float a, float b) {
  const f32x2_cv v = {a, b};
  return __builtin_bit_cast(unsigned, __builtin_convertvector(v, bf16x2_cv));
}
__device__ __forceinline__ bf16_t f2bf(float f) { return (bf16_t)(pk2bf(f, 0.0f) & 0xffffu); }
__device__ __forceinline__ float bf2f(bf16_t h) { return __uint_as_float(((unsigned)h) << 16); }
__device__ __forceinline__ float wave_sum(float v) {
#pragma unroll
  for (int o = 32; o > 0; o >>= 1) v += __shfl_xor(v, o, 64);
  return v;
}
__device__ __forceinline__ const float* hrow(const Params& p, int tt) {
  int b = tt / L, pos = tt - b * L;
  return pos < NM ? p.meta + (size_t)pos * D : p.x + ((size_t)(b * SEQ + pos - NM)) * D;
}
__device__ __forceinline__ int rt2tt(int rt) { return (rt >> 11) * L + NM + (rt & 2047); }

template <class AF, class BF, class EF>
__device__ __forceinline__ void gemm_naive(int M, int N, int K, AF af, BF bf, EF ef, int bid, int nb) {
  const int ncb = (N + 255) / 256;
  const int ntiles = (M / 8) * ncb;
  for (int tile = bid; tile < ntiles; tile += nb) {
    const int r0 = (tile / ncb) * 8;
    const int n = (tile % ncb) * 256 + threadIdx.x;
    if (n < N) {
      float a0 = 0, a1 = 0, a2 = 0, a3 = 0, a4 = 0, a5 = 0, a6 = 0, a7 = 0;
      for (int k = 0; k < K; ++k) {
        const float bv = bf(k, n);
        a0 += af(r0 + 0, k) * bv; a1 += af(r0 + 1, k) * bv; a2 += af(r0 + 2, k) * bv; a3 += af(r0 + 3, k) * bv;
        a4 += af(r0 + 4, k) * bv; a5 += af(r0 + 5, k) * bv; a6 += af(r0 + 6, k) * bv; a7 += af(r0 + 7, k) * bv;
      }
      ef(r0 + 0, n, a0); ef(r0 + 1, n, a1); ef(r0 + 2, n, a2); ef(r0 + 3, n, a3);
      ef(r0 + 4, n, a4); ef(r0 + 5, n, a5); ef(r0 + 6, n, a6); ef(r0 + 7, n, a7);
    }
  }
}


typedef __attribute__((ext_vector_type(8))) short bf16x8;
typedef __attribute__((ext_vector_type(4))) float f32x4;
typedef __attribute__((ext_vector_type(4))) unsigned u32x4;
typedef __attribute__((ext_vector_type(2))) float f32x2;
typedef __attribute__((ext_vector_type(4))) short bf16x4;
typedef __attribute__((ext_vector_type(2))) unsigned u32x2;
constexpr int NCH = 129;

__device__ __forceinline__ uint2 pack4bf(float a, float b, float c, float d) {
  uint2 r;
  r.x = pk2bf(a, b);
  r.y = pk2bf(c, d);
  return r;
}

__device__ __forceinline__ bf16x4 pk4(const f32x4 v) {
  const uint2 t = pack4bf(v[0], v[1], v[2], v[3]);
  u32x2 u; u[0] = t.x; u[1] = t.y;
  return __builtin_bit_cast(bf16x4, u);
}
__device__ __forceinline__ f32x4 unpk4(const u32x2 u) {
  f32x4 r;
  r[0] = __uint_as_float(u[0] << 16); r[1] = __uint_as_float(u[0] & 0xffff0000u);
  r[2] = __uint_as_float(u[1] << 16); r[3] = __uint_as_float(u[1] & 0xffff0000u);
  return r;
}
#define MFMA16(a, b, c) __builtin_amdgcn_mfma_f32_16x16x16bf16_1k(a, b, c, 0, 0, 0)
#define MFMA32(a, b, c) __builtin_amdgcn_mfma_f32_16x16x32_bf16(a, b, c, 0, 0, 0)

__device__ __forceinline__ float dpp_sum8(float v) {
  v += __int_as_float(__builtin_amdgcn_update_dpp(0, __float_as_int(v), 0xB1, 0xF, 0xF, true));
  v += __int_as_float(__builtin_amdgcn_update_dpp(0, __float_as_int(v), 0x4E, 0xF, 0xF, true));
  v += __int_as_float(__builtin_amdgcn_update_dpp(0, __float_as_int(v), 0x141, 0xF, 0xF, true));
  return v;
}
__device__ __forceinline__ float tr_reduce16(const float (&pd)[16], int lane) {
  const bool b5 = lane & 32, b4 = lane & 16, b3 = lane & 8, b2 = lane & 4;
  float q8[8], q4[4], q2[2], q1;
#pragma unroll
  for (int i = 0; i < 8; ++i) { const float sd = b5 ? pd[i] : pd[i + 8], kp = b5 ? pd[i + 8] : pd[i]; q8[i] = kp + __shfl_xor(sd, 32, 64); }
#pragma unroll
  for (int i = 0; i < 4; ++i) { const float sd = b4 ? q8[i] : q8[i + 4], kp = b4 ? q8[i + 4] : q8[i]; q4[i] = kp + __shfl_xor(sd, 16, 64); }
#pragma unroll
  for (int i = 0; i < 2; ++i) { const float sd = b3 ? q4[i] : q4[i + 2], kp = b3 ? q4[i + 2] : q4[i]; q2[i] = kp + __shfl_xor(sd, 8, 64); }
  { const float sd = b2 ? q2[0] : q2[1], kp = b2 ? q2[1] : q2[0]; q1 = kp + __shfl_xor(sd, 4, 64); }
  q1 += __shfl_xor(q1, 2, 64);
  q1 += __shfl_xor(q1, 1, 64);
  return q1;
}

struct NoMid { __device__ __forceinline__ void operator()(int, f32x4 (&)[4][4]) const {} };
template <bool TRANS, bool ZERO = true, bool SPLITA = false, class ALoad, class BLoad, class Mid = NoMid>
__device__ __forceinline__ void gemm_tile(char* smem, int m0, int n0, int kt0, int kt1, ALoad aload, BLoad bload, f32x4 (&acc)[4][4], Mid mid = Mid()) {
  const int tid = threadIdx.x, lane = tid & 63, w = tid >> 6, wm = w >> 1, wn = w & 1;
  const int srow = tid >> 3, sslot = tid & 7;
  const int swz = (sslot ^ (srow & 7)) << 4;
  char* sA = smem;
  char* sB = smem + 32768;
  const int g = lane >> 4, r16 = lane & 15;
  const int fa0 = (wm * 64 + r16) * 128 + (((0 + g) ^ (lane & 7)) << 4);
  const int fa1 = (wm * 64 + r16) * 128 + (((4 + g) ^ (lane & 7)) << 4);
  const int fb0 = (wn * 64 + r16) * 128 + (((0 + g) ^ (lane & 7)) << 4);
  const int fb1 = (wn * 64 + r16) * 128 + (((4 + g) ^ (lane & 7)) << 4);
  u32x4 ra[4], rb[4];
#pragma unroll
  for (int i = 0; i < 4; ++i) {
    ra[i] = aload(m0 + srow + 32 * i, kt0 * 64 + sslot * 8, i);
    rb[i] = bload(n0 + srow + 32 * i, kt0 * 64 + sslot * 8);
  }
  if constexpr (ZERO) {
#pragma unroll
    for (int i = 0; i < 4; ++i)
#pragma unroll
      for (int j = 0; j < 4; ++j) acc[i][j] = (f32x4){0.f, 0.f, 0.f, 0.f};
  }
  __syncthreads();
#pragma unroll
  for (int i = 0; i < 4; ++i) {
    *reinterpret_cast<u32x4*>(sA + (srow + 32 * i) * 128 + swz) = ra[i];
    *reinterpret_cast<u32x4*>(sB + (srow + 32 * i) * 128 + swz) = rb[i];
  }
  __syncthreads();
  for (int kt = kt0; kt < kt1; ++kt) {
    const int cur = ((kt - kt0) & 1) * 16384;
    mid(kt, acc);
    if (kt + 1 < kt1) {
#pragma unroll
      for (int i = 0; i < 4; ++i) {
        if (!SPLITA || i < 2) ra[i] = aload(m0 + srow + 32 * i, (kt + 1) * 64 + sslot * 8, i);
        rb[i] = bload(n0 + srow + 32 * i, (kt + 1) * 64 + sslot * 8);
      }
    }
#pragma unroll
    for (int ks = 0; ks < 2; ++ks) {
      if (SPLITA && ks == 1 && kt + 1 < kt1) {
#pragma unroll
        for (int i = 2; i < 4; ++i) ra[i] = aload(m0 + srow + 32 * i, (kt + 1) * 64 + sslot * 8, i);
      }
      bf16x8 af[4], bfr[4];
#pragma unroll
      for (int i = 0; i < 4; ++i) af[i] = *reinterpret_cast<const bf16x8*>(sA + cur + (ks ? fa1 : fa0) + i * 2048);
#pragma unroll
      for (int j = 0; j < 4; ++j) bfr[j] = *reinterpret_cast<const bf16x8*>(sB + cur + (ks ? fb1 : fb0) + j * 2048);
#pragma unroll
      for (int i = 0; i < 4; ++i)
#pragma unroll
        for (int j = 0; j < 4; ++j) {
          if constexpr (TRANS) acc[i][j] = __builtin_amdgcn_mfma_f32_16x16x32_bf16(bfr[j], af[i], acc[i][j], 0, 0, 0);
          else acc[i][j] = __builtin_amdgcn_mfma_f32_16x16x32_bf16(af[i], bfr[j], acc[i][j], 0, 0, 0);
        }
    }
    if (kt + 1 < kt1) {
      const int nxt = 16384 - cur;
#pragma unroll
      for (int i = 0; i < 4; ++i) {
        *reinterpret_cast<u32x4*>(sA + nxt + (srow + 32 * i) * 128 + swz) = ra[i];
        *reinterpret_cast<u32x4*>(sB + nxt + (srow + 32 * i) * 128 + swz) = rb[i];
      }
    }
    __syncthreads();
  }
}
#define GLDS16(gp, lp) __builtin_amdgcn_global_load_lds((const __attribute__((address_space(1))) void*)(gp), (__attribute__((address_space(3))) void*)(lp), 16, 0, 0)
template <bool TRANS, class APtr, class BPtr, class Mid = NoMid>
__device__ __forceinline__ void gemm_tile_glds(char* smem, int m0, int n0, int nk32, APtr aptr, BPtr bptr, f32x4 (&acc)[4][4], Mid mid = Mid()) {
  const int tid = threadIdx.x, lane = tid & 63, w = tid >> 6, wm = w >> 1, wn = w & 1;
  const int lrow = lane >> 2;
  const int schunk = ((lane & 3) ^ ((lrow >> 2) & 3)) * 8;
  const int wb = (__builtin_amdgcn_readfirstlane(tid) >> 6);
  const int g = lane >> 4, r16 = lane & 15;
  const int fsl = (g ^ ((r16 >> 2) & 3)) << 4;
  const int fa = (wm * 64 + r16) * 64 + fsl;
  const int fb = 8192 + (wn * 64 + r16) * 64 + fsl;
#pragma unroll
  for (int i = 0; i < 4; ++i)
#pragma unroll
    for (int j = 0; j < 4; ++j) acc[i][j] = (f32x4){0.f, 0.f, 0.f, 0.f};
  __syncthreads();
  auto issue = [&](int kt) {
    char* st = smem + (kt & 3) * 16384;
#pragma unroll
    for (int i = 0; i < 2; ++i) {
      const int row = 16 * wb + 64 * i + lrow;
      GLDS16(aptr(m0 + row, kt * 32 + schunk), st + (16 * wb + 64 * i) * 64);
      GLDS16(bptr(n0 + row, kt * 32 + schunk), st + 8192 + (16 * wb + 64 * i) * 64);
    }
  };
  issue(0);
  if (nk32 > 1) issue(1);
  if (nk32 > 2) issue(2);
  for (int kt = 0; kt < nk32; ++kt) {
    if (kt + 2 < nk32) asm volatile("s_waitcnt vmcnt(8)\n\ts_barrier" ::: "memory");
    else if (kt + 1 < nk32) asm volatile("s_waitcnt vmcnt(4)\n\ts_barrier" ::: "memory");
    else asm volatile("s_waitcnt vmcnt(0)\n\ts_barrier" ::: "memory");
    if (kt + 3 < nk32) issue(kt + 3);
    mid(kt, acc);
    const char* st = smem + (kt & 3) * 16384;
    bf16x8 af[4], bfr[4];
#pragma unroll
    for (int i = 0; i < 4; ++i) af[i] = *reinterpret_cast<const bf16x8*>(st + fa + i * 1024);
#pragma unroll
    for (int j = 0; j < 4; ++j) bfr[j] = *reinterpret_cast<const bf16x8*>(st + fb + j * 1024);
#pragma unroll
    for (int i = 0; i < 4; ++i)
#pragma unroll
      for (int j = 0; j < 4; ++j) {
        if constexpr (TRANS) acc[i][j] = __builtin_amdgcn_mfma_f32_16x16x32_bf16(bfr[j], af[i], acc[i][j], 0, 0, 0);
        else acc[i][j] = __builtin_amdgcn_mfma_f32_16x16x32_bf16(af[i], bfr[j], acc[i][j], 0, 0, 0);
      }
  }
  __syncthreads();
}
struct NoMidW { __device__ __forceinline__ void operator()(int, f32x4 (&)[4][8]) const {} };
template <class APtr, class BPtr, class Mid = NoMidW>
__device__ __forceinline__ void gemm_tile_wide(char* smem, int m0, int n0, int nk32, APtr aptr, BPtr bptr, f32x4 (&acc)[4][8], Mid mid = Mid()) {
  const int tid = threadIdx.x, lane = tid & 63, w = tid >> 6, wm = w >> 1, wn = w & 1;
  const int lrow = lane >> 2;
  const int schunk = ((lane & 3) ^ ((lrow >> 2) & 3)) * 8;
  const int wb = (__builtin_amdgcn_readfirstlane(tid) >> 6);
  const int g = lane >> 4, r16 = lane & 15;
  const int fsl = (g ^ ((r16 >> 2) & 3)) << 4;
  const int fa = (wm * 64 + r16) * 64 + fsl;
  const int fb = 8192 + (wn * 128 + r16) * 64 + fsl;
#pragma unroll
  for (int i = 0; i < 4; ++i)
#pragma unroll
    for (int j = 0; j < 8; ++j) acc[i][j] = (f32x4){0.f, 0.f, 0.f, 0.f};
  __syncthreads();
  auto issue = [&](int kt) {
    char* st = smem + (kt % 3) * 24576;
#pragma unroll
    for (int i = 0; i < 2; ++i) GLDS16(aptr(m0 + 16 * wb + 64 * i + lrow, kt * 32 + schunk), st + (16 * wb + 64 * i) * 64);
#pragma unroll
    for (int i = 0; i < 4; ++i) GLDS16(bptr(n0 + 16 * wb + 64 * i + lrow, kt * 32 + schunk), st + 8192 + (16 * wb + 64 * i) * 64);
  };
  issue(0);
  if (nk32 > 1) issue(1);
  for (int kt = 0; kt < nk32; ++kt) {
    if (kt + 1 < nk32) asm volatile("s_waitcnt vmcnt(6)\n\ts_barrier" ::: "memory");
    else asm volatile("s_waitcnt vmcnt(0)\n\ts_barrier" ::: "memory");
    if (kt + 2 < nk32) issue(kt + 2);
    mid(kt, acc);
    const char* st = smem + (kt % 3) * 24576;
    bf16x8 af[4], bfr[8];
#pragma unroll
    for (int i = 0; i < 4; ++i) af[i] = *reinterpret_cast<const bf16x8*>(st + fa + i * 1024);
#pragma unroll
    for (int j = 0; j < 8; ++j) bfr[j] = *reinterpret_cast<const bf16x8*>(st + fb + j * 1024);
#pragma unroll
    for (int i = 0; i < 4; ++i)
#pragma unroll
      for (int j = 0; j < 8; ++j) acc[i][j] = __builtin_amdgcn_mfma_f32_16x16x32_bf16(bfr[j], af[i], acc[i][j], 0, 0, 0);
  }
  __syncthreads();
}
__device__ __forceinline__ void stage_acc_half(char* smem, const f32x4 (&acc)[4][8], int half) {
  const int lane = threadIdx.x & 63, w = threadIdx.x >> 6, wm = w >> 1, wn = w & 1, g = lane >> 4, r16 = lane & 15;
  float* Et = reinterpret_cast<float*>(smem);
  __syncthreads();
  if (wn == half) {
#pragma unroll
    for (int i = 0; i < 4; ++i)
#pragma unroll
      for (int j = 0; j < 8; ++j)
        *reinterpret_cast<f32x4*>(Et + (wm * 64 + 16 * i + r16) * 132 + 16 * j + 4 * g) = acc[i][j];
  }
  __syncthreads();
}
template <class Body>
__device__ __forceinline__ void for_tiles_xcd(int MT, int NT, int bid, int nb, Body body, int rshift = 0) {
  if (nb & 7) {
    for (int e = bid; e < MT * NT; e += nb) body(e / NT, e % NT);
    return;
  }
  const int x = bid & 7, lb = bid >> 3, nlb = nb >> 3;
  const int mper = (MT >> 3) & ~3;
  const int main_cnt = mper * NT;
  for (int q = lb; q < main_cnt; q += nlb) {
    const int patch = q / (4 * NT), r = q - patch * (4 * NT);
    body(x * mper + patch * 4 + (r & 3), r >> 2);
  }
  const int rem = (MT - 8 * mper) * NT;
  const int rb = ((nb - 1 - bid - rshift) % nb + nb) % nb;
  for (int e = rb; e < rem; e += nb) body(8 * mper + e / NT, e % NT);
}
__device__ __forceinline__ void st8f(bf16_t* dst, const float (&v)[8]) {
  u32x4 w;
#pragma unroll
  for (int e = 0; e < 4; ++e) w[e] = pk2bf(v[2 * e], v[2 * e + 1]);
  *reinterpret_cast<u32x4*>(dst) = w;
}
__device__ __forceinline__ void stage_acc(char* smem, const f32x4 (&acc)[4][4]) {
  const int lane = threadIdx.x & 63, w = threadIdx.x >> 6, wm = w >> 1, wn = w & 1, g = lane >> 4, r16 = lane & 15;
  float* Et = reinterpret_cast<float*>(smem);
#pragma unroll
  for (int i = 0; i < 4; ++i)
#pragma unroll
    for (int j = 0; j < 4; ++j)
      *reinterpret_cast<f32x4*>(Et + (wm * 64 + 16 * i + r16) * 132 + wn * 64 + 16 * j + 4 * g) = acc[i][j];
  __syncthreads();
}
__device__ __forceinline__ void ld8(const char* smem, int row, int col8, float (&v)[8]) {
  const float* Et = reinterpret_cast<const float*>(smem);
  const f32x4 a = *reinterpret_cast<const f32x4*>(Et + row * 132 + col8), b = *reinterpret_cast<const f32x4*>(Et + row * 132 + col8 + 4);
#pragma unroll
  for (int e = 0; e < 4; ++e) { v[e] = a[e]; v[4 + e] = b[e]; }
}
__device__ __forceinline__ float sumsq8(const u32x4 v) {
  float s = 0.f;
#pragma unroll
  for (int q = 0; q < 4; ++q) {
    const float lo = __uint_as_float(v[q] << 16), hi = __uint_as_float(v[q] & 0xffff0000u);
    s += lo * lo + hi * hi;
  }
  return s;
}
__device__ __forceinline__ void rowss_publish(float* rowss, const float (&ss)[4]) {
  const int srow = threadIdx.x >> 3, sslot = threadIdx.x & 7;
#pragma unroll
  for (int i = 0; i < 4; ++i) {
    float v = ss[i];
    v += __shfl_xor(v, 1, 64); v += __shfl_xor(v, 2, 64); v += __shfl_xor(v, 4, 64);
    if (sslot == 0) rowss[srow + 32 * i] = v;
  }
  __syncthreads();
}
template <bool TRANS, class ARow, class BRow, class Epi>
__device__ __forceinline__ void gemm_bf16(char* smem, int mtiles, int N, int K, ARow arow, BRow brow,
                                          Epi epi, int bid, int nb) {
  const int lane = threadIdx.x & 63, w = threadIdx.x >> 6, wm = w >> 1, wn = w & 1, g = lane >> 4, r16 = lane & 15;
  const int ntn = (N + 127) >> 7;
  for (int tile = bid; tile < mtiles * ntn; tile += nb) {
    const int tm = tile / ntn, tn = tile - tm * ntn;
    const int m0 = tm * 128, n0 = tn * 128;
    f32x4 acc[4][4];
    gemm_tile<TRANS>(smem, m0, n0, 0, K >> 6,
        [&](int r, int k, int) { return *reinterpret_cast<const u32x4*>(arow(r) + k); },
        [&](int n, int k) { return *reinterpret_cast<const u32x4*>(brow(min(n, N - 1)) + k); }, acc);
    if constexpr (TRANS) epi(acc, m0 + wm * 64 + r16, n0 + wn * 64 + 4 * g);
    else epi(acc, m0 + wm * 64 + 4 * g, n0 + wn * 64 + r16);
  }
}

__device__ __forceinline__ void wtrans(const float* __restrict__ W, const float* __restrict__ gk, int K, int N, bf16_t* out,
                                       int gtid, int gthreads, int glim = 1 << 30) {
  const int total = N * (K >> 3);
  for (int idx = gtid; idx < total; idx += gthreads) {
    const int n = idx % N, kc = idx / N;
    float v[8];
#pragma unroll
    for (int i = 0; i < 8; ++i) {
      const int k = kc * 8 + i;
      v[i] = W[(size_t)k * N + n] * ((gk && k < glim) ? gk[k] : 1.0f);
    }
    uint4 o;
    uint2 lo = pack4bf(v[0], v[1], v[2], v[3]), hi = pack4bf(v[4], v[5], v[6], v[7]);
    o.x = lo.x; o.y = lo.y; o.z = hi.x; o.w = hi.y;
    *reinterpret_cast<uint4*>(out + (size_t)n * K + kc * 8) = o;
  }
}

__device__ __forceinline__ void ph_prep(const Params& p, int bid, int nb) {
  const int lane = threadIdx.x & 63, wv = threadIdx.x >> 6;
  for (int tt = bid * 4 + wv; tt < T; tt += nb * 4) {
    const float4* hr = reinterpret_cast<const float4*>(hrow(p, tt));
    float s = 0;
#pragma unroll
    for (int j = 0; j < 4; ++j) {
      const float4 v = hr[j * 64 + lane];
      s += v.x * v.x + v.y * v.y + v.z * v.z + v.w * v.w;
      *reinterpret_cast<uint2*>(p.hb + (size_t)tt * D + (j * 64 + lane) * 4) = pack4bf(v.x, v.y, v.z, v.w);
    }
    s = wave_sum(s);
    if (lane == 0) p.rstd1[tt] = rsqrtf(s * (1.0f / D) + RMS_EPS);
  }
  const int gtid = bid * NTHR + threadIdx.x, gth = nb * NTHR;
  for (int e = gtid; e < L * 32; e += gth) {
    const int i = e & 31, pos = e >> 5;
    const float inv = exp2f(-(float)i * (13.287712379549449f / 32.0f));
    float sn, cs; sincosf((float)pos * inv, &sn, &cs);
    p.ropec[e] = cs; p.ropes[e] = sn;
  }
  wtrans(p.w_in, p.g_mix, 1024, DIN, p.w_inT, gtid, gth);
  wtrans(p.w_uq, p.g_q, 256, 768, p.w_uqT, gtid, gth);
  wtrans(p.w_ukv, p.g_kv, 128, 1024, p.w_ukvT, gtid, gth);
  wtrans(p.w_out, p.g_out, 1024, 1024, p.w_outT, gtid, gth, 512);
  for (int e = gtid; e < 1024 * 2048 / 4; e += gth) {
    const f32x4 v = *reinterpret_cast<const f32x4*>(p.w_q + (size_t)e * 4);
    *reinterpret_cast<uint2*>(p.w_qb + (size_t)e * 4) = pack4bf(v[0], v[1], v[2], v[3]);
  }
  for (int e = gtid; e < 8 * 2 * 128 * 128 / 4; e += gth) {
    const f32x4 v = *reinterpret_cast<const f32x4*>(p.subk + (size_t)e * 4);
    *reinterpret_cast<uint2*>(p.subkb + (size_t)e * 4) = pack4bf(v[0], v[1], v[2], v[3]);
  }
  for (int e = gtid; e < 1536 * 128; e += gth) {
    const int n = e >> 7, k = e & 127;
    float v = 0.f;
    if (n < 512) { if (k < 64) v = p.w_up[k * 512 + n]; }
    else if (n < 1024) { if (k < 64) v = p.a_up[k * 512 + n - 512]; }
    else v = p.g_up[k * 512 + n - 1024];
    p.w_lrT[e] = f2bf(v);
  }
}
__device__ __forceinline__ void ph_inproj(const Params& p, char* smem, int bid, int nb) {
  const int lane = threadIdx.x & 63, w = threadIdx.x >> 6, wm = w >> 1, wn = w & 1, g = lane >> 4, r16 = lane & 15;
  for_tiles_xcd(T / 128, (DIN + 127) >> 7, bid, nb, [&](int tm, int tn) {
    const int m0 = tm * 128, n0 = tn * 128;
    f32x4 acc[4][4];
    gemm_tile_glds<true>(smem, m0, n0, 32,
        [&](int r, int k) { return p.hb + (size_t)r * D + k; },
        [&](int n, int k) { return p.w_inT + (size_t)min(n, DIN - 1) * 1024 + k; }, acc);
    float rsq[8];
#pragma unroll
    for (int q = 0; q < 8; ++q) rsq[q] = p.rstd1[m0 + ((threadIdx.x + 256 * q) >> 4)];
    stage_acc(smem, acc);
#pragma unroll
    for (int q = 0; q < 8; ++q) {
      const int c = threadIdx.x + 256 * q;
      const int row = c >> 4, col8 = (c & 15) * 8;
      const int m = m0 + row, n = n0 + col8;
      const float rs = rsq[q];
      float v[8];
      ld8(smem, row, col8, v);
      if (n0 == 384 && col8 < 64) {
        if (col8 < 32) {
          float v2[8], y1[8], y2[8];
          ld8(smem, row, col8 + 32, v2);
          const int pos = m % L;
          const f32x4 c0 = *reinterpret_cast<const f32x4*>(p.ropec + pos * 32 + col8), c1 = *reinterpret_cast<const f32x4*>(p.ropec + pos * 32 + col8 + 4);
          const f32x4 s0 = *reinterpret_cast<const f32x4*>(p.ropes + pos * 32 + col8), s1 = *reinterpret_cast<const f32x4*>(p.ropes + pos * 32 + col8 + 4);
#pragma unroll
          for (int e = 0; e < 8; ++e) {
            const float cs = e < 4 ? c0[e] : c1[e - 4], sn = e < 4 ? s0[e] : s1[e - 4];
            const float x1 = v[e] * rs, x2 = v2[e] * rs;
            y1[e] = x1 * cs - x2 * sn; y2[e] = x1 * sn + x2 * cs;
          }
          st8f(p.kr + (size_t)m * 64 + col8, y1);
          st8f(p.kr + (size_t)m * 64 + 32 + col8, y2);
        }
      } else if (n < DIN) {
#pragma unroll
        for (int e = 0; e < 8; ++e) v[e] *= rs;
        st8f(p.proj + (size_t)m * DIN + n, v);
      }
    }
  });
}
__device__ __forceinline__ void ph_w2(const Params& p, char* smem, int bid, int nb) {
  for (int e = bid; e < 128; e += nb) {
    const int hc = e >> 3, n0 = (e & 7) * 128;
    f32x4 acc[4][4];
    gemm_tile_glds<true>(smem, 0, n0, 4,
        [&](int r, int k) { return p.subkb + ((size_t)hc * 128 + r) * 128 + k; },
        [&](int n, int k) { return p.w_qb + (size_t)n * 2048 + hc * 128 + k; }, acc);
    stage_acc(smem, acc);
#pragma unroll 2
    for (int q = 0; q < 8; ++q) {
      const int c = threadIdx.x + 256 * q;
      const int row = c >> 4, col8 = (c & 15) * 8;
      float v[8];
      ld8(smem, row, col8, v);
      const f32x4 g0 = *reinterpret_cast<const f32x4*>(p.g_ffn + n0 + col8), g1 = *reinterpret_cast<const f32x4*>(p.g_ffn + n0 + col8 + 4);
#pragma unroll
      for (int e2 = 0; e2 < 8; ++e2) v[e2] *= e2 < 4 ? g0[e2] : g1[e2 - 4];
      st8f(p.w_qT + ((size_t)hc * 128 + row) * 1024 + n0 + col8, v);
    }
  }
}
__device__ __forceinline__ void ph_q_up(const Params& p, char* smem, int bid, int nb) {
  const int lane = threadIdx.x & 63, w = threadIdx.x >> 6, wm = w >> 1, wn = w & 1, g = lane >> 4, r16 = lane & 15;
  float* rowss = reinterpret_cast<float*>(smem);
  for_tiles_xcd(T / 128, 6, bid, nb, [&](int tm, int tn) {
    const int m0 = tm * 128, n0 = tn * 128;
    f32x4 acc[4][4];
    float ss[4] = {0.f, 0.f, 0.f, 0.f};
    gemm_tile<true>(smem, m0, n0, 0, 4,
        [&](int r, int k, int i) { const u32x4 v = *reinterpret_cast<const u32x4*>(p.proj + (size_t)r * DIN + k); ss[i] += sumsq8(v); return v; },
        [&](int n, int k) { return *reinterpret_cast<const u32x4*>(p.w_uqT + (size_t)n * 256 + k); }, acc);
    float rsum[4];
#pragma unroll
    for (int i = 0; i < 4; ++i) {
      float v = ss[i];
      v += __shfl_xor(v, 1, 64); v += __shfl_xor(v, 2, 64); v += __shfl_xor(v, 4, 64);
      rsum[i] = v;
    }
    stage_acc(smem, acc);
    float* rowss2 = reinterpret_cast<float*>(smem + 128 * 132 * 4);
    if ((threadIdx.x & 7) == 0) {
#pragma unroll
      for (int i = 0; i < 4; ++i) rowss2[(threadIdx.x >> 3) + 32 * i] = rsum[i];
    }
    __syncthreads();
#pragma unroll 2
    for (int q = 0; q < 8; ++q) {
      const int c = threadIdx.x + 256 * q;
      const int row = c >> 4, col8 = (c & 15) * 8;
      const int m = m0 + row, n = n0 + col8;
      const float rs = rsqrtf(rowss2[row] * (1.0f / 256) + RMS_EPS) * (0.07216878364870322f * 1.4426950408889634f);
      const int off = n % 192;
      float v[8];
      ld8(smem, row, col8, v);
      if (off >= 128) {
        if (off < 160) {
          float v2[8], y1[8], y2[8];
          ld8(smem, row, col8 + 32, v2);
          const int pos = m % L, ii = off - 128;
          const f32x4 c0 = *reinterpret_cast<const f32x4*>(p.ropec + pos * 32 + ii), c1 = *reinterpret_cast<const f32x4*>(p.ropec + pos * 32 + ii + 4);
          const f32x4 s0 = *reinterpret_cast<const f32x4*>(p.ropes + pos * 32 + ii), s1 = *reinterpret_cast<const f32x4*>(p.ropes + pos * 32 + ii + 4);
#pragma unroll
          for (int e = 0; e < 8; ++e) {
            const float cs = e < 4 ? c0[e] : c1[e - 4], sn = e < 4 ? s0[e] : s1[e - 4];
            const float x1 = v[e] * rs, x2 = v2[e] * rs;
            y1[e] = x1 * cs - x2 * sn; y2[e] = x1 * sn + x2 * cs;
          }
          st8f(p.qf + (size_t)m * 768 + n, y1);
          st8f(p.qf + (size_t)m * 768 + n + 32, y2);
        }
      } else {
#pragma unroll
        for (int e = 0; e < 8; ++e) v[e] *= rs;
        st8f(p.qf + (size_t)m * 768 + n, v);
      }
    }
  }, 12);
}
__device__ __forceinline__ void ph_kv_up(const Params& p, char* smem, int bid, int nb) {
  const int lane = threadIdx.x & 63, w = threadIdx.x >> 6, wm = w >> 1, wn = w & 1, g = lane >> 4, r16 = lane & 15;
  float* rowss = reinterpret_cast<float*>(smem);
  for_tiles_xcd(T / 128, 8, bid, nb, [&](int tm, int tn) {
    const bool vpart = tn >= 4;
    const int m0 = tm * 128, n0 = (tn & 3) * 128;
    f32x4 acc[4][4];
    float ss[4] = {0.f, 0.f, 0.f, 0.f};
    auto al = [&](int r, int k, int i) { const u32x4 v = *reinterpret_cast<const u32x4*>(p.proj + (size_t)r * DIN + 256 + k); ss[i] += sumsq8(v); return v; };
    if (!vpart) {
      gemm_tile<true>(smem, m0, n0, 0, 2, al,
          [&](int n, int k) { return *reinterpret_cast<const u32x4*>(p.w_ukvT + (size_t)((n >> 7) * 256 + (n & 127)) * 128 + k); }, acc);
      float rsum[4];
#pragma unroll
      for (int i = 0; i < 4; ++i) {
        float v = ss[i];
        v += __shfl_xor(v, 1, 64); v += __shfl_xor(v, 2, 64); v += __shfl_xor(v, 4, 64);
        rsum[i] = v;
      }
      stage_acc(smem, acc);
      float* rowss2 = reinterpret_cast<float*>(smem + 128 * 132 * 4);
      if ((threadIdx.x & 7) == 0) {
#pragma unroll
        for (int i = 0; i < 4; ++i) rowss2[(threadIdx.x >> 3) + 32 * i] = rsum[i];
      }
      __syncthreads();
#pragma unroll 2
      for (int q = 0; q < 8; ++q) {
        const int c = threadIdx.x + 256 * q;
        const int row = c >> 4, col8 = (c & 15) * 8;
        const int m = m0 + row, n = n0 + col8;
        const float rs = rsqrtf(rowss2[row] * (1.0f / 128) + RMS_EPS);
        const int b = m / L, pos = m - b * L;
        float v[8];
        ld8(smem, row, col8, v);
#pragma unroll
        for (int e = 0; e < 8; ++e) v[e] *= rs;
        st8f(p.kn + ((size_t)((b * 4 + (n >> 7)) * L + pos)) * 128 + (n & 127), v);
      }
    } else {
      gemm_tile<false>(smem, m0, n0, 0, 2, al,
          [&](int n, int k) { return *reinterpret_cast<const u32x4*>(p.w_ukvT + (size_t)((n >> 7) * 256 + 128 + (n & 127)) * 128 + k); }, acc);
      rowss_publish(rowss, ss);
      const int mb = m0 + wm * 64 + 4 * g, nbase = n0 + wn * 64 + r16;
#pragma unroll
      for (int i = 0; i < 4; ++i) {
        const int m = mb + 16 * i;
        f32x4 rs;
#pragma unroll
        for (int r = 0; r < 4; ++r) rs[r] = rsqrtf(rowss[wm * 64 + 16 * i + 4 * g + r] * (1.0f / 128) + RMS_EPS);
        const int b = m / L, pos = m - b * L;
#pragma unroll
        for (int j = 0; j < 4; ++j) {
          const int n = nbase + 16 * j;
          const int h = n >> 7, dv = n & 127;
          const f32x4 v = acc[i][j] * rs;
          *reinterpret_cast<uint2*>(p.vt + ((size_t)((b * 4 + h) * 128 + dv)) * L + pos) = pack4bf(v[0], v[1], v[2], v[3]);
        }
      }
    }
  }, 18);
}
__device__ __forceinline__ float fast_rcp(float x) { return __builtin_amdgcn_rcpf(x); }
__device__ __forceinline__ float fast_sigmoid(float x) { return fast_rcp(1.0f + __expf(-x)); }
__device__ __forceinline__ float fast_tanh(float x) { return 1.0f - 2.0f * fast_rcp(1.0f + __expf(2.0f * x)); }
__device__ __forceinline__ float lerp_tok(const Params& p, int tt, int pos, int c) {
  const float cur = bf2f(p.proj[(size_t)tt * DIN + 448 + c]);
  const float prev = pos > 0 ? bf2f(p.proj[(size_t)(tt - 1) * DIN + 448 + c]) : 0.0f;
  return cur + p.mu[c] * (prev - cur);
}
__device__ __forceinline__ f32x4 lerp4(const Params& p, int tt, int pos, int c) {
  const f32x4 cur = unpk4(*reinterpret_cast<const u32x2*>(p.proj + (size_t)tt * DIN + 448 + c));
  f32x4 prev = {0.f, 0.f, 0.f, 0.f};
  if (pos > 0) prev = unpk4(*reinterpret_cast<const u32x2*>(p.proj + (size_t)(tt - 1) * DIN + 448 + c));
  const f32x4 m = *reinterpret_cast<const f32x4*>(p.mu + c);
  return cur + m * (prev - cur);
}
__device__ __forceinline__ void ph_rwkv_prep(const Params& p, char* smem, int bid, int nb) {
  const int lane = threadIdx.x & 63, w = threadIdx.x >> 6, wm = w >> 1, wn = w & 1, g = lane >> 4, r16 = lane & 15;
  for_tiles_xcd(T / 128, 12, bid, nb, [&](int tm, int tn) {
    const int kind = tn >> 2, n0 = (tn & 3) * 128;
    const int m0 = tm * 128;
    const int kbase = kind == 0 ? 1536 : (kind == 1 ? 1600 : 1664);
    f32x4 acc[4][4];
    gemm_tile<true>(smem, m0, n0, 0, kind == 2 ? 2 : 1,
        [&](int r, int k, int) {
          const int pos = r % L;
          const u32x4 cu = *reinterpret_cast<const u32x4*>(p.proj + (size_t)r * DIN + 448 + kbase + k);
          u32x4 pv = {0u, 0u, 0u, 0u};
          if (pos > 0) pv = *reinterpret_cast<const u32x4*>(p.proj + (size_t)(r - 1) * DIN + 448 + kbase + k);
          u32x4 o;
#pragma unroll
          for (int q = 0; q < 4; ++q) {
            float c0 = __uint_as_float(cu[q] << 16), c1 = __uint_as_float(cu[q] & 0xffff0000u);
            const float p0 = __uint_as_float(pv[q] << 16), p1 = __uint_as_float(pv[q] & 0xffff0000u);
            c0 += p.mu[kbase + k + 2 * q] * (p0 - c0);
            c1 += p.mu[kbase + k + 2 * q + 1] * (p1 - c1);
            if (kind == 0) { c0 = fast_tanh(c0); c1 = fast_tanh(c1); }
            else if (kind == 2) { c0 = fast_sigmoid(c0); c1 = fast_sigmoid(c1); }
            o[q] = pk2bf(c0, c1);
          }
          return o;
        },
        [&](int n, int k) { return *reinterpret_cast<const u32x4*>(p.w_lrT + (size_t)(kind * 512 + n) * 128 + k); }, acc);
    float* Et = reinterpret_cast<float*>(smem);
#pragma unroll
    for (int i = 0; i < 4; ++i)
#pragma unroll
      for (int j = 0; j < 4; ++j)
        *reinterpret_cast<f32x4*>(Et + (wm * 64 + 16 * i + r16) * 132 + wn * 64 + 16 * j + 4 * g) = acc[i][j];
    __syncthreads();
    const int coloff = kind == 0 ? 0 : (kind == 1 ? 512 : 1024);
    bf16_t* const xdst = kind == 0 ? p.rr : (kind == 1 ? p.rk2 : p.rv);
    bf16_t* const ldst = kind == 0 ? p.rlw : (kind == 1 ? p.rkk : p.rg);
    const int chh = n0 + (threadIdx.x & 15) * 8;
    const f32x4 mu0 = *reinterpret_cast<const f32x4*>(p.mu + coloff + chh), mu1 = *reinterpret_cast<const f32x4*>(p.mu + coloff + chh + 4);
#pragma unroll 1
    for (int qb = 0; qb < 8; qb += 4) {
    u32x4 cuv[4], pvv[4];
#pragma unroll
    for (int qi = 0; qi < 4; ++qi) {
      const int c = threadIdx.x + 256 * (qb + qi);
      const int m = m0 + (c >> 4);
      const bf16_t* pc = p.proj + (size_t)m * DIN + 448 + coloff + n0 + (c & 15) * 8;
      cuv[qi] = *reinterpret_cast<const u32x4*>(pc);
      pvv[qi] = *reinterpret_cast<const u32x4*>(pc - ((m % L) > 0 ? DIN : 0));
    }
#pragma unroll
    for (int qi = 0; qi < 4; ++qi) {
      const int q = qb + qi;
      const int c = threadIdx.x + 256 * q;
      const int row = c >> 4, ch = n0 + (c & 15) * 8;
      const int m = m0 + row, pos = m % L;
      const f32x4 l0 = *reinterpret_cast<const f32x4*>(Et + row * 132 + (c & 15) * 8);
      const f32x4 l1 = *reinterpret_cast<const f32x4*>(Et + row * 132 + (c & 15) * 8 + 4);
      const u32x4 cu = cuv[qi];
      u32x4 pv = pvv[qi];
      if (pos == 0) pv = (u32x4){0u, 0u, 0u, 0u};
      float xs[8], lr[8];
#pragma unroll
      for (int e = 0; e < 4; ++e) {
        const float c0 = __uint_as_float(cu[e] << 16), c1 = __uint_as_float(cu[e] & 0xffff0000u);
        const float p0 = __uint_as_float(pv[e] << 16), p1 = __uint_as_float(pv[e] & 0xffff0000u);
        const float m0_ = e < 2 ? mu0[2 * e] : mu1[2 * e - 4], m1_ = e < 2 ? mu0[2 * e + 1] : mu1[2 * e - 3];
        xs[2 * e] = c0 + m0_ * (p0 - c0);
        xs[2 * e + 1] = c1 + m1_ * (p1 - c1);
      }
#pragma unroll
      for (int e = 0; e < 4; ++e) { lr[e] = l0[e]; lr[4 + e] = l1[e]; }
      const size_t o = (size_t)m * 512 + ch;
      if (kind == 0) {
        const f32x4 w00 = *reinterpret_cast<const f32x4*>(p.w0 + ch), w01 = *reinterpret_cast<const f32x4*>(p.w0 + ch + 4);
        float lw[8];
#pragma unroll
        for (int e = 0; e < 8; ++e) {
          const float nx = -(lr[e] + (e < 4 ? w00[e] : w01[e - 4]));
          const float sp = fmaxf(nx, 0.0f) + __logf(1.0f + __expf(-fabsf(nx)));
          lw[e] = -__expf(-sp - 0.5f);
        }
        st8f(ldst + o, lw);
        st8f(xdst + o, xs);
      } else if (kind == 2) {
        st8f(ldst + o, lr);
        st8f(xdst + o, xs);
      } else {
        const f32x4 a00 = *reinterpret_cast<const f32x4*>(p.a0 + ch), a01 = *reinterpret_cast<const f32x4*>(p.a0 + ch + 4);
        const f32x4 kk0 = *reinterpret_cast<const f32x4*>(p.k_k + ch), kk1 = *reinterpret_cast<const f32x4*>(p.k_k + ch + 4);
        const f32x4 ka0 = *reinterpret_cast<const f32x4*>(p.k_a + ch), ka1 = *reinterpret_cast<const f32x4*>(p.k_a + ch + 4);
        float av[8], kkr[8], ss = 0.f;
#pragma unroll
        for (int e = 0; e < 8; ++e) {
          av[e] = fast_sigmoid(lr[e] + (e < 4 ? a00[e] : a01[e - 4]));
          kkr[e] = xs[e] * (e < 4 ? kk0[e] : kk1[e - 4]);
          ss += kkr[e] * kkr[e];
        }
        ss = dpp_sum8(ss);
        const float inr = 1.0f / fmaxf(sqrtf(ss), 1e-12f);
        float kkn[8], k2[8], bb[8];
#pragma unroll
        for (int e = 0; e < 8; ++e) {
          kkn[e] = kkr[e] * inr;
          k2[e] = xs[e] * (1.0f + (av[e] - 1.0f) * (e < 4 ? ka0[e] : ka1[e - 4]));
          bb[e] = kkn[e] * av[e];
        }
        st8f(ldst + o, kkn);
        st8f(xdst + o, k2);
        st8f(p.rbb + o, bb);
      }
    }
    }
  });
}
template <bool STORE = true>
__device__ __forceinline__ void ph_attn(const Params& p, char* smem, int bid, int nb) {
  char* Kb = smem;
  char* Vs = smem + 49152;
  const int tid = threadIdx.x, lane = tid & 63, w = tid >> 6, g = lane >> 4, r16 = lane & 15;
  const int wu = __builtin_amdgcn_readfirstlane(tid) >> 6;
  const int nitems = 32 * 17;
  for (int it = bid; it < nitems; it += nb) {
    const int bh = it & 31, grp = it >> 5;
    const bool meta = grp == 16;
    const int j = 15 - grp;
    const int b = bh >> 2, h = bh & 3;
    const int qbase = meta ? 0 : 16 + 128 * j;
    const int ntiles = meta ? 1 : 2 * j + 3;
    const int my_ntiles = meta ? 1 : (w < 2 ? 2 * j + 2 : 2 * j + 3);
    bf16x8 qf[2][6];
#pragma unroll
    for (int nt = 0; nt < 2; ++nt)
#pragma unroll
      for (int ks = 0; ks < 6; ++ks) {
        const int pos = qbase + 32 * w + 16 * nt + r16;
        qf[nt][ks] = *reinterpret_cast<const bf16x8*>(p.qf + ((size_t)(b * L + pos)) * 768 + h * 192 + ks * 32 + 8 * g);
      }
    f32x4 o[8][2];
#pragma unroll
    for (int a = 0; a < 8; ++a) { o[a][0] = (f32x4){0.f, 0.f, 0.f, 0.f}; o[a][1] = (f32x4){0.f, 0.f, 0.f, 0.f}; }
    float mrun[2] = {-1e30f, -1e30f}, lrun[2] = {0.f, 0.f};
    const bf16_t* knb = p.kn + (size_t)(b * 4 + h) * L * 128;
    const bf16_t* krb = p.kr + (size_t)b * L * 64;
    const bf16_t* vtb = p.vt + (size_t)(b * 4 + h) * 128 * L;
    int koff[6], voff[4];
    unsigned kmask = 0;
#pragma unroll
    for (int i = 0; i < 6; ++i) {
      const int Lk = 64 * (6 * wu + i) + lane;
      const int row = Lk / 24, sp = Lk - row * 24;
      const int ch = (sp & ~7) | ((sp ^ row) & 7);
      if (ch < 16) koff[i] = row * 128 + ch * 8; else { koff[i] = row * 64 + (ch - 16) * 8; kmask |= 1u << i; }
    }
#pragma unroll
    for (int i = 0; i < 4; ++i) {
      const int row = 8 * (4 * wu + i) + (lane >> 3);
      voff[i] = row * L + (((lane & 7) ^ ((row >> 1) & 7)) * 8);
    }
    auto issueK = [&](int t) {
      const int kp0 = t == 0 ? 0 : 16 + 64 * (t - 1);
      char* dst = Kb + (t & 1) * 24576;
      const bf16_t* kb0 = knb + (size_t)kp0 * 128;
      const bf16_t* kb1 = krb + (size_t)kp0 * 64;
#pragma unroll
      for (int i = 0; i < 6; ++i) GLDS16(((kmask >> i) & 1u ? kb1 : kb0) + koff[i], dst + (6 * wu + i) * 1024);
    };
    auto issueV = [&](int t) {
      const int kp0 = t == 0 ? 0 : 16 + 64 * (t - 1);
      const bf16_t* vb0 = vtb + kp0;
#pragma unroll
      for (int i = 0; i < 4; ++i) GLDS16(vb0 + voff[i], Vs + (4 * wu + i) * 1024);
    };
    __syncthreads();
    issueK(0);
    asm volatile("s_waitcnt vmcnt(0)\n\ts_barrier" ::: "memory");
    for (int t = 0; t < ntiles; ++t) {
      const char* Ks = Kb + (t & 1) * 24576;
      issueV(t);
      if (t + 1 < ntiles) issueK(t + 1);
      bf16x8 pb[2][2];
      if (t < my_ntiles) {
        f32x4 s[4][2];
#pragma unroll
        for (int a = 0; a < 4; ++a) { s[a][0] = (f32x4){0.f, 0.f, 0.f, 0.f}; s[a][1] = (f32x4){0.f, 0.f, 0.f, 0.f}; }
#pragma unroll
        for (int ks = 0; ks < 6; ++ks) {
          const int slot = ks * 4 + g;
          const int so = ((slot & ~7) | ((slot ^ lane) & 7)) << 4;
#pragma unroll
          for (int mt = 0; mt < 4; ++mt) {
            const bf16x8 kf = *reinterpret_cast<const bf16x8*>(Ks + (mt * 16 + r16) * 384 + so);
            s[mt][0] = __builtin_amdgcn_mfma_f32_16x16x32_bf16(kf, qf[0][ks], s[mt][0], 0, 0, 0);
            s[mt][1] = __builtin_amdgcn_mfma_f32_16x16x32_bf16(kf, qf[1][ks], s[mt][1], 0, 0, 0);
          }
        }
        if (t == 0) {
#pragma unroll
          for (int mt = 1; mt < 4; ++mt) { s[mt][0] = (f32x4){-1e30f, -1e30f, -1e30f, -1e30f}; s[mt][1] = s[mt][0]; }
        }
#pragma unroll
        for (int nt = 0; nt < 2; ++nt) {
          float mx = -1e30f;
#pragma unroll
          for (int mt = 0; mt < 4; ++mt)
#pragma unroll
            for (int r = 0; r < 4; ++r) mx = fmaxf(mx, s[mt][nt][r]);
          mx = fmaxf(mx, __shfl_xor(mx, 16, 64));
          mx = fmaxf(mx, __shfl_xor(mx, 32, 64));
          const float mn = fmaxf(mrun[nt], mx);
          const float alpha = __builtin_amdgcn_exp2f(mrun[nt] - mn);
          mrun[nt] = mn;
          float rs = 0.f;
#pragma unroll
          for (int mt = 0; mt < 4; ++mt)
#pragma unroll
            for (int r = 0; r < 4; ++r) { const float pv = __builtin_amdgcn_exp2f(s[mt][nt][r] - mn); s[mt][nt][r] = pv; rs += pv; }
          lrun[nt] = lrun[nt] * alpha + rs;
#pragma unroll
          for (int a = 0; a < 8; ++a) o[a][nt] *= alpha;
#pragma unroll
          for (int k2 = 0; k2 < 2; ++k2) {
            const uint2 lo = pack4bf(s[2 * k2][nt][0], s[2 * k2][nt][1], s[2 * k2][nt][2], s[2 * k2][nt][3]);
            const uint2 hi = pack4bf(s[2 * k2 + 1][nt][0], s[2 * k2 + 1][nt][1], s[2 * k2 + 1][nt][2], s[2 * k2 + 1][nt][3]);
            u32x4 pk; pk[0] = lo.x; pk[1] = lo.y; pk[2] = hi.x; pk[3] = hi.y;
            pb[k2][nt] = __builtin_bit_cast(bf16x8, pk);
          }
        }
      }
      if (t + 1 < ntiles) asm volatile("s_waitcnt vmcnt(6)\n\ts_barrier" ::: "memory");
      else asm volatile("s_waitcnt vmcnt(0)\n\ts_barrier" ::: "memory");
      if (t < my_ntiles) {
#pragma unroll
        for (int k2 = 0; k2 < 2; ++k2) {
          const int sa = ((8 * k2 + g) ^ (r16 & 14)) << 3;
          const int sb = ((8 * k2 + 4 + g) ^ (r16 & 14)) << 3;
#pragma unroll
          for (int a = 0; a < 8; ++a) {
            const uint2 va = *reinterpret_cast<const uint2*>(Vs + (a * 16 + r16) * 128 + sa);
            const uint2 vb = *reinterpret_cast<const uint2*>(Vs + (a * 16 + r16) * 128 + sb);
            u32x4 pk; pk[0] = va.x; pk[1] = va.y; pk[2] = vb.x; pk[3] = vb.y;
            const bf16x8 vf = __builtin_bit_cast(bf16x8, pk);
            o[a][0] = __builtin_amdgcn_mfma_f32_16x16x32_bf16(vf, pb[k2][0], o[a][0], 0, 0, 0);
            o[a][1] = __builtin_amdgcn_mfma_f32_16x16x32_bf16(vf, pb[k2][1], o[a][1], 0, 0, 0);
          }
        }
      }
      asm volatile("s_waitcnt vmcnt(0)\n\ts_waitcnt lgkmcnt(0)\n\ts_barrier" ::: "memory");
    }
#pragma unroll
    for (int nt = 0; nt < 2; ++nt) {
      float l = lrun[nt];
      l += __shfl_xor(l, 16, 64);
      l += __shfl_xor(l, 32, 64);
      const float il = 1.0f / l;
      const int pos = qbase + 32 * w + 16 * nt + r16;
      float sq = 0.f;
#pragma unroll
      for (int a = 0; a < 8; ++a) { const f32x4 v = o[a][nt] * il; sq += v[0] * v[0] + v[1] * v[1] + v[2] * v[2] + v[3] * v[3]; }
      sq += __shfl_xor(sq, 16, 64);
      sq += __shfl_xor(sq, 32, 64);
      if (STORE && (!meta || pos < NM)) {
        bf16_t* dst = p.qf + (size_t)(b * L + pos) * 768 + h * 192 + 4 * g;
#pragma unroll
        for (int a = 0; a < 8; ++a) {
          const f32x4 v = o[a][nt] * il;
          *reinterpret_cast<uint2*>(dst + a * 16) = pack4bf(v[0], v[1], v[2], v[3]);
        }
        if (g == 0) p.ossq[(size_t)(b * L + pos) * 4 + h] = sq;
      }
    }
  }
}
__device__ __forceinline__ void ph_rwkv_pre(const Params& p, char* smem, int bid, int nb) {
  const int lane = threadIdx.x & 63, wv = threadIdx.x >> 6, g = lane >> 4, r16 = lane & 15;
  char* my = smem + wv * 16384;
  char* At = my;
  char* Bt = my + 2048;
  char* Kt = my + 4096;
  char* Rt = my + 6144;
  char* AtT = my + 8192;
  char* VtT = my + 10240;
  char* BhT = my + 12288;
  char* KhT = my + 14336;
  const int nitems = NB_ * 8 * NCH;
  for (int wi = bid * 4 + wv; wi < nitems; wi += nb * 4) {
    const int chunk = wi % NCH, bh = wi / NCH, b = bh >> 3, h = bh & 7;
    float btv[16], ktv[16];
    unsigned atp[8], vtp[8];
    float cum = 0.f;
    const size_t o0 = ((size_t)b * L + chunk * 16) * 512 + h * 64 + lane;
#pragma unroll
    for (int t = 0; t < 16; ++t) {
      const size_t o = o0 + (size_t)t * 512;
      const float lw = bf2f(p.rlw[o]);
      const float gp = __expf(cum);
      cum += lw;
      const float gc = __expf(cum), ig = __expf(-cum);
      const float av = -bf2f(p.rkk[o]) * gp;
      const float bv = bf2f(p.rbb[o]) * ig;
      const float kv = bf2f(p.rk2[o]) * ig;
      const float rv = bf2f(p.rr[o]) * gc;
      const bf16_t vb = p.rv[o];
      btv[t] = bv; ktv[t] = kv;
      const bf16_t ab = f2bf(av);
      *reinterpret_cast<bf16_t*>(At + t * 128 + lane * 2) = ab;
      *reinterpret_cast<bf16_t*>(Bt + t * 128 + lane * 2) = f2bf(bv);
      *reinterpret_cast<bf16_t*>(Kt + t * 128 + lane * 2) = f2bf(kv);
      *reinterpret_cast<bf16_t*>(Rt + t * 128 + lane * 2) = f2bf(rv);
      if (t & 1) { atp[t >> 1] |= (unsigned)ab << 16; vtp[t >> 1] |= (unsigned)vb << 16; }
      else { atp[t >> 1] = ab; vtp[t >> 1] = vb; }
    }
    const float gC = __expf(cum);
    p.cd_gc[(size_t)wi * 64 + lane] = gC;
    {
      u32x4 w0, w1;
#pragma unroll
      for (int q = 0; q < 4; ++q) { w0[q] = atp[q]; w1[q] = atp[4 + q]; }
      *reinterpret_cast<u32x4*>(AtT + lane * 32) = w0; *reinterpret_cast<u32x4*>(AtT + lane * 32 + 16) = w1;
#pragma unroll
      for (int q = 0; q < 4; ++q) { w0[q] = vtp[q]; w1[q] = vtp[4 + q]; }
      *reinterpret_cast<u32x4*>(VtT + lane * 32) = w0; *reinterpret_cast<u32x4*>(VtT + lane * 32 + 16) = w1;
#pragma unroll
      for (int q = 0; q < 4; ++q) {
        w0[q] = pk2bf(btv[2 * q] * gC, btv[2 * q + 1] * gC);
        w1[q] = pk2bf(btv[8 + 2 * q] * gC, btv[8 + 2 * q + 1] * gC);
      }
      *reinterpret_cast<u32x4*>(BhT + lane * 32) = w0; *reinterpret_cast<u32x4*>(BhT + lane * 32 + 16) = w1;
#pragma unroll
      for (int q = 0; q < 4; ++q) {
        w0[q] = pk2bf(ktv[2 * q] * gC, ktv[2 * q + 1] * gC);
        w1[q] = pk2bf(ktv[8 + 2 * q] * gC, ktv[8 + 2 * q + 1] * gC);
      }
      *reinterpret_cast<u32x4*>(KhT + lane * 32) = w0; *reinterpret_cast<u32x4*>(KhT + lane * 32 + 16) = w1;
    }
    __builtin_amdgcn_wave_barrier();
    f32x4 mab = {0.f, 0.f, 0.f, 0.f}, mak = mab, nbr = mab, nkr = mab;
#pragma unroll
    for (int ks = 0; ks < 2; ++ks) {
      const int off = r16 * 128 + ks * 64 + g * 16;
      const bf16x8 fa = *reinterpret_cast<const bf16x8*>(At + off);
      const bf16x8 fb = *reinterpret_cast<const bf16x8*>(Bt + off);
      const bf16x8 fk = *reinterpret_cast<const bf16x8*>(Kt + off);
      const bf16x8 fr = *reinterpret_cast<const bf16x8*>(Rt + off);
      mab = MFMA32(fb, fa, mab); mak = MFMA32(fk, fa, mak);
      nbr = MFMA32(fb, fr, nbr); nkr = MFMA32(fk, fr, nkr);
    }
#pragma unroll
    for (int r = 0; r < 4; ++r) {
      const int sidx = 4 * g + r;
      if (!(sidx < r16)) { mab[r] = 0.f; mak[r] = 0.f; }
      if (!(sidx <= r16)) { nbr[r] = 0.f; nkr[r] = 0.f; }
    }
    float Tc[16];
#pragma unroll
    for (int sidx = 15; sidx >= 0; --sidx) {
      float acc = (r16 == sidx) ? 1.0f : 0.0f;
#pragma unroll
      for (int u = sidx + 1; u < 16; ++u) {
        const float m = __int_as_float(__builtin_amdgcn_readlane(__float_as_int(mab[sidx & 3]), 16 * (sidx >> 2) + u));
        acc += m * Tc[u];
      }
      Tc[sidx] = acc;
    }
    f32x4 tqf;
#pragma unroll
    for (int r = 0; r < 4; ++r) tqf[r] = g == 0 ? Tc[r] : (g == 1 ? Tc[4 + r] : (g == 2 ? Tc[8 + r] : Tc[12 + r]));
    const bf16x4 tq = pk4(tqf);
    const bf16x4 makA = pk4(mak), nbrA = pk4(nbr), nkrA = pk4(nkr);
    f32x4 ah[4], qm[4], wt[4], zt[4];
    bf16x4 vfr[4];
#pragma unroll
    for (int q = 0; q < 4; ++q) {
      const f32x4 z4 = {0.f, 0.f, 0.f, 0.f};
      const bf16x4 atf = *reinterpret_cast<const bf16x4*>(AtT + (16 * q + r16) * 32 + g * 8);
      vfr[q] = *reinterpret_cast<const bf16x4*>(VtT + (16 * q + r16) * 32 + g * 8);
      ah[q] = MFMA16(tq, atf, z4);
      const f32x4 xt = MFMA16(makA, vfr[q], z4);
      wt[q] = MFMA16(tq, pk4(xt), z4);
      qm[q] = MFMA16(nbrA, pk4(ah[q]), z4);
      zt[q] = MFMA16(nbrA, pk4(wt[q]), z4);
      zt[q] = MFMA16(nkrA, vfr[q], zt[q]);
    }
    unsigned char* oah = p.cd_ah + (size_t)wi * 2048;
    unsigned char* oqm = p.cd_qm + (size_t)wi * 2048;
    unsigned char* obk = p.cd_bk + (size_t)wi * 4096;
    unsigned char* owt = p.cd_wt + (size_t)wi * 2048;
    unsigned char* ozt = p.cd_zt + (size_t)wi * 2048;
    unsigned char* ovb = p.cd_vb + (size_t)wi * 2048;
#pragma unroll
    for (int q = 0; q < 4; ++q) {
      *reinterpret_cast<bf16x4*>(owt + (q * 64 + lane) * 8) = pk4(wt[q]);
      *reinterpret_cast<bf16x4*>(ozt + (q * 64 + lane) * 8) = pk4(zt[q]);
      *reinterpret_cast<bf16x4*>(ovb + (q * 64 + lane) * 8) = vfr[q];
      const u32x2 bh2 = *reinterpret_cast<const u32x2*>(BhT + (16 * q + r16) * 32 + g * 8);
      const u32x2 kh2 = *reinterpret_cast<const u32x2*>(KhT + (16 * q + r16) * 32 + g * 8);
      u32x4 bk; bk[0] = bh2[0]; bk[1] = bh2[1]; bk[2] = kh2[0]; bk[3] = kh2[1];
      *reinterpret_cast<u32x4*>(obk + (q * 64 + lane) * 16) = bk;
    }
    __builtin_amdgcn_wave_barrier();
#pragma unroll
    for (int q = 0; q < 4; ++q)
#pragma unroll
      for (int r = 0; r < 4; ++r) *reinterpret_cast<bf16_t*>(Bt + (4 * g + r) * 128 + (16 * q + r16) * 2) = f2bf(ah[q][r]);
    __builtin_amdgcn_wave_barrier();
#pragma unroll
    for (int ks = 0; ks < 2; ++ks) {
      const u32x2 lo = *reinterpret_cast<const u32x2*>(Bt + r16 * 128 + (32 * ks + 4 * g) * 2);
      const u32x2 hi = *reinterpret_cast<const u32x2*>(Bt + r16 * 128 + (32 * ks + 16 + 4 * g) * 2);
      u32x4 v; v[0] = lo[0]; v[1] = lo[1]; v[2] = hi[0]; v[3] = hi[1];
      *reinterpret_cast<u32x4*>(oah + (ks * 64 + lane) * 16) = v;
    }
    __builtin_amdgcn_wave_barrier();
#pragma unroll
    for (int q = 0; q < 4; ++q)
#pragma unroll
      for (int r = 0; r < 4; ++r) *reinterpret_cast<bf16_t*>(Bt + (4 * g + r) * 128 + (16 * q + r16) * 2) = f2bf(qm[q][r]);
    __builtin_amdgcn_wave_barrier();
#pragma unroll
    for (int ks = 0; ks < 2; ++ks) {
      const int o1 = r16 * 128 + (32 * ks + 4 * g) * 2, o2 = r16 * 128 + (32 * ks + 16 + 4 * g) * 2;
      const f32x4 a1 = unpk4(*reinterpret_cast<const u32x2*>(Bt + o1)) + unpk4(*reinterpret_cast<const u32x2*>(Rt + o1));
      const f32x4 a2 = unpk4(*reinterpret_cast<const u32x2*>(Bt + o2)) + unpk4(*reinterpret_cast<const u32x2*>(Rt + o2));
      const uint2 lo = pack4bf(a1[0], a1[1], a1[2], a1[3]), hi = pack4bf(a2[0], a2[1], a2[2], a2[3]);
      u32x4 v; v[0] = lo.x; v[1] = lo.y; v[2] = hi.x; v[3] = hi.y;
      *reinterpret_cast<u32x4*>(oqm + (ks * 64 + lane) * 16) = v;
    }
    __builtin_amdgcn_wave_barrier();
  }
}
__device__ __forceinline__ void ph_rwkv_pq(const Params& p, int bid, int nb) {
  const int lane = threadIdx.x & 63, wv = threadIdx.x >> 6;
  const int nitems = NB_ * 8 * NCH;
  for (int wi = bid * 4 + wv; wi < nitems; wi += nb * 4) {
    const int chunk = wi % NCH, bh = wi / NCH, b = bh >> 3, h = bh & 7;
    const size_t o0 = ((size_t)b * L + chunk * 16) * 512 + h * 64 + lane;
    float pdv[16];
    const float rkc = p.r_k[h * 64 + lane];
#pragma unroll
    for (int t = 0; t < 16; ++t) { const size_t o = o0 + (size_t)t * 512; pdv[t] = bf2f(p.rr[o]) * bf2f(p.rk2[o]) * rkc; }
    const float s3l = tr_reduce16(pdv, lane);
    const float lnw = p.ln_w[h * 64 + lane], lnb = p.ln_b[h * 64 + lane];
    bf16_t gtv[16], vtv[16];
#pragma unroll
    for (int t = 0; t < 16; ++t) { const size_t o = o0 + (size_t)t * 512; gtv[t] = p.rg[o]; vtv[t] = p.rv[o]; }
#pragma unroll
    for (int t = 0; t < 16; ++t) {
      const float s3 = __int_as_float(__builtin_amdgcn_readlane(__float_as_int(s3l), 4 * t));
      const size_t o = o0 + (size_t)t * 512;
      const float gt = bf2f(gtv[t]), vt_ = bf2f(vtv[t]);
      p.rlw[o] = f2bf(lnw * gt);
      p.rbb[o] = f2bf((lnb + s3 * vt_) * gt);
    }
  }
}
struct ChainRegs { u32x4 s0, s1; u32x2 wt, zt, vb, pp, qq; float gcs; };
__device__ __forceinline__ void chain_load(const Params& p, int wi, unsigned ytok, int it, int lane, ChainRegs& c) {
  const unsigned char* q0 = (it < 2 ? p.cd_ah : p.cd_qm) + (size_t)wi * 2048 + (it & 1) * 1024;
  c.gcs = p.cd_gc[(size_t)wi * 64 + lane];
  c.s0 = *reinterpret_cast<const u32x4*>(q0 + lane * 16);
  c.s1 = *reinterpret_cast<const u32x4*>(p.cd_bk + (size_t)wi * 4096 + it * 1024 + lane * 16);
  c.wt = *reinterpret_cast<const u32x2*>(p.cd_wt + (size_t)wi * 2048 + (it * 64 + lane) * 8);
  c.zt = *reinterpret_cast<const u32x2*>(p.cd_zt + (size_t)wi * 2048 + (it * 64 + lane) * 8);
  c.vb = *reinterpret_cast<const u32x2*>(p.cd_vb + (size_t)wi * 2048 + (it * 64 + lane) * 8);
  c.pp = *reinterpret_cast<const u32x2*>(p.rlw + ytok);
  c.qq = *reinterpret_cast<const u32x2*>(p.rbb + ytok);
}
__device__ __forceinline__ void chain_publish(char* sh, int it, int lane, const ChainRegs& c) {
  *reinterpret_cast<u32x4*>(sh + it * 1024 + lane * 16) = c.s0;
  *reinterpret_cast<u32x4*>(sh + 4096 + it * 1024 + lane * 16) = c.s1;
  if (it == 0) reinterpret_cast<float*>(sh + 8192)[lane] = c.gcs;
}
__device__ __forceinline__ float dpp_sum16(float v) {
  v += __int_as_float(__builtin_amdgcn_update_dpp(0, __float_as_int(v), 0xB1, 0xF, 0xF, true));
  v += __int_as_float(__builtin_amdgcn_update_dpp(0, __float_as_int(v), 0x4E, 0xF, 0xF, true));
  v += __int_as_float(__builtin_amdgcn_update_dpp(0, __float_as_int(v), 0x141, 0xF, 0xF, true));
  v += __int_as_float(__builtin_amdgcn_update_dpp(0, __float_as_int(v), 0x140, 0xF, 0xF, true));
  return v;
}
template <bool STORE>
__device__ __forceinline__ void chain_finalize(const Params& p, const char* otile, unsigned ytok, u32x2 pp, u32x2 qq) {
  const int tid = threadIdx.x;
  const f32x4 o4 = *reinterpret_cast<const f32x4*>(otile + (tid >> 4) * 256 + (tid & 15) * 16);
  const float s1 = dpp_sum16(o4[0] + o4[1] + o4[2] + o4[3]);
  const float s2 = dpp_sum16(o4[0] * o4[0] + o4[1] * o4[1] + o4[2] * o4[2] + o4[3] * o4[3]);
  const float mean = s1 * (1.0f / 64);
  const float var = fmaxf(s2 * (1.0f / 64) - mean * mean, 0.0f);
  const float istd = rsqrtf(var + 64e-5f);
  const f32x4 y = (o4 - mean) * istd * unpk4(pp) + unpk4(qq);
  if (STORE) *reinterpret_cast<uint2*>(p.rkk + ytok) = pack4bf(y[0], y[1], y[2], y[3]);
  else asm volatile("" :: "v"(y[0]), "v"(y[1]), "v"(y[2]), "v"(y[3]));
}
template <bool STORE>
__device__ __forceinline__ void chain_step(const Params& p, char* otile, const char* otile_prev, bool have_prev, unsigned ytok_prev, u32x2 pp_prev, u32x2 qq_prev,
                                           const char* sh, char* shn, int it, int lane,
                                           const ChainRegs& c, const ChainRegs& cn, f32x4 (&st)[4]) {
  const int g = lane >> 4, r16 = lane & 15;
  const float* gcur = reinterpret_cast<const float*>(sh + 8192);
  u32x4 s0, s1;
  {
    const uint2 a = pack4bf(st[0][0], st[0][1], st[0][2], st[0][3]), b = pack4bf(st[1][0], st[1][1], st[1][2], st[1][3]);
    const uint2 cc = pack4bf(st[2][0], st[2][1], st[2][2], st[2][3]), d = pack4bf(st[3][0], st[3][1], st[3][2], st[3][3]);
    s0[0] = a.x; s0[1] = a.y; s0[2] = b.x; s0[3] = b.y;
    s1[0] = cc.x; s1[1] = cc.y; s1[2] = d.x; s1[3] = d.y;
  }
  const bf16x8 sb0 = __builtin_bit_cast(bf16x8, s0), sb1 = __builtin_bit_cast(bf16x8, s1);
  f32x4 ut = unpk4(c.wt), ot = unpk4(c.zt);
  ut = MFMA32(*reinterpret_cast<const bf16x8*>(sh + lane * 16), sb0, ut);
  ot = MFMA32(*reinterpret_cast<const bf16x8*>(sh + 2048 + lane * 16), sb0, ot);
  ut = MFMA32(*reinterpret_cast<const bf16x8*>(sh + 1024 + lane * 16), sb1, ut);
  ot = MFMA32(*reinterpret_cast<const bf16x8*>(sh + 3072 + lane * 16), sb1, ot);
  chain_publish(shn, it, lane, cn);
  if (have_prev) chain_finalize<STORE>(p, otile_prev, ytok_prev, pp_prev, qq_prev);
#pragma unroll
  for (int r = 0; r < 4; ++r) *reinterpret_cast<float*>(otile + (4 * g + r) * 256 + (16 * it + r16) * 4) = ot[r];
  const uint2 u2 = pack4bf(ut[0], ut[1], ut[2], ut[3]);
  u32x4 uv; uv[0] = u2.x; uv[1] = u2.y; uv[2] = c.vb[0]; uv[3] = c.vb[1];
  const bf16x8 uvb = __builtin_bit_cast(bf16x8, uv);
#pragma unroll
  for (int q = 0; q < 4; ++q)
    st[q] = MFMA32(*reinterpret_cast<const bf16x8*>(sh + 4096 + q * 1024 + lane * 16), uvb, st[q] * *reinterpret_cast<const f32x4*>(gcur + 16 * q + 4 * g));
  __syncthreads();
}
template <bool STORE = true>
__device__ __forceinline__ void ph_chain(const Params& p, char* smem, int bid, int nb) {
  const int tid = threadIdx.x, lane = tid & 63, it = tid >> 6;
  char* shb = smem + 8192;
  for (int bh = bid; bh < NB_ * 8; bh += nb) {
    f32x4 st[4];
#pragma unroll
    for (int q = 0; q < 4; ++q) st[q] = (f32x4){0.f, 0.f, 0.f, 0.f};
    const int w0 = bh * NCH;
    const int b = bh >> 3, h = bh & 7;
    const unsigned y0 = (unsigned)((b * L + (tid >> 4)) * 512 + h * 64 + (tid & 15) * 4);
    ChainRegs c0, c1, c2, c3, c4, c5, c6, c7;
#define CH_LOAD(cc, set) chain_load(p, w0 + min((cc), NCH - 1), y0 + (unsigned)min((cc), NCH - 1) * 8192u, it, lane, set)
    CH_LOAD(0, c0); CH_LOAD(1, c1); CH_LOAD(2, c2); CH_LOAD(3, c3); CH_LOAD(4, c4); CH_LOAD(5, c5); CH_LOAD(6, c6); CH_LOAD(7, c7);
    __syncthreads();
    chain_publish(shb, it, lane, c0);
    __syncthreads();
    u32x2 ppp = {0u, 0u}, qqp = {0u, 0u};
#define CH_STEP(cc, cur, nxt) { const int par = (cc) & 1; \
      chain_step<STORE>(p, smem + par * 4096, smem + (1 - par) * 4096, (cc) > 0, y0 + (unsigned)((cc) - 1) * 8192u, ppp, qqp, \
                        shb + par * 8448, shb + (1 - par) * 8448, it, lane, cur, nxt, st); \
      ppp = cur.pp; qqp = cur.qq; CH_LOAD((cc) + 8, cur); }
    for (int ch = 0; ch < 128; ch += 8) {
      CH_STEP(ch, c0, c1) CH_STEP(ch + 1, c1, c2) CH_STEP(ch + 2, c2, c3) CH_STEP(ch + 3, c3, c4)
      CH_STEP(ch + 4, c4, c5) CH_STEP(ch + 5, c5, c6) CH_STEP(ch + 6, c6, c7) CH_STEP(ch + 7, c7, c0)
    }
    CH_STEP(128, c0, c1)
#undef CH_STEP
#undef CH_LOAD
    chain_finalize<STORE>(p, smem + ((NCH - 1) & 1) * 4096, y0 + (unsigned)(NCH - 1) * 8192u, ppp, qqp);
    __syncthreads();
  }
}
__device__ __forceinline__ void ph_tabconv(const Params& p, int bid, int nb) {
  const int nvec = 2 * 16384 * 256;
  const int stride = nb * NTHR;
  for (int base = bid * NTHR + threadIdx.x; base < nvec; base += 8 * stride) {
    f32x4 v[8];
#pragma unroll
    for (int k = 0; k < 8; ++k) {
      const int i = min(base + k * stride, nvec - 1);
      const bool tab = i >= 16384 * 256;
      v[k] = *reinterpret_cast<const f32x4*>((tab ? p.pv : p.pu) + (size_t)(tab ? i - 16384 * 256 : i) * 4);
    }
#pragma unroll
    for (int k = 0; k < 8; ++k) {
      const int i = min(base + k * stride, nvec - 1);
      const bool tab = i >= 16384 * 256;
      f32x4 w = v[k] * (tab ? 16.0f : 256.0f);
      if (!tab) w *= *reinterpret_cast<const f32x4*>(p.g_ffn + (i & 255) * 4);
      int wv = __builtin_amdgcn_cvt_pk_fp8_f32(w[0], w[1], 0, false);
      wv = __builtin_amdgcn_cvt_pk_fp8_f32(w[2], w[3], wv, true);
      *reinterpret_cast<unsigned*>((tab ? p.v8 : p.u8) + (size_t)(tab ? i - 16384 * 256 : i) * 4) = (unsigned)wv;
    }
  }
}
__device__ __forceinline__ void ph_outproj(const Params& p, char* smem, int bid, int nb) {
  const int lane = threadIdx.x & 63, w = threadIdx.x >> 6, wm = w >> 1, wn = w & 1, g = lane >> 4, r16 = lane & 15;
  for_tiles_xcd(TR / 128, 4, bid, nb, [&](int tm, int tn) {
    const int m0 = tm * 128, n0 = tn * 256;
    f32x4 acc[4][8];
    gemm_tile_wide(smem, m0, n0, 32,
        [&](int r, int k) {
          const size_t tt = (size_t)rt2tt(r);
          return k < 512 ? p.qf + tt * 768 + (k >> 7) * 192 + (k & 127) : p.rkk + tt * 512 + (k - 512);
        },
        [&](int n, int k) { return p.w_outT + (size_t)n * 1024 + k; }, acc,
        [&](int kt, f32x4 (&a)[4][8]) {
          if (kt == 16) {
#pragma unroll
            for (int i = 0; i < 4; ++i) {
              const f32x4 q4 = *reinterpret_cast<const f32x4*>(p.ossq + (size_t)rt2tt(m0 + wm * 64 + 16 * i + r16) * 4);
              const float rs = rsqrtf((q4[0] + q4[1] + q4[2] + q4[3]) * (1.0f / 512) + RMS_EPS);
#pragma unroll
              for (int j = 0; j < 8; ++j) a[i][j] *= rs;
            }
          }
        });
#pragma unroll 1
    for (int half = 0; half < 2; ++half) {
      stage_acc_half(smem, acc, half);
#pragma unroll 1
      for (int qb = 0; qb < 8; qb += 4) {
      f32x4 hh[4][2];
#pragma unroll
      for (int qi = 0; qi < 4; ++qi) {
        const int c = threadIdx.x + 256 * (qb + qi);
        const float* hr = hrow(p, rt2tt(m0 + (c >> 4))) + n0 + half * 128 + (c & 15) * 8;
        hh[qi][0] = *reinterpret_cast<const f32x4*>(hr); hh[qi][1] = *reinterpret_cast<const f32x4*>(hr + 4);
      }
#pragma unroll
      for (int qi = 0; qi < 4; ++qi) {
        const int q = qb + qi;
        const int c = threadIdx.x + 256 * q;
        const int row = c >> 4, col8 = (c & 15) * 8;
        const int m = m0 + row, n = n0 + half * 128 + col8;
        const f32x4 h0 = hh[qi][0], h1 = hh[qi][1];
        float v[8];
        ld8(smem, row, col8, v);
        float sq = 0.f;
#pragma unroll
        for (int e = 0; e < 8; ++e) { v[e] += e < 4 ? h0[e] : h1[e - 4]; sq += v[e] * v[e]; }
        f32x4 o0, o1;
#pragma unroll
        for (int e = 0; e < 4; ++e) { o0[e] = v[e]; o1[e] = v[4 + e]; }
        *reinterpret_cast<f32x4*>(p.out + (size_t)m * D + n) = o0;
        *reinterpret_cast<f32x4*>(p.out + (size_t)m * D + n + 4) = o1;
        st8f(p.h2b + (size_t)m * D + n, v);
        sq += __shfl_xor(sq, 1, 64); sq += __shfl_xor(sq, 2, 64); sq += __shfl_xor(sq, 4, 64); sq += __shfl_xor(sq, 8, 64);
        if ((threadIdx.x & 15) == 0) atomicAdd(p.h2ss + m, sq);
      }
      }
    }
  });
}
#define CE_(a, b) { const int t_ = max(a, b); b = min(a, b); a = t_; }
__device__ __forceinline__ int fkey7(float x, int idx) {
  int b = __float_as_int(x);
  b ^= (b >> 31) & 0x7fffffff;
  return (b & ~127) | (127 - idx);
}
__device__ __forceinline__ float fvalm(int k, int mask) {
  int b = k & ~mask;
  b ^= (b >> 31) & 0x7fffffff;
  return __int_as_float(b);
}
__device__ __forceinline__ void bitonic_sort16(int (&v)[16]) {
#pragma unroll
  for (int k = 2; k <= 16; k <<= 1)
#pragma unroll
    for (int j = k >> 1; j > 0; j >>= 1)
#pragma unroll
      for (int i = 0; i < 16; ++i) {
        const int l = i ^ j;
        if (l > i) {
          if ((i & k) == 0) { CE_(v[i], v[l]); } else { CE_(v[l], v[i]); }
        }
      }
}
__device__ __forceinline__ void bitonic_merge16(int (&v)[16]) {
#pragma unroll
  for (int j = 8; j > 0; j >>= 1)
#pragma unroll
    for (int i = 0; i < 16; ++i) {
      const int l = i ^ j;
      if (l > i) { CE_(v[i], v[l]); }
    }
}
__device__ __forceinline__ void ph_route(const Params& p, char* smem, int bid, int nb) {
  const int tid = threadIdx.x, lane = tid & 63, w = tid >> 6, wm = w >> 1, wn = w & 1, g = lane >> 4, r16 = lane & 15;
  int* L2l = reinterpret_cast<int*>(smem);
  int* Lx = reinterpret_cast<int*>(smem + 8192);
  int* L1l = reinterpret_cast<int*>(smem + 67584);
  for_tiles_xcd(TR / 128, 8, bid, nb, [&](int mt, int h) {
    const int m0 = mt * 128;
    for (int c = 0; c < 2; ++c) {
      f32x4 acc[4][4];
      gemm_tile_glds<true>(smem, m0, (2 * h + c) * 128, 32,
          [&](int r, int k) { return p.h2b + (size_t)r * D + k; },
          [&](int n, int k) { return p.w_qT + (size_t)n * 1024 + k; }, acc);
      float* Et = reinterpret_cast<float*>(smem);
#pragma unroll
      for (int i = 0; i < 4; ++i)
#pragma unroll
        for (int j = 0; j < 4; ++j)
          *reinterpret_cast<f32x4*>(Et + (wm * 64 + 16 * i + r16) * 132 + wn * 64 + 16 * j + 4 * g) = acc[i][j];
      __syncthreads();
      f32x4 sc[2][8];
#pragma unroll
      for (int tt = 0; tt < 2; ++tt)
#pragma unroll
        for (int kt = 0; kt < 8; ++kt) sc[tt][kt] = *reinterpret_cast<const f32x4*>(Et + (32 * w + 16 * tt + r16) * 132 + 16 * kt + 4 * g);
      __syncthreads();
#pragma unroll
      for (int tt = 0; tt < 2; ++tt) {
        int lo[16], hi[16];
#pragma unroll
        for (int kt = 0; kt < 4; ++kt)
#pragma unroll
          for (int r = 0; r < 4; ++r) {
            lo[kt * 4 + r] = fkey7(sc[tt][kt][r], 16 * kt + 4 * g + r);
            hi[kt * 4 + r] = fkey7(sc[tt][kt + 4][r], 16 * (kt + 4) + 4 * g + r);
          }
        bitonic_sort16(lo);
        bitonic_sort16(hi);
#pragma unroll
        for (int i = 0; i < 16; ++i) lo[i] = max(lo[i], hi[15 - i]);
        bitonic_merge16(lo);
#pragma unroll
        for (int st = 16; st <= 32; st <<= 1) {
          int ot[16];
#pragma unroll
          for (int i = 0; i < 16; ++i) ot[i] = __shfl_xor(lo[15 - i], st, 64);
#pragma unroll
          for (int i = 0; i < 16; ++i) lo[i] = max(lo[i], ot[i]);
          bitonic_merge16(lo);
        }
        if (g == 0) {
          int* dst = (c ? L2l : L1l) + (32 * w + 16 * tt + r16) * 16;
#pragma unroll
          for (int q = 0; q < 4; ++q) {
            u32x4 v; v[0] = lo[4 * q]; v[1] = lo[4 * q + 1]; v[2] = lo[4 * q + 2]; v[3] = lo[4 * q + 3];
            *reinterpret_cast<u32x4*>(dst + 4 * q) = v;
          }
        }
      }
      __syncthreads();
    }
    {
      const int tok = tid & 127, half = tid >> 7;
      int k1[16], k2[16];
      float v1[16], v2[16];
#pragma unroll
      for (int q = 0; q < 4; ++q) {
        const u32x4 a = *reinterpret_cast<const u32x4*>(L1l + tok * 16 + 4 * q);
        const u32x4 b = *reinterpret_cast<const u32x4*>(L2l + tok * 16 + 4 * q);
#pragma unroll
        for (int e = 0; e < 4; ++e) { k1[4 * q + e] = (int)a[e]; k2[4 * q + e] = (int)b[e]; }
      }
#pragma unroll
      for (int i = 0; i < 16; ++i) { v1[i] = fvalm(k1[i], 127); v2[i] = fvalm(k2[i], 127); }
      int lst[16];
#pragma unroll
      for (int i = 0; i < 16; ++i) lst[i] = (int)0x80000000;
      if (half == 0) {
#pragma unroll
        for (int a = 0; a < 2; ++a)
#pragma unroll
          for (int b = 0; b < 16 / (a + 1); ++b) {
            int x = __float_as_int(v1[a] + v2[b]);
            x ^= (x >> 31) & 0x7fffffff;
            x = (x & ~255) | (255 - (a * 16 + b));
#pragma unroll
            for (int i = 0; i < 16; ++i) CE_(lst[i], x);
          }
      } else {
#pragma unroll
        for (int a = 2; a < 16; ++a)
#pragma unroll
          for (int b = 0; b < 16 / (a + 1); ++b) {
            int x = __float_as_int(v1[a] + v2[b]);
            x ^= (x >> 31) & 0x7fffffff;
            x = (x & ~255) | (255 - (a * 16 + b));
#pragma unroll
            for (int i = 0; i < 16; ++i) CE_(lst[i], x);
          }
      }
#pragma unroll
      for (int q = 0; q < 4; ++q) {
        u32x4 v; v[0] = lst[4 * q]; v[1] = lst[4 * q + 1]; v[2] = lst[4 * q + 2]; v[3] = lst[4 * q + 3];
        *reinterpret_cast<u32x4*>(Lx + (half * 128 + tok) * 16 + 4 * q) = v;
      }
      __syncthreads();
      int fin[16];
#pragma unroll
      for (int q = 0; q < 4; ++q) {
        const u32x4 o = *reinterpret_cast<const u32x4*>(Lx + ((1 - half) * 128 + tok) * 16 + 4 * q);
#pragma unroll
        for (int e = 0; e < 4; ++e) fin[4 * q + e] = (int)o[e];
      }
#pragma unroll
      for (int i = 0; i < 8; ++i) { const int t_ = fin[i]; fin[i] = fin[15 - i]; fin[15 - i] = t_; }
#pragma unroll
      for (int i = 0; i < 16; ++i) fin[i] = max(fin[i], lst[i]);
      float sv[16], mx = -1e30f;
      const float rs2 = rsqrtf(p.h2ss[m0 + tok] * (1.0f / D) + RMS_EPS);
#pragma unroll
      for (int i = 0; i < 16; ++i) { sv[i] = fvalm(fin[i], 255); mx = fmaxf(mx, sv[i]); }
      float sum = 0.f;
#pragma unroll
      for (int i = 0; i < 16; ++i) { sv[i] = __expf((sv[i] - mx) * rs2); sum += sv[i]; }
      const float isum = 1.0f / sum;
      const size_t ob = (size_t)(m0 + tok) * 128 + h * 16 + half * 8;
#pragma unroll
      for (int i = 0; i < 8; ++i) {
        const int code = 255 - (fin[i] & 255);
        const int a = code >> 4, b = code & 15;
        const int i1 = 127 - (L1l[tok * 16 + a] & 127), i2 = 127 - (L2l[tok * 16 + b] & 127);
        p.pidx[ob + i] = i1 * 128 + i2;
        p.pgate[ob + i] = sv[i] * isum;
      }
    }
    __syncthreads();
  });
}
__device__ __forceinline__ void ph_expert(const Params& p, char* smem, int bid, int nb) {
  const int lane = threadIdx.x & 63, wv = threadIdx.x >> 6;
  const int g3 = lane >> 3, p8 = lane & 7;
  const bool b5 = lane & 32, b4 = lane & 16, b3 = lane & 8;
  unsigned* idxl = reinterpret_cast<unsigned*>(smem + wv * 8192);
  float* al = reinterpret_cast<float*>(smem + wv * 8192 + 4096);
  for (int grp = bid * 4 + wv; grp < TR / 8; grp += nb * 4) {
    const int rt0 = grp * 8;
    float rs2[8];
#pragma unroll
    for (int t = 0; t < 8; ++t) {
      rs2[t] = rsqrtf(p.h2ss[rt0 + t] * (1.0f / D) + RMS_EPS);
      const size_t pb = (size_t)(rt0 + t) * 128;
      idxl[t * 128 + lane] = (unsigned)p.pidx[pb + lane] << 10;
      idxl[t * 128 + 64 + lane] = (unsigned)p.pidx[pb + 64 + lane] << 10;
      al[t * 128 + lane] = p.pgate[pb + lane];
      al[t * 128 + 64 + lane] = p.pgate[pb + 64 + lane];
    }
    __builtin_amdgcn_wave_barrier();
    float dacc[8][2];
#pragma unroll
    for (int t = 0; t < 8; ++t) { dacc[t][0] = 0.f; dacc[t][1] = 0.f; }
#pragma unroll 1
    for (int x = 0; x < 8; ++x) {
      const unsigned coff = 128u * x + 16u * p8;
#pragma unroll 1
      for (int t = 0; t < 8; ++t) {
        f32x2 xp[8];
        {
          const bf16_t* hr = p.h2b + (size_t)(rt0 + t) * D + coff;
          const u32x4 a = *reinterpret_cast<const u32x4*>(hr);
          const u32x4 b = *reinterpret_cast<const u32x4*>(hr + 8);
#pragma unroll
          for (int q = 0; q < 4; ++q) {
            xp[q][0] = __uint_as_float(a[q] << 16); xp[q][1] = __uint_as_float(a[q] & 0xffff0000u);
            xp[4 + q][0] = __uint_as_float(b[q] << 16); xp[4 + q][1] = __uint_as_float(b[q] & 0xffff0000u);
          }
        }
        u32x4 rows[16];
#pragma unroll
        for (int j = 0; j < 16; ++j) {
          const unsigned off = idxl[t * 128 + 8 * j + g3];
          rows[j] = *reinterpret_cast<const u32x4*>(p.u8 + off + coff);
        }
#pragma unroll
        for (int j = 0; j < 16; ++j) {
          f32x2 acc2 = {0.f, 0.f};
#pragma unroll
          for (int q = 0; q < 4; ++q) {
            acc2 += xp[2 * q] * __builtin_amdgcn_cvt_pk_f32_fp8((int)rows[j][q], false);
            acc2 += xp[2 * q + 1] * __builtin_amdgcn_cvt_pk_f32_fp8((int)rows[j][q], true);
          }
          const float sm = dpp_sum8(acc2[0] + acc2[1]);
          if (p8 == (j & 7)) dacc[0][j >> 3] += sm;
        }
        {
          const float r0 = dacc[0][0], r1 = dacc[0][1];
#pragma unroll
          for (int q = 0; q < 7; ++q) { dacc[q][0] = dacc[q + 1][0]; dacc[q][1] = dacc[q + 1][1]; }
          dacc[7][0] = r0; dacc[7][1] = r1;
        }
      }
    }
#pragma unroll
    for (int t = 0; t < 8; ++t)
#pragma unroll
      for (int jj = 0; jj < 2; ++jj) {
        const int slot = 8 * (p8 + 8 * jj) + g3;
        const float dot = dacc[t][jj] * rs2[t] * (1.0f / 256.0f);
        const float gt = al[t * 128 + slot];
        al[t * 128 + slot] = 0.5f * dot * (1.0f + erff(dot * 0.7071067811865476f)) * gt * (1.0f / 16.0f);
      }
    __builtin_amdgcn_wave_barrier();
    float ssq[8];
#pragma unroll
    for (int t = 0; t < 8; ++t) ssq[t] = 0.f;
    const int cw = 8 * (b5 ? 1 : 0) + 4 * (b4 ? 1 : 0) + 2 * (b3 ? 1 : 0);
#pragma unroll 1
    for (int x = 0; x < 8; ++x) {
      const unsigned coff = 128u * x + 16u * p8;
#pragma unroll 1
      for (int t = 0; t < 8; ++t) {
        u32x4 rows[16];
        float av[16];
#pragma unroll
        for (int j = 0; j < 16; ++j) {
          const unsigned off = idxl[t * 128 + 8 * j + g3];
          av[j] = al[t * 128 + 8 * j + g3];
          rows[j] = *reinterpret_cast<const u32x4*>(p.v8 + off + coff);
        }
        f32x2 oa[8];
#pragma unroll
        for (int q = 0; q < 8; ++q) oa[q] = (f32x2){0.f, 0.f};
#pragma unroll
        for (int j = 0; j < 16; ++j) {
          const f32x2 a2 = {av[j], av[j]};
#pragma unroll
          for (int q = 0; q < 4; ++q) {
            oa[2 * q] += a2 * __builtin_amdgcn_cvt_pk_f32_fp8((int)rows[j][q], false);
            oa[2 * q + 1] += a2 * __builtin_amdgcn_cvt_pk_f32_fp8((int)rows[j][q], true);
          }
        }
        f32x2 q4v[4], q2v[2], q1v;
#pragma unroll
        for (int i = 0; i < 4; ++i)
#pragma unroll
          for (int c = 0; c < 2; ++c) {
            const auto r = __builtin_amdgcn_permlane32_swap(__float_as_uint(oa[i][c]), __float_as_uint(oa[i + 4][c]), false, false);
            q4v[i][c] = __uint_as_float(r[0]) + __uint_as_float(r[1]);
          }
#pragma unroll
        for (int i = 0; i < 2; ++i)
#pragma unroll
          for (int c = 0; c < 2; ++c) {
            const auto r = __builtin_amdgcn_permlane16_swap(__float_as_uint(q4v[i][c]), __float_as_uint(q4v[i + 2][c]), false, false);
            q2v[i][c] = __uint_as_float(r[0]) + __uint_as_float(r[1]);
          }
        {
          const f32x2 sd = b3 ? q2v[0] : q2v[1], kp = b3 ? q2v[1] : q2v[0];
          q1v[0] = kp[0] + __int_as_float(__builtin_amdgcn_update_dpp(0, __float_as_int(sd[0]), 0x128, 0xF, 0xF, true));
          q1v[1] = kp[1] + __int_as_float(__builtin_amdgcn_update_dpp(0, __float_as_int(sd[1]), 0x128, 0xF, 0xF, true));
        }
        float* hp = p.out + (size_t)(rt0 + t) * D + coff + cw;
        const f32x2 h3 = *reinterpret_cast<const f32x2*>(hp) + q1v;
        *reinterpret_cast<f32x2*>(hp) = h3;
        {
          const float r0 = ssq[0] + h3[0] * h3[0] + h3[1] * h3[1];
#pragma unroll
          for (int q = 0; q < 7; ++q) ssq[q] = ssq[q + 1];
          ssq[7] = r0;
        }
      }
    }
    asm volatile("s_waitcnt vmcnt(0)" ::: "memory");
    {
      float rsv[8];
#pragma unroll
      for (int t = 0; t < 8; ++t) rsv[t] = rsqrtf(wave_sum(ssq[t]) * (1.0f / D) + RMS_EPS);
      f32x2 gfv[8];
#pragma unroll
      for (int x = 0; x < 8; ++x) gfv[x] = *reinterpret_cast<const f32x2*>(p.g_fin + 128 * x + 16 * p8 + cw);
      unsigned long long hv[8][8];
#pragma unroll
      for (int t = 0; t < 8; ++t)
#pragma unroll
        for (int x = 0; x < 8; ++x)
          hv[t][x] = __hip_atomic_load(reinterpret_cast<unsigned long long*>(p.out + (size_t)(rt0 + t) * D + 128 * x + 16 * p8 + cw),
                                       __ATOMIC_RELAXED, __HIP_MEMORY_SCOPE_AGENT);
#pragma unroll
      for (int t = 0; t < 8; ++t)
#pragma unroll
        for (int x = 0; x < 8; ++x) {
          f32x2 o2;
          o2[0] = __uint_as_float((unsigned)hv[t][x]) * rsv[t] * gfv[x][0];
          o2[1] = __uint_as_float((unsigned)(hv[t][x] >> 32)) * rsv[t] * gfv[x][1];
          *reinterpret_cast<f32x2*>(p.out + (size_t)(rt0 + t) * D + 128 * x + 16 * p8 + cw) = o2;
        }
    }
    __builtin_amdgcn_wave_barrier();
  }
}

#define XB_TMO      128
#define XB_XCNT(j)  (256  + 64 * (j))
#define XB_XSUB(j)  (1280 + 64 * (j))
#define XB_XGEN(j)  (2304 + 64 * (j))
#define XB_TOP      3328
#define XB_TOPGEN   3392
#define XCD_BAR_WORDS 3456
#define XB_SPIN_CAP (1u << 18)
#define LAS __attribute__((address_space(3)))
__device__ __forceinline__ unsigned xb_ld(unsigned* p) { return __hip_atomic_load(p, __ATOMIC_RELAXED, __HIP_MEMORY_SCOPE_AGENT); }
__device__ __forceinline__ unsigned xb_add(unsigned* p, unsigned v) { return __hip_atomic_fetch_add(p, v, __ATOMIC_RELAXED, __HIP_MEMORY_SCOPE_AGENT); }
__device__ __forceinline__ unsigned xb_xcc_id() { return (unsigned)__builtin_amdgcn_s_getreg((3 << 11) | 20) & 0xFu; }
#define XB_SPIN(cond, bar) do { unsigned _sp = 0; while (cond) { __builtin_amdgcn_s_sleep(1); \
    if ((++_sp & 255u) == 0u) { if (xb_ld(&(bar)[XB_TMO])) break; if (_sp > XB_SPIN_CAP) { atomicAdd(&(bar)[XB_TMO], 1u); break; } } } } while (0)
struct XcdBarrier { unsigned* bar; unsigned x; volatile LAS unsigned* st; };
__device__ __forceinline__ XcdBarrier xcd_barrier_post(unsigned* bar, volatile LAS unsigned* st) {
  XcdBarrier b; b.bar = bar; b.x = xb_xcc_id(); b.st = st;
  if (threadIdx.x == 0) (void)xb_add(&bar[XB_XCNT(b.x)], 1u);
  return b;
}
__device__ __forceinline__ void xcd_barrier_complete(unsigned* bar, unsigned x, unsigned& nloc, unsigned& nx) {
  const unsigned G = gridDim.x * gridDim.y * gridDim.z;
  unsigned sum, cnt, mine, sp = 0u;
  for (;;) {
    sum = 0u; cnt = 0u; mine = 0u;
#pragma unroll
    for (unsigned j = 0; j < 16; ++j) { const unsigned c = xb_ld(&bar[XB_XCNT(j)]); sum += c; cnt += (c > 0u) ? 1u : 0u; mine = (j == x) ? c : mine; }
    if (sum == G) break;
    __builtin_amdgcn_s_sleep(1);
    if ((++sp & 255u) == 0u) { if (xb_ld(&bar[XB_TMO])) break; if (sp > XB_SPIN_CAP) { atomicAdd(&bar[XB_TMO], 1u); break; } }
  }
  nloc = mine > 0u ? mine : 1u; nx = cnt > 0u ? cnt : 1u;
}
__device__ __forceinline__ void xcd_barrier(const XcdBarrier& b) {
  asm volatile("s_waitcnt vmcnt(0)" ::: "memory");
  __syncthreads();
  if (threadIdx.x == 0) {
    unsigned* bar = b.bar;
    __builtin_amdgcn_s_waitcnt(0);
    unsigned nloc = b.st[0], nx = b.st[1];
    if (nloc == 0u) { xcd_barrier_complete(bar, b.x, nloc, nx); b.st[0] = nloc; b.st[1] = nx; }
    const unsigned old = xb_add(&bar[XB_XSUB(b.x)], 1u);
    const unsigned gen = old / nloc;
    if (old + 1u == (gen + 1u) * nloc) {
      __builtin_amdgcn_fence(__ATOMIC_RELEASE, "agent");
      asm volatile("s_waitcnt vmcnt(0)" ::: "memory");
      const unsigned og = xb_add(&bar[XB_TOP], 1u);
      const unsigned tg = og / nx;
      if (og + 1u == (tg + 1u) * nx) xb_add(&bar[XB_TOPGEN], 1u);
      else XB_SPIN(xb_ld(&bar[XB_TOPGEN]) == tg, bar);
      __builtin_amdgcn_fence(__ATOMIC_ACQUIRE, "agent");
      xb_add(&bar[XB_XGEN(b.x)], 1u);
      asm volatile("s_waitcnt vmcnt(0)" ::: "memory");
    } else {
      XB_SPIN(xb_ld(&bar[XB_XGEN(b.x)]) == gen, bar);
      __builtin_amdgcn_fence(__ATOMIC_ACQUIRE, "agent");
      asm volatile("s_waitcnt vmcnt(0)" ::: "memory");
    }
  }
  __syncthreads();
}

constexpr int SMEM_FLOATS = 18944 + 4;


__global__ void __launch_bounds__(NTHR, 2) k_mega(Params p) {
  __shared__ __attribute__((aligned(16))) float smem[SMEM_FLOATS];
  if (threadIdx.x == 0) { smem[18944] = 0.f; smem[18945] = 0.f; smem[18946] = 0.f; smem[18947] = 0.f; }
  __syncthreads();
  const XcdBarrier xb = xcd_barrier_post(p.bar, (volatile LAS unsigned*)&smem[18944]);
  if (p.never) { cg::grid_group grid = cg::this_grid(); grid.sync(); }
  const int bid = blockIdx.x, nb = gridDim.x;
  ph_prep(p, bid, nb);
  xcd_barrier(xb);
  ph_inproj(p, (char*)smem, bid, nb);
  if (nb > 384) { if (bid >= 256) ph_w2(p, (char*)smem, bid - 256, nb - 256); }
  else ph_w2(p, (char*)smem, bid, nb);
  xcd_barrier(xb);
  ph_rwkv_prep(p, (char*)smem, bid, nb);
  ph_q_up(p, (char*)smem, bid, nb);
  ph_kv_up(p, (char*)smem, bid, nb);
  xcd_barrier(xb);
  ph_rwkv_pre(p, (char*)smem, bid, nb);
  ph_rwkv_pq(p, bid, nb);
  xcd_barrier(xb);
  if (bid < 64) ph_chain(p, (char*)smem, bid, 64);
  else { ph_attn(p, (char*)smem, bid - 64, nb - 64); ph_tabconv(p, bid - 64, nb - 64); }
  xcd_barrier(xb);
  ph_outproj(p, (char*)smem, bid, nb);
  xcd_barrier(xb);
  ph_route(p, (char*)smem, bid, nb);
  xcd_barrier(xb);
  ph_expert(p, (char*)smem, bid, nb);
}

extern "C" void kernel_launch(void* const* d_in, const int* in_sizes, int n_in, void* d_out, int out_size, void* d_ws,
                              size_t ws_size, hipStream_t stream) {
  Params p{};
  const float* const* in = reinterpret_cast<const float* const*>(d_in);
  p.x = in[0]; p.meta = in[1]; p.g_mix = in[2]; p.w_in = in[3]; p.g_q = in[4]; p.w_uq = in[5]; p.g_kv = in[6];
  p.w_ukv = in[7]; p.g_out = in[8]; p.mu = in[9]; p.w0 = in[10]; p.w_up = in[11]; p.a0 = in[12]; p.a_up = in[13];
  p.g_up = in[14]; p.k_k = in[15]; p.k_a = in[16]; p.r_k = in[17]; p.ln_w = in[18]; p.ln_b = in[19]; p.w_out = in[20];
  p.g_ffn = in[21]; p.w_q = in[22]; p.subk = in[23]; p.pu = in[24]; p.pv = in[25]; p.g_fin = in[26];
  p.out = (float*)d_out;
  char* ws = (char*)d_ws;
  size_t off = 0;
  auto take = [&](size_t bytes) { char* r = ws + off; off += (bytes + 255) & ~(size_t)255; return r; };
  p.bar = (unsigned*)take((size_t)XCD_BAR_WORDS * 4);
  p.h2ss = (float*)take((size_t)TR * 4);
  const size_t zero_bytes = off;
  p.rstd1 = (float*)take((size_t)T * 4);
  p.ossq = (float*)take((size_t)T * 4 * 4);
  p.w_inT = (bf16_t*)take((size_t)DIN * 1024 * 2);
  p.w_uqT = (bf16_t*)take((size_t)768 * 256 * 2);
  p.w_ukvT = (bf16_t*)take((size_t)1024 * 128 * 2);
  p.w_outT = (bf16_t*)take((size_t)1024 * 1024 * 2);
  p.w_qT = (bf16_t*)take((size_t)2048 * 1024 * 2);
  p.subkb = (bf16_t*)take((size_t)8 * 2 * 128 * 128 * 2);
  p.w_lrT = (bf16_t*)take((size_t)1536 * 128 * 2);
  p.ropec = (float*)take((size_t)L * 32 * 4);
  p.ropes = (float*)take((size_t)L * 32 * 4);
  char* regA = take((size_t)T * DIN * 2);
  char* regB = take((size_t)T * (768 + 1024 + 64) * 2);
  char* regBend = ws + off;
  char* regC = take((size_t)T * 512 * 2 * 7);
  if (off > ws_size) fprintf(stderr, "workspace too small: need %zu have %zu\n", off, ws_size);
  p.proj = (bf16_t*)regA;
  {
    const size_t NW = (size_t)NB_ * 8 * NCH;
    p.cd_qm = (unsigned char*)regA;
    p.cd_wt = p.cd_qm + NW * 2048;
    p.cd_zt = p.cd_wt + NW * 2048;
    p.cd_vb = p.cd_zt + NW * 2048;
    p.cd_bk = (unsigned char*)d_out;
    p.cd_ah = p.cd_bk + NW * 4096;
    p.cd_gc = (float*)(p.cd_ah + NW * 2048);
  }
  p.h2b = (bf16_t*)regA;
  p.pidx = (int*)(regA + (size_t)TR * D * 2);
  p.pgate = (float*)(regA + (size_t)TR * D * 2 + (size_t)TR * 128 * 4);
  p.qf = (bf16_t*)regB;
  p.kn = (bf16_t*)(regB + (size_t)T * 768 * 2);
  p.vt = (bf16_t*)(regB + (size_t)T * (768 + 512) * 2);
  p.kr = (bf16_t*)(regB + (size_t)T * (768 + 1024) * 2);
  p.hb = (bf16_t*)regC;
  p.w_qb = (bf16_t*)(regC + (size_t)40 * 1024 * 1024);
  bf16_t* c = (bf16_t*)regC;
  const size_t a512 = (size_t)T * 512;
  p.rr = c; p.rk2 = c + a512; p.rv = c + 2 * a512; p.rkk = c + 3 * a512; p.rbb = c + 4 * a512; p.rg = c + 5 * a512; p.rlw = c + 6 * a512;
  p.u8 = (unsigned char*)regC;
  p.v8 = p.u8 + (size_t)16384 * 1024;
  static int grid_blocks = 0;
  if (!grid_blocks) {
    int dev = 0, cus = 0, per_cu = 0;
    (void)hipGetDevice(&dev);
    (void)hipDeviceGetAttribute(&cus, hipDeviceAttributeMultiprocessorCount, dev);
    (void)hipOccupancyMaxActiveBlocksPerMultiprocessor(&per_cu, k_mega, NTHR, 0);
    if (per_cu > 2) per_cu = 2;
    grid_blocks = cus * per_cu;
  }
  (void)hipMemsetAsync(p.bar, 0, zero_bytes, stream);
  void* args[] = {&p};
  hipError_t e = hipLaunchCooperativeKernel((void*)k_mega, dim3(grid_blocks), dim3(NTHR), args, 0, stream);
  if (e != hipSuccess) fprintf(stderr, "cooperative launch failed: %s (grid %d)\n", hipGetErrorString(e), grid_blocks);
}
```

```cpp
#include <hip/hip_runtime.h>
#include <hip/hip_cooperative_groups.h>
#include <stdint.h>
#include <stdio.h>
#include <math.h>

constexpr int NB_ = 8, SEQ = 2048, NM = 16, L = 2064, T = NB_ * L, TR = NB_ * SEQ, D = 1024, DIN = 2240;
constexpr int NTHR = 256;
constexpr float RMS_EPS = 1e-6f;
typedef unsigned short bf16_t;
namespace cg = cooperative_groups;

struct Params {
  const float *x, *meta, *g_mix, *w_in, *g_q, *w_uq, *g_kv, *w_ukv, *g_out, *mu, *w0, *w_up, *a0, *a_up, *g_up,
      *k_k, *k_a, *r_k, *ln_w, *ln_b, *w_out, *g_ffn, *w_q, *subk, *pu, *pv, *g_fin;
  float* out;
  float *rstd1;
  float *ossq;
  float *h2ss;
  bf16_t* proj;
  bf16_t *qf, *kn, *vt, *kr;
  float *ropec, *ropes;
  bf16_t *rr, *rk2, *rv, *rkk, *rbb, *rg, *rlw;
  unsigned char *cd_ah, *cd_qm, *cd_bk, *cd_wt, *cd_zt, *cd_vb;
  float* cd_gc;
  bf16_t* h2b;
  int* pidx;
  float* pgate;
  unsigned* bar;
  int never;
  int pad0;
  bf16_t* hb;
  unsigned char *u8, *v8;
  bf16_t *w_inT, *w_uqT, *w_ukvT, *w_outT, *w_qT;
  bf16_t *w_qb;
  bf16_t *subkb;
  bf16_t *w_lrT;
};

typedef float f32x2_cv __attribute__((ext_vector_type(2)));
typedef __bf16 bf16x2_cv __attribute__((ext_vector_type(2)));
__device__ __forceinline__ unsigned pk2bf(float a, float b) {
  const f32x2_cv v = {a, b};
  return __builtin_bit_cast(unsigned, __builtin_convertvector(v, bf16x2_cv));
}
__device__ __forceinline__ bf16_t f2bf(float f) { return (bf16_t)(pk2bf(f, 0.0f) & 0xffffu); }
__device__ __forceinline__ float bf2f(bf16_t h) { return __uint_as_float(((unsigned)h) << 16); }
__device__ __forceinline__ float wave_sum(float v) {
#pragma unroll
  for (int o = 32; o > 0; o >>= 1) v += __shfl_xor(v, o, 64);
  return v;
}
__device__ __forceinline__ const float* hrow(const Params& p, int tt) {
  int b = tt / L, pos = tt - b * L;
  return pos < NM ? p.meta + (size_t)pos * D : p.x + ((size_t)(b * SEQ + pos - NM)) * D;
}
__device__ __forceinline__ int rt2tt(int rt) { return (rt >> 11) * L + NM + (rt & 2047); }

template <class AF, class BF, class EF>
__device__ __forceinline__ void gemm_naive(int M, int N, int K, AF af, BF bf, EF ef, int bid, int nb) {
  const int ncb = (N + 255) / 256;
  const int ntiles = (M / 8) * ncb;
  for (int tile = bid; tile < ntiles; tile += nb) {
    const int r0 = (tile / ncb) * 8;
    const int n = (tile % ncb) * 256 + threadIdx.x;
    if (n < N) {
      float a0 = 0, a1 = 0, a2 = 0, a3 = 0, a4 = 0, a5 = 0, a6 = 0, a7 = 0;
      for (int k = 0; k < K; ++k) {
        const float bv = bf(k, n);
        a0 += af(r0 + 0, k) * bv; a1 += af(r0 + 1, k) * bv; a2 += af(r0 + 2, k) * bv; a3 += af(r0 + 3, k) * bv;
        a4 += af(r0 + 4, k) * bv; a5 += af(r0 + 5, k) * bv; a6 += af(r0 + 6, k) * bv; a7 += af(r0 + 7, k) * bv;
      }
      ef(r0 + 0, n, a0); ef(r0 + 1, n, a1); ef(r0 + 2, n, a2); ef(r0 + 3, n, a3);
      ef(r0 + 4, n, a4); ef(r0 + 5, n, a5); ef(r0 + 6, n, a6); ef(r0 + 7, n, a7);
    }
  }
}


typedef __attribute__((ext_vector_type(8))) short bf16x8;
typedef __attribute__((ext_vector_type(4))) float f32x4;
typedef __attribute__((ext_vector_type(4))) unsigned u32x4;
typedef __attribute__((ext_vector_type(2))) float f32x2;
typedef __attribute__((ext_vector_type(4))) short bf16x4;
typedef __attribute__((ext_vector_type(2))) unsigned u32x2;
constexpr int NCH = 129;

__device__ __forceinline__ uint2 pack4bf(float a, float b, float c, float d) {
  uint2 r;
  r.x = pk2bf(a, b);
  r.y = pk2bf(c, d);
  return r;
}

__device__ __forceinline__ bf16x4 pk4(const f32x4 v) {
  const uint2 t = pack4bf(v[0], v[1], v[2], v[3]);
  u32x2 u; u[0] = t.x; u[1] = t.y;
  return __builtin_bit_cast(bf16x4, u);
}
__device__ __forceinline__ f32x4 unpk4(const u32x2 u) {
  f32x4 r;
  r[0] = __uint_as_float(u[0] << 16); r[1] = __uint_as_float(u[0] & 0xffff0000u);
  r[2] = __uint_as_float(u[1] << 16); r[3] = __uint_as_float(u[1] & 0xffff0000u);
  return r;
}
#define MFMA16(a, b, c) __builtin_amdgcn_mfma_f32_16x16x16bf16_1k(a, b, c, 0, 0, 0)
#define MFMA32(a, b, c) __builtin_amdgcn_mfma_f32_16x16x32_bf16(a, b, c, 0, 0, 0)

__device__ __forceinline__ float dpp_sum8(float v) {
  v += __int_as_float(__builtin_amdgcn_update_dpp(0, __float_as_int(v), 0xB1, 0xF, 0xF, true));
  v += __int_as_float(__builtin_amdgcn_update_dpp(0, __float_as_int(v), 0x4E, 0xF, 0xF, true));
  v += __int_as_float(__builtin_amdgcn_update_dpp(0, __float_as_int(v), 0x141, 0xF, 0xF, true));
  return v;
}
__device__ __forceinline__ float tr_reduce16(const float (&pd)[16], int lane) {
  const bool b5 = lane & 32, b4 = lane & 16, b3 = lane & 8, b2 = lane & 4;
  float q8[8], q4[4], q2[2], q1;
#pragma unroll
  for (int i = 0; i < 8; ++i) { const float sd = b5 ? pd[i] : pd[i + 8], kp = b5 ? pd[i + 8] : pd[i]; q8[i] = kp + __shfl_xor(sd, 32, 64); }
#pragma unroll
  for (int i = 0; i < 4; ++i) { const float sd = b4 ? q8[i] : q8[i + 4], kp = b4 ? q8[i + 4] : q8[i]; q4[i] = kp + __shfl_xor(sd, 16, 64); }
#pragma unroll
  for (int i = 0; i < 2; ++i) { const float sd = b3 ? q4[i] : q4[i + 2], kp = b3 ? q4[i + 2] : q4[i]; q2[i] = kp + __shfl_xor(sd, 8, 64); }
  { const float sd = b2 ? q2[0] : q2[1], kp = b2 ? q2[1] : q2[0]; q1 = kp + __shfl_xor(sd, 4, 64); }
  q1 += __shfl_xor(q1, 2, 64);
  q1 += __shfl_xor(q1, 1, 64);
  return q1;
}

struct NoMid { __device__ __forceinline__ void operator()(int, f32x4 (&)[4][4]) const {} };
template <bool TRANS, bool ZERO = true, bool SPLITA = false, class ALoad, class BLoad, class Mid = NoMid>
__device__ __forceinline__ void gemm_tile(char* smem, int m0, int n0, int kt0, int kt1, ALoad aload, BLoad bload, f32x4 (&acc)[4][4], Mid mid = Mid()) {
  const int tid = threadIdx.x, lane = tid & 63, w = tid >> 6, wm = w >> 1, wn = w & 1;
  const int srow = tid >> 3, sslot = tid & 7;
  const int swz = (sslot ^ (srow & 7)) << 4;
  char* sA = smem;
  char* sB = smem + 32768;
  const int g = lane >> 4, r16 = lane & 15;
  const int fa0 = (wm * 64 + r16) * 128 + (((0 + g) ^ (lane & 7)) << 4);
  const int fa1 = (wm * 64 + r16) * 128 + (((4 + g) ^ (lane & 7)) << 4);
  const int fb0 = (wn * 64 + r16) * 128 + (((0 + g) ^ (lane & 7)) << 4);
  const int fb1 = (wn * 64 + r16) * 128 + (((4 + g) ^ (lane & 7)) << 4);
  u32x4 ra[4], rb[4];
#pragma unroll
  for (int i = 0; i < 4; ++i) {
    ra[i] = aload(m0 + srow + 32 * i, kt0 * 64 + sslot * 8, i);
    rb[i] = bload(n0 + srow + 32 * i, kt0 * 64 + sslot * 8);
  }
  if constexpr (ZERO) {
#pragma unroll
    for (int i = 0; i < 4; ++i)
#pragma unroll
      for (int j = 0; j < 4; ++j) acc[i][j] = (f32x4){0.f, 0.f, 0.f, 0.f};
  }
  __syncthreads();
#pragma unroll
  for (int i = 0; i < 4; ++i) {
    *reinterpret_cast<u32x4*>(sA + (srow + 32 * i) * 128 + swz) = ra[i];
    *reinterpret_cast<u32x4*>(sB + (srow + 32 * i) * 128 + swz) = rb[i];
  }
  __syncthreads();
  for (int kt = kt0; kt < kt1; ++kt) {
    const int cur = ((kt - kt0) & 1) * 16384;
    mid(kt, acc);
    if (kt + 1 < kt1) {
#pragma unroll
      for (int i = 0; i < 4; ++i) {
        if (!SPLITA || i < 2) ra[i] = aload(m0 + srow + 32 * i, (kt + 1) * 64 + sslot * 8, i);
        rb[i] = bload(n0 + srow + 32 * i, (kt + 1) * 64 + sslot * 8);
      }
    }
#pragma unroll
    for (int ks = 0; ks < 2; ++ks) {
      if (SPLITA && ks == 1 && kt + 1 < kt1) {
#pragma unroll
        for (int i = 2; i < 4; ++i) ra[i] = aload(m0 + srow + 32 * i, (kt + 1) * 64 + sslot * 8, i);
      }
      bf16x8 af[4], bfr[4];
#pragma unroll
      for (int i = 0; i < 4; ++i) af[i] = *reinterpret_cast<const bf16x8*>(sA + cur + (ks ? fa1 : fa0) + i * 2048);
#pragma unroll
      for (int j = 0; j < 4; ++j) bfr[j] = *reinterpret_cast<const bf16x8*>(sB + cur + (ks ? fb1 : fb0) + j * 2048);
#pragma unroll
      for (int i = 0; i < 4; ++i)
#pragma unroll
        for (int j = 0; j < 4; ++j) {
          if constexpr (TRANS) acc[i][j] = __builtin_amdgcn_mfma_f32_16x16x32_bf16(bfr[j], af[i], acc[i][j], 0, 0, 0);
          else acc[i][j] = __builtin_amdgcn_mfma_f32_16x16x32_bf16(af[i], bfr[j], acc[i][j], 0, 0, 0);
        }
    }
    if (kt + 1 < kt1) {
      const int nxt = 16384 - cur;
#pragma unroll
      for (int i = 0; i < 4; ++i) {
        *reinterpret_cast<u32x4*>(sA + nxt + (srow + 32 * i) * 128 + swz) = ra[i];
        *reinterpret_cast<u32x4*>(sB + nxt + (srow + 32 * i) * 128 + swz) = rb[i];
      }
    }
    __syncthreads();
  }
}
#define GLDS16(gp, lp) __builtin_amdgcn_global_load_lds((const __attribute__((address_space(1))) void*)(gp), (__attribute__((address_space(3))) void*)(lp), 16, 0, 0)
template <bool TRANS, class APtr, class BPtr, class Mid = NoMid>
__device__ __forceinline__ void gemm_tile_glds(char* smem, int m0, int n0, int nk32, APtr aptr, BPtr bptr, f32x4 (&acc)[4][4], Mid mid = Mid()) {
  const int tid = threadIdx.x, lane = tid & 63, w = tid >> 6, wm = w >> 1, wn = w & 1;
  const int lrow = lane >> 2;
  const int schunk = ((lane & 3) ^ ((lrow >> 2) & 3)) * 8;
  const int wb = (__builtin_amdgcn_readfirstlane(tid) >> 6);
  const int g = lane >> 4, r16 = lane & 15;
  const int fsl = (g ^ ((r16 >> 2) & 3)) << 4;
  const int fa = (wm * 64 + r16) * 64 + fsl;
  const int fb = 8192 + (wn * 64 + r16) * 64 + fsl;
#pragma unroll
  for (int i = 0; i < 4; ++i)
#pragma unroll
    for (int j = 0; j < 4; ++j) acc[i][j] = (f32x4){0.f, 0.f, 0.f, 0.f};
  __syncthreads();
  auto issue = [&](int kt) {
    char* st = smem + (kt & 3) * 16384;
#pragma unroll
    for (int i = 0; i < 2; ++i) {
      const int row = 16 * wb + 64 * i + lrow;
      GLDS16(aptr(m0 + row, kt * 32 + schunk), st + (16 * wb + 64 * i) * 64);
      GLDS16(bptr(n0 + row, kt * 32 + schunk), st + 8192 + (16 * wb + 64 * i) * 64);
    }
  };
  issue(0);
  if (nk32 > 1) issue(1);
  if (nk32 > 2) issue(2);
  for (int kt = 0; kt < nk32; ++kt) {
    if (kt + 2 < nk32) asm volatile("s_waitcnt vmcnt(8)\n\ts_barrier" ::: "memory");
    else if (kt + 1 < nk32) asm volatile("s_waitcnt vmcnt(4)\n\ts_barrier" ::: "memory");
    else asm volatile("s_waitcnt vmcnt(0)\n\ts_barrier" ::: "memory");
    if (kt + 3 < nk32) issue(kt + 3);
    mid(kt, acc);
    const char* st = smem + (kt & 3) * 16384;
    bf16x8 af[4], bfr[4];
#pragma unroll
    for (int i = 0; i < 4; ++i) af[i] = *reinterpret_cast<const bf16x8*>(st + fa + i * 1024);
#pragma unroll
    for (int j = 0; j < 4; ++j) bfr[j] = *reinterpret_cast<const bf16x8*>(st + fb + j * 1024);
#pragma unroll
    for (int i = 0; i < 4; ++i)
#pragma unroll
      for (int j = 0; j < 4; ++j) {
        if constexpr (TRANS) acc[i][j] = __builtin_amdgcn_mfma_f32_16x16x32_bf16(bfr[j], af[i], acc[i][j], 0, 0, 0);
        else acc[i][j] = __builtin_amdgcn_mfma_f32_16x16x32_bf16(af[i], bfr[j], acc[i][j], 0, 0, 0);
      }
  }
  __syncthreads();
}
struct NoMidW { __device__ __forceinline__ void operator()(int, f32x4 (&)[4][8]) const {} };
template <class APtr, class BPtr, class Mid = NoMidW>
__device__ __forceinline__ void gemm_tile_wide(char* smem, int m0, int n0, int nk32, APtr aptr, BPtr bptr, f32x4 (&acc)[4][8], Mid mid = Mid()) {
  const int tid = threadIdx.x, lane = tid & 63, w = tid >> 6, wm = w >> 1, wn = w & 1;
  const int lrow = lane >> 2;
  const int schunk = ((lane & 3) ^ ((lrow >> 2) & 3)) * 8;
  const int wb = (__builtin_amdgcn_readfirstlane(tid) >> 6);
  const int g = lane >> 4, r16 = lane & 15;
  const int fsl = (g ^ ((r16 >> 2) & 3)) << 4;
  const int fa = (wm * 64 + r16) * 64 + fsl;
  const int fb = 8192 + (wn * 128 + r16) * 64 + fsl;
#pragma unroll
  for (int i = 0; i < 4; ++i)
#pragma unroll
    for (int j = 0; j < 8; ++j) acc[i][j] = (f32x4){0.f, 0.f, 0.f, 0.f};
  __syncthreads();
  auto issue = [&](int kt) {
    char* st = smem + (kt % 3) * 24576;
#pragma unroll
    for (int i = 0; i < 2; ++i) GLDS16(aptr(m0 + 16 * wb + 64 * i + lrow, kt * 32 + schunk), st + (16 * wb + 64 * i) * 64);
#pragma unroll
    for (int i = 0; i < 4; ++i) GLDS16(bptr(n0 + 16 * wb + 64 * i + lrow, kt * 32 + schunk), st + 8192 + (16 * wb + 64 * i) * 64);
  };
  issue(0);
  if (nk32 > 1) issue(1);
  for (int kt = 0; kt < nk32; ++kt) {
    if (kt + 1 < nk32) asm volatile("s_waitcnt vmcnt(6)\n\ts_barrier" ::: "memory");
    else asm volatile("s_waitcnt vmcnt(0)\n\ts_barrier" ::: "memory");
    if (kt + 2 < nk32) issue(kt + 2);
    mid(kt, acc);
    const char* st = smem + (kt % 3) * 24576;
    bf16x8 af[4], bfr[8];
#pragma unroll
    for (int i = 0; i < 4; ++i) af[i] = *reinterpret_cast<const bf16x8*>(st + fa + i * 1024);
#pragma unroll
    for (int j = 0; j < 8; ++j) bfr[j] = *reinterpret_cast<const bf16x8*>(st + fb + j * 1024);
#pragma unroll
    for (int i = 0; i < 4; ++i)
#pragma unroll
      for (int j = 0; j < 8; ++j) acc[i][j] = __builtin_amdgcn_mfma_f32_16x16x32_bf16(bfr[j], af[i], acc[i][j], 0, 0, 0);
  }
  __syncthreads();
}
__device__ __forceinline__ void stage_acc_half(char* smem, const f32x4 (&acc)[4][8], int half) {
  const int lane = threadIdx.x & 63, w = threadIdx.x >> 6, wm = w >> 1, wn = w & 1, g = lane >> 4, r16 = lane & 15;
  float* Et = reinterpret_cast<float*>(smem);
  __syncthreads();
  if (wn == half) {
#pragma unroll
    for (int i = 0; i < 4; ++i)
#pragma unroll
      for (int j = 0; j < 8; ++j)
        *reinterpret_cast<f32x4*>(Et + (wm * 64 + 16 * i + r16) * 132 + 16 * j + 4 * g) = acc[i][j];
  }
  __syncthreads();
}
template <class Body>
__device__ __forceinline__ void for_tiles_xcd(int MT, int NT, int bid, int nb, Body body, int rshift = 0) {
  if (nb & 7) {
    for (int e = bid; e < MT * NT; e += nb) body(e / NT, e % NT);
    return;
  }
  const int x = bid & 7, lb = bid >> 3, nlb = nb >> 3;
  const int mper = (MT >> 3) & ~3;
  const int main_cnt = mper * NT;
  for (int q = lb; q < main_cnt; q += nlb) {
    const int patch = q / (4 * NT), r = q - patch * (4 * NT);
    body(x * mper + patch * 4 + (r & 3), r >> 2);
  }
  const int rem = (MT - 8 * mper) * NT;
  const int rb = ((nb - 1 - bid - rshift) % nb + nb) % nb;
  for (int e = rb; e < rem; e += nb) body(8 * mper + e / NT, e % NT);
}
__device__ __forceinline__ void st8f(bf16_t* dst, const float (&v)[8]) {
  u32x4 w;
#pragma unroll
  for (int e = 0; e < 4; ++e) w[e] = pk2bf(v[2 * e], v[2 * e + 1]);
  *reinterpret_cast<u32x4*>(dst) = w;
}
__device__ __forceinline__ void stage_acc(char* smem, const f32x4 (&acc)[4][4]) {
  const int lane = threadIdx.x & 63, w = threadIdx.x >> 6, wm = w >> 1, wn = w & 1, g = lane >> 4, r16 = lane & 15;
  float* Et = reinterpret_cast<float*>(smem);
#pragma unroll
  for (int i = 0; i < 4; ++i)
#pragma unroll
    for (int j = 0; j < 4; ++j)
      *reinterpret_cast<f32x4*>(Et + (wm * 64 + 16 * i + r16) * 132 + wn * 64 + 16 * j + 4 * g) = acc[i][j];
  __syncthreads();
}
__device__ __forceinline__ void ld8(const char* smem, int row, int col8, float (&v)[8]) {
  const float* Et = reinterpret_cast<const float*>(smem);
  const f32x4 a = *reinterpret_cast<const f32x4*>(Et + row * 132 + col8), b = *reinterpret_cast<const f32x4*>(Et + row * 132 + col8 + 4);
#pragma unroll
  for (int e = 0; e < 4; ++e) { v[e] = a[e]; v[4 + e] = b[e]; }
}
__device__ __forceinline__ float sumsq8(const u32x4 v) {
  float s = 0.f;
#pragma unroll
  for (int q = 0; q < 4; ++q) {
    const float lo = __uint_as_float(v[q] << 16), hi = __uint_as_float(v[q] & 0xffff0000u);
    s += lo * lo + hi * hi;
  }
  return s;
}
__device__ __forceinline__ void rowss_publish(float* rowss, const float (&ss)[4]) {
  const int srow = threadIdx.x >> 3, sslot = threadIdx.x & 7;
#pragma unroll
  for (int i = 0; i < 4; ++i) {
    float v = ss[i];
    v += __shfl_xor(v, 1, 64); v += __shfl_xor(v, 2, 64); v += __shfl_xor(v, 4, 64);
    if (sslot == 0) rowss[srow + 32 * i] = v;
  }
  __syncthreads();
}
template <bool TRANS, class ARow, class BRow, class Epi>
__device__ __forceinline__ void gemm_bf16(char* smem, int mtiles, int N, int K, ARow arow, BRow brow,
                                          Epi epi, int bid, int nb) {
  const int lane = threadIdx.x & 63, w = threadIdx.x >> 6, wm = w >> 1, wn = w & 1, g = lane >> 4, r16 = lane & 15;
  const int ntn = (N + 127) >> 7;
  for (int tile = bid; tile < mtiles * ntn; tile += nb) {
    const int tm = tile / ntn, tn = tile - tm * ntn;
    const int m0 = tm * 128, n0 = tn * 128;
    f32x4 acc[4][4];
    gemm_tile<TRANS>(smem, m0, n0, 0, K >> 6,
        [&](int r, int k, int) { return *reinterpret_cast<const u32x4*>(arow(r) + k); },
        [&](int n, int k) { return *reinterpret_cast<const u32x4*>(brow(min(n, N - 1)) + k); }, acc);
    if constexpr (TRANS) epi(acc, m0 + wm * 64 + r16, n0 + wn * 64 + 4 * g);
    else epi(acc, m0 + wm * 64 + 4 * g, n0 + wn * 64 + r16);
  }
}

__device__ __forceinline__ void wtrans(const float* __restrict__ W, const float* __restrict__ gk, int K, int N, bf16_t* out,
                                       int gtid, int gthreads, int glim = 1 << 30) {
  const int total = N * (K >> 3);
#pragma unroll 2
  for (int idx = gtid; idx < total; idx += gthreads) {
    const int n = idx % N, kc = idx / N;
    float v[8];
#pragma unroll
    for (int i = 0; i < 8; ++i) {
      const int k = kc * 8 + i;
      v[i] = W[(size_t)k * N + n] * ((gk && k < glim) ? gk[k] : 1.0f);
    }
    uint4 o;
    uint2 lo = pack4bf(v[0], v[1], v[2], v[3]), hi = pack4bf(v[4], v[5], v[6], v[7]);
    o.x = lo.x; o.y = lo.y; o.z = hi.x; o.w = hi.y;
    *reinterpret_cast<uint4*>(out + (size_t)n * K + kc * 8) = o;
  }
}

__device__ __forceinline__ void ph_prep(const Params& p, int bid, int nb) {
  const int lane = threadIdx.x & 63, wv = threadIdx.x >> 6;
#pragma unroll 2
  for (int tt = bid * 4 + wv; tt < T; tt += nb * 4) {
    const float4* hr = reinterpret_cast<const float4*>(hrow(p, tt));
    float s = 0;
#pragma unroll
    for (int j = 0; j < 4; ++j) {
      const float4 v = hr[j * 64 + lane];
      s += v.x * v.x + v.y * v.y + v.z * v.z + v.w * v.w;
      *reinterpret_cast<uint2*>(p.hb + (size_t)tt * D + (j * 64 + lane) * 4) = pack4bf(v.x, v.y, v.z, v.w);
    }
    s = wave_sum(s);
    if (lane == 0) p.rstd1[tt] = rsqrtf(s * (1.0f / D) + RMS_EPS);
  }
  const int gtid = bid * NTHR + threadIdx.x, gth = nb * NTHR;
  for (int e = gtid; e < L * 32; e += gth) {
    const int i = e & 31, pos = e >> 5;
    const float inv = exp2f(-(float)i * (13.287712379549449f / 32.0f));
    float sn, cs; sincosf((float)pos * inv, &sn, &cs);
    p.ropec[e] = cs; p.ropes[e] = sn;
  }
  wtrans(p.w_in, p.g_mix, 1024, DIN, p.w_inT, gtid, gth);
  wtrans(p.w_uq, p.g_q, 256, 768, p.w_uqT, gtid, gth);
  wtrans(p.w_ukv, p.g_kv, 128, 1024, p.w_ukvT, gtid, gth);
  wtrans(p.w_out, p.g_out, 1024, 1024, p.w_outT, gtid, gth, 512);
#pragma unroll 4
  for (int e = gtid; e < 1024 * 2048 / 4; e += gth) {
    const f32x4 v = *reinterpret_cast<const f32x4*>(p.w_q + (size_t)e * 4);
    *reinterpret_cast<uint2*>(p.w_qb + (size_t)e * 4) = pack4bf(v[0], v[1], v[2], v[3]);
  }
#pragma unroll 2
  for (int e = gtid; e < 8 * 2 * 128 * 128 / 4; e += gth) {
    const f32x4 v = *reinterpret_cast<const f32x4*>(p.subk + (size_t)e * 4);
    *reinterpret_cast<uint2*>(p.subkb + (size_t)e * 4) = pack4bf(v[0], v[1], v[2], v[3]);
  }
#pragma unroll 2
  for (int e = gtid; e < 1536 * 128; e += gth) {
    const int n = e >> 7, k = e & 127;
    float v = 0.f;
    if (n < 512) { if (k < 64) v = p.w_up[k * 512 + n]; }
    else if (n < 1024) { if (k < 64) v = p.a_up[k * 512 + n - 512]; }
    else v = p.g_up[k * 512 + n - 1024];
    p.w_lrT[e] = f2bf(v);
  }
}
__device__ __forceinline__ void ph_inproj(const Params& p, char* smem, int bid, int nb) {
  const int lane = threadIdx.x & 63, w = threadIdx.x >> 6, wm = w >> 1, wn = w & 1, g = lane >> 4, r16 = lane & 15;
  for_tiles_xcd(T / 128, (DIN + 127) >> 7, bid, nb, [&](int tm, int tn) {
    const int m0 = tm * 128, n0 = tn * 128;
    f32x4 acc[4][4];
    gemm_tile_glds<true>(smem, m0, n0, 32,
        [&](int r, int k) { return p.hb + (size_t)r * D + k; },
        [&](int n, int k) { return p.w_inT + (size_t)min(n, DIN - 1) * 1024 + k; }, acc);
    float rsq[8];
#pragma unroll
    for (int q = 0; q < 8; ++q) rsq[q] = p.rstd1[m0 + ((threadIdx.x + 256 * q) >> 4)];
    stage_acc(smem, acc);
#pragma unroll
    for (int q = 0; q < 8; ++q) {
      const int c = threadIdx.x + 256 * q;
      const int row = c >> 4, col8 = (c & 15) * 8;
      const int m = m0 + row, n = n0 + col8;
      const float rs = rsq[q];
      float v[8];
      ld8(smem, row, col8, v);
      if (n0 == 384 && col8 < 64) {
        if (col8 < 32) {
          float v2[8], y1[8], y2[8];
          ld8(smem, row, col8 + 32, v2);
          const int pos = m % L;
          const f32x4 c0 = *reinterpret_cast<const f32x4*>(p.ropec + pos * 32 + col8), c1 = *reinterpret_cast<const f32x4*>(p.ropec + pos * 32 + col8 + 4);
          const f32x4 s0 = *reinterpret_cast<const f32x4*>(p.ropes + pos * 32 + col8), s1 = *reinterpret_cast<const f32x4*>(p.ropes + pos * 32 + col8 + 4);
#pragma unroll
          for (int e = 0; e < 8; ++e) {
            const float cs = e < 4 ? c0[e] : c1[e - 4], sn = e < 4 ? s0[e] : s1[e - 4];
            const float x1 = v[e] * rs, x2 = v2[e] * rs;
            y1[e] = x1 * cs - x2 * sn; y2[e] = x1 * sn + x2 * cs;
          }
          st8f(p.kr + (size_t)m * 64 + col8, y1);
          st8f(p.kr + (size_t)m * 64 + 32 + col8, y2);
        }
      } else if (n < DIN) {
#pragma unroll
        for (int e = 0; e < 8; ++e) v[e] *= rs;
        st8f(p.proj + (size_t)m * DIN + n, v);
      }
    }
  });
}
__device__ __forceinline__ void ph_w2(const Params& p, char* smem, int bid, int nb) {
  for (int e = bid; e < 128; e += nb) {
    const int hc = e >> 3, n0 = (e & 7) * 128;
    f32x4 acc[4][4];
    gemm_tile_glds<true>(smem, 0, n0, 4,
        [&](int r, int k) { return p.subkb + ((size_t)hc * 128 + r) * 128 + k; },
        [&](int n, int k) { return p.w_qb + (size_t)n * 2048 + hc * 128 + k; }, acc);
    stage_acc(smem, acc);
#pragma unroll 2
    for (int q = 0; q < 8; ++q) {
      const int c = threadIdx.x + 256 * q;
      const int row = c >> 4, col8 = (c & 15) * 8;
      float v[8];
      ld8(smem, row, col8, v);
      const f32x4 g0 = *reinterpret_cast<const f32x4*>(p.g_ffn + n0 + col8), g1 = *reinterpret_cast<const f32x4*>(p.g_ffn + n0 + col8 + 4);
#pragma unroll
      for (int e2 = 0; e2 < 8; ++e2) v[e2] *= e2 < 4 ? g0[e2] : g1[e2 - 4];
      st8f(p.w_qT + ((size_t)hc * 128 + row) * 1024 + n0 + col8, v);
    }
  }
}
__device__ __forceinline__ void ph_q_up(const Params& p, char* smem, int bid, int nb) {
  const int lane = threadIdx.x & 63, w = threadIdx.x >> 6, wm = w >> 1, wn = w & 1, g = lane >> 4, r16 = lane & 15;
  float* rowss = reinterpret_cast<float*>(smem);
  for_tiles_xcd(T / 128, 6, bid, nb, [&](int tm, int tn) {
    const int m0 = tm * 128, n0 = tn * 128;
    f32x4 acc[4][4];
    float ss[4] = {0.f, 0.f, 0.f, 0.f};
    gemm_tile<true>(smem, m0, n0, 0, 4,
        [&](int r, int k, int i) { const u32x4 v = *reinterpret_cast<const u32x4*>(p.proj + (size_t)r * DIN + k); ss[i] += sumsq8(v); return v; },
        [&](int n, int k) { return *reinterpret_cast<const u32x4*>(p.w_uqT + (size_t)n * 256 + k); }, acc);
    float rsum[4];
#pragma unroll
    for (int i = 0; i < 4; ++i) {
      float v = ss[i];
      v += __shfl_xor(v, 1, 64); v += __shfl_xor(v, 2, 64); v += __shfl_xor(v, 4, 64);
      rsum[i] = v;
    }
    stage_acc(smem, acc);
    float* rowss2 = reinterpret_cast<float*>(smem + 128 * 132 * 4);
    if ((threadIdx.x & 7) == 0) {
#pragma unroll
      for (int i = 0; i < 4; ++i) rowss2[(threadIdx.x >> 3) + 32 * i] = rsum[i];
    }
    __syncthreads();
#pragma unroll 2
    for (int q = 0; q < 8; ++q) {
      const int c = threadIdx.x + 256 * q;
      const int row = c >> 4, col8 = (c & 15) * 8;
      const int m = m0 + row, n = n0 + col8;
      const float rs = rsqrtf(rowss2[row] * (1.0f / 256) + RMS_EPS) * (0.07216878364870322f * 1.4426950408889634f);
      const int off = n % 192;
      float v[8];
      ld8(smem, row, col8, v);
      if (off >= 128) {
        if (off < 160) {
          float v2[8], y1[8], y2[8];
          ld8(smem, row, col8 + 32, v2);
          const int pos = m % L, ii = off - 128;
          const f32x4 c0 = *reinterpret_cast<const f32x4*>(p.ropec + pos * 32 + ii), c1 = *reinterpret_cast<const f32x4*>(p.ropec + pos * 32 + ii + 4);
          const f32x4 s0 = *reinterpret_cast<const f32x4*>(p.ropes + pos * 32 + ii), s1 = *reinterpret_cast<const f32x4*>(p.ropes + pos * 32 + ii + 4);
#pragma unroll
          for (int e = 0; e < 8; ++e) {
            const float cs = e < 4 ? c0[e] : c1[e - 4], sn = e < 4 ? s0[e] : s1[e - 4];
            const float x1 = v[e] * rs, x2 = v2[e] * rs;
            y1[e] = x1 * cs - x2 * sn; y2[e] = x1 * sn + x2 * cs;
          }
          st8f(p.qf + (size_t)m * 768 + n, y1);
          st8f(p.qf + (size_t)m * 768 + n + 32, y2);
        }
      } else {
#pragma unroll
        for (int e = 0; e < 8; ++e) v[e] *= rs;
        st8f(p.qf + (size_t)m * 768 + n, v);
      }
    }
  }, 12);
}
__device__ __forceinline__ void ph_kv_up(const Params& p, char* smem, int bid, int nb) {
  const int lane = threadIdx.x & 63, w = threadIdx.x >> 6, wm = w >> 1, wn = w & 1, g = lane >> 4, r16 = lane & 15;
  float* rowss = reinterpret_cast<float*>(smem);
  for_tiles_xcd(T / 128, 8, bid, nb, [&](int tm, int tn) {
    const bool vpart = tn >= 4;
    const int m0 = tm * 128, n0 = (tn & 3) * 128;
    f32x4 acc[4][4];
    float ss[4] = {0.f, 0.f, 0.f, 0.f};
    auto al = [&](int r, int k, int i) { const u32x4 v = *reinterpret_cast<const u32x4*>(p.proj + (size_t)r * DIN + 256 + k); ss[i] += sumsq8(v); return v; };
    if (!vpart) {
      gemm_tile<true>(smem, m0, n0, 0, 2, al,
          [&](int n, int k) { return *reinterpret_cast<const u32x4*>(p.w_ukvT + (size_t)((n >> 7) * 256 + (n & 127)) * 128 + k); }, acc);
      float rsum[4];
#pragma unroll
      for (int i = 0; i < 4; ++i) {
        float v = ss[i];
        v += __shfl_xor(v, 1, 64); v += __shfl_xor(v, 2, 64); v += __shfl_xor(v, 4, 64);
        rsum[i] = v;
      }
      stage_acc(smem, acc);
      float* rowss2 = reinterpret_cast<float*>(smem + 128 * 132 * 4);
      if ((threadIdx.x & 7) == 0) {
#pragma unroll
        for (int i = 0; i < 4; ++i) rowss2[(threadIdx.x >> 3) + 32 * i] = rsum[i];
      }
      __syncthreads();
#pragma unroll 2
      for (int q = 0; q < 8; ++q) {
        const int c = threadIdx.x + 256 * q;
        const int row = c >> 4, col8 = (c & 15) * 8;
        const int m = m0 + row, n = n0 + col8;
        const float rs = rsqrtf(rowss2[row] * (1.0f / 128) + RMS_EPS);
        const int b = m / L, pos = m - b * L;
        float v[8];
        ld8(smem, row, col8, v);
#pragma unroll
        for (int e = 0; e < 8; ++e) v[e] *= rs;
        st8f(p.kn + ((size_t)((b * 4 + (n >> 7)) * L + pos)) * 128 + (n & 127), v);
      }
    } else {
      gemm_tile<false>(smem, m0, n0, 0, 2, al,
          [&](int n, int k) { return *reinterpret_cast<const u32x4*>(p.w_ukvT + (size_t)((n >> 7) * 256 + 128 + (n & 127)) * 128 + k); }, acc);
      rowss_publish(rowss, ss);
      const int mb = m0 + wm * 64 + 4 * g, nbase = n0 + wn * 64 + r16;
#pragma unroll
      for (int i = 0; i < 4; ++i) {
        const int m = mb + 16 * i;
        f32x4 rs;
#pragma unroll
        for (int r = 0; r < 4; ++r) rs[r] = rsqrtf(rowss[wm * 64 + 16 * i + 4 * g + r] * (1.0f / 128) + RMS_EPS);
        const int b = m / L, pos = m - b * L;
#pragma unroll
        for (int j = 0; j < 4; ++j) {
          const int n = nbase + 16 * j;
          const int h = n >> 7, dv = n & 127;
          const f32x4 v = acc[i][j] * rs;
          *reinterpret_cast<uint2*>(p.vt + ((size_t)((b * 4 + h) * 128 + dv)) * L + pos) = pack4bf(v[0], v[1], v[2], v[3]);
        }
      }
    }
  }, 18);
}
__device__ __forceinline__ float fast_rcp(float x) { return __builtin_amdgcn_rcpf(x); }
__device__ __forceinline__ float fast_sigmoid(float x) { return fast_rcp(1.0f + __expf(-x)); }
__device__ __forceinline__ float fast_tanh(float x) { return 1.0f - 2.0f * fast_rcp(1.0f + __expf(2.0f * x)); }
__device__ __forceinline__ float lerp_tok(const Params& p, int tt, int pos, int c) {
  const float cur = bf2f(p.proj[(size_t)tt * DIN + 448 + c]);
  const float prev = pos > 0 ? bf2f(p.proj[(size_t)(tt - 1) * DIN + 448 + c]) : 0.0f;
  return cur + p.mu[c] * (prev - cur);
}
__device__ __forceinline__ f32x4 lerp4(const Params& p, int tt, int pos, int c) {
  const f32x4 cur = unpk4(*reinterpret_cast<const u32x2*>(p.proj + (size_t)tt * DIN + 448 + c));
  f32x4 prev = {0.f, 0.f, 0.f, 0.f};
  if (pos > 0) prev = unpk4(*reinterpret_cast<const u32x2*>(p.proj + (size_t)(tt - 1) * DIN + 448 + c));
  const f32x4 m = *reinterpret_cast<const f32x4*>(p.mu + c);
  return cur + m * (prev - cur);
}
__device__ __forceinline__ void ph_rwkv_prep(const Params& p, char* smem, int bid, int nb) {
  const int lane = threadIdx.x & 63, w = threadIdx.x >> 6, wm = w >> 1, wn = w & 1, g = lane >> 4, r16 = lane & 15;
  for_tiles_xcd(T / 128, 12, bid, nb, [&](int tm, int tn) {
    const int kind = tn >> 2, n0 = (tn & 3) * 128;
    const int m0 = tm * 128;
    const int kbase = kind == 0 ? 1536 : (kind == 1 ? 1600 : 1664);
    f32x4 acc[4][4];
    gemm_tile<true>(smem, m0, n0, 0, kind == 2 ? 2 : 1,
        [&](int r, int k, int) {
          const int pos = r % L;
          const u32x4 cu = *reinterpret_cast<const u32x4*>(p.proj + (size_t)r * DIN + 448 + kbase + k);
          u32x4 pv = {0u, 0u, 0u, 0u};
          if (pos > 0) pv = *reinterpret_cast<const u32x4*>(p.proj + (size_t)(r - 1) * DIN + 448 + kbase + k);
          u32x4 o;
#pragma unroll
          for (int q = 0; q < 4; ++q) {
            float c0 = __uint_as_float(cu[q] << 16), c1 = __uint_as_float(cu[q] & 0xffff0000u);
            const float p0 = __uint_as_float(pv[q] << 16), p1 = __uint_as_float(pv[q] & 0xffff0000u);
            c0 += p.mu[kbase + k + 2 * q] * (p0 - c0);
            c1 += p.mu[kbase + k + 2 * q + 1] * (p1 - c1);
            if (kind == 0) { c0 = fast_tanh(c0); c1 = fast_tanh(c1); }
            else if (kind == 2) { c0 = fast_sigmoid(c0); c1 = fast_sigmoid(c1); }
            o[q] = pk2bf(c0, c1);
          }
          return o;
        },
        [&](int n, int k) { return *reinterpret_cast<const u32x4*>(p.w_lrT + (size_t)(kind * 512 + n) * 128 + k); }, acc);
    float* Et = reinterpret_cast<float*>(smem);
#pragma unroll
    for (int i = 0; i < 4; ++i)
#pragma unroll
      for (int j = 0; j < 4; ++j)
        *reinterpret_cast<f32x4*>(Et + (wm * 64 + 16 * i + r16) * 132 + wn * 64 + 16 * j + 4 * g) = acc[i][j];
    __syncthreads();
    const int coloff = kind == 0 ? 0 : (kind == 1 ? 512 : 1024);
    bf16_t* const xdst = kind == 0 ? p.rr : (kind == 1 ? p.rk2 : p.rv);
    bf16_t* const ldst = kind == 0 ? p.rlw : (kind == 1 ? p.rkk : p.rg);
    const int chh = n0 + (threadIdx.x & 15) * 8;
    const f32x4 mu0 = *reinterpret_cast<const f32x4*>(p.mu + coloff + chh), mu1 = *reinterpret_cast<const f32x4*>(p.mu + coloff + chh + 4);
#pragma unroll 1
    for (int qb = 0; qb < 8; qb += 4) {
    u32x4 cuv[4], pvv[4];
#pragma unroll
    for (int qi = 0; qi < 4; ++qi) {
      const int c = threadIdx.x + 256 * (qb + qi);
      const int m = m0 + (c >> 4);
      const bf16_t* pc = p.proj + (size_t)m * DIN + 448 + coloff + n0 + (c & 15) * 8;
      cuv[qi] = *reinterpret_cast<const u32x4*>(pc);
      pvv[qi] = *reinterpret_cast<const u32x4*>(pc - ((m % L) > 0 ? DIN : 0));
    }
#pragma unroll
    for (int qi = 0; qi < 4; ++qi) {
      const int q = qb + qi;
      const int c = threadIdx.x + 256 * q;
      const int row = c >> 4, ch = n0 + (c & 15) * 8;
      const int m = m0 + row, pos = m % L;
      const f32x4 l0 = *reinterpret_cast<const f32x4*>(Et + row * 132 + (c & 15) * 8);
      const f32x4 l1 = *reinterpret_cast<const f32x4*>(Et + row * 132 + (c & 15) * 8 + 4);
      const u32x4 cu = cuv[qi];
      u32x4 pv = pvv[qi];
      if (pos == 0) pv = (u32x4){0u, 0u, 0u, 0u};
      float xs[8], lr[8];
#pragma unroll
      for (int e = 0; e < 4; ++e) {
        const float c0 = __uint_as_float(cu[e] << 16), c1 = __uint_as_float(cu[e] & 0xffff0000u);
        const float p0 = __uint_as_float(pv[e] << 16), p1 = __uint_as_float(pv[e] & 0xffff0000u);
        const float m0_ = e < 2 ? mu0[2 * e] : mu1[2 * e - 4], m1_ = e < 2 ? mu0[2 * e + 1] : mu1[2 * e - 3];
        xs[2 * e] = c0 + m0_ * (p0 - c0);
        xs[2 * e + 1] = c1 + m1_ * (p1 - c1);
      }
#pragma unroll
      for (int e = 0; e < 4; ++e) { lr[e] = l0[e]; lr[4 + e] = l1[e]; }
      const size_t o = (size_t)m * 512 + ch;
      if (kind == 0) {
        const f32x4 w00 = *reinterpret_cast<const f32x4*>(p.w0 + ch), w01 = *reinterpret_cast<const f32x4*>(p.w0 + ch + 4);
        float lw[8];
#pragma unroll
        for (int e = 0; e < 8; ++e) {
          const float nx = -(lr[e] + (e < 4 ? w00[e] : w01[e - 4]));
          const float sp = fmaxf(nx, 0.0f) + __logf(1.0f + __expf(-fabsf(nx)));
          lw[e] = -__expf(-sp - 0.5f);
        }
        st8f(ldst + o, lw);
        st8f(xdst + o, xs);
      } else if (kind == 2) {
        st8f(ldst + o, lr);
        st8f(xdst + o, xs);
      } else {
        const f32x4 a00 = *reinterpret_cast<const f32x4*>(p.a0 + ch), a01 = *reinterpret_cast<const f32x4*>(p.a0 + ch + 4);
        const f32x4 kk0 = *reinterpret_cast<const f32x4*>(p.k_k + ch), kk1 = *reinterpret_cast<const f32x4*>(p.k_k + ch + 4);
        const f32x4 ka0 = *reinterpret_cast<const f32x4*>(p.k_a + ch), ka1 = *reinterpret_cast<const f32x4*>(p.k_a + ch + 4);
        float av[8], kkr[8], ss = 0.f;
#pragma unroll
        for (int e = 0; e < 8; ++e) {
          av[e] = fast_sigmoid(lr[e] + (e < 4 ? a00[e] : a01[e - 4]));
          kkr[e] = xs[e] * (e < 4 ? kk0[e] : kk1[e - 4]);
          ss += kkr[e] * kkr[e];
        }
        ss = dpp_sum8(ss);
        const float inr = 1.0f / fmaxf(sqrtf(ss), 1e-12f);
        float kkn[8], k2[8], bb[8];
#pragma unroll
        for (int e = 0; e < 8; ++e) {
          kkn[e] = kkr[e] * inr;
          k2[e] = xs[e] * (1.0f + (av[e] - 1.0f) * (e < 4 ? ka0[e] : ka1[e - 4]));
          bb[e] = kkn[e] * av[e];
        }
        st8f(ldst + o, kkn);
        st8f(xdst + o, k2);
        st8f(p.rbb + o, bb);
      }
    }
    }
  });
}
template <bool STORE = true>
__device__ __forceinline__ void ph_attn(const Params& p, char* smem, int bid, int nb) {
  char* Kb = smem;
  char* Vs = smem + 49152;
  const int tid = threadIdx.x, lane = tid & 63, w = tid >> 6, g = lane >> 4, r16 = lane & 15;
  const int wu = __builtin_amdgcn_readfirstlane(tid) >> 6;
  const int nitems = 32 * 17;
  for (int it = bid; it < nitems; it += nb) {
    const int bh = it & 31, grp = it >> 5;
    const bool meta = grp == 16;
    const int j = 15 - grp;
    const int b = bh >> 2, h = bh & 3;
    const int qbase = meta ? 0 : 16 + 128 * j;
    const int ntiles = meta ? 1 : 2 * j + 3;
    const int my_ntiles = meta ? 1 : (w < 2 ? 2 * j + 2 : 2 * j + 3);
    bf16x8 qf[2][6];
#pragma unroll
    for (int nt = 0; nt < 2; ++nt)
#pragma unroll
      for (int ks = 0; ks < 6; ++ks) {
        const int pos = qbase + 32 * w + 16 * nt + r16;
        qf[nt][ks] = *reinterpret_cast<const bf16x8*>(p.qf + ((size_t)(b * L + pos)) * 768 + h * 192 + ks * 32 + 8 * g);
      }
    f32x4 o[8][2];
#pragma unroll
    for (int a = 0; a < 8; ++a) { o[a][0] = (f32x4){0.f, 0.f, 0.f, 0.f}; o[a][1] = (f32x4){0.f, 0.f, 0.f, 0.f}; }
    float mrun[2] = {-1e30f, -1e30f}, lrun[2] = {0.f, 0.f};
    const bf16_t* knb = p.kn + (size_t)(b * 4 + h) * L * 128;
    const bf16_t* krb = p.kr + (size_t)b * L * 64;
    const bf16_t* vtb = p.vt + (size_t)(b * 4 + h) * 128 * L;
    int koff[6], voff[4];
    unsigned kmask = 0;
#pragma unroll
    for (int i = 0; i < 6; ++i) {
      const int Lk = 64 * (6 * wu + i) + lane;
      const int row = Lk / 24, sp = Lk - row * 24;
      const int ch = (sp & ~7) | ((sp ^ row) & 7);
      if (ch < 16) koff[i] = row * 128 + ch * 8; else { koff[i] = row * 64 + (ch - 16) * 8; kmask |= 1u << i; }
    }
#pragma unroll
    for (int i = 0; i < 4; ++i) {
      const int row = 8 * (4 * wu + i) + (lane >> 3);
      voff[i] = row * L + (((lane & 7) ^ ((row >> 1) & 7)) * 8);
    }
    auto issueK = [&](int t) {
      const int kp0 = t == 0 ? 0 : 16 + 64 * (t - 1);
      char* dst = Kb + (t & 1) * 24576;
      const bf16_t* kb0 = knb + (size_t)kp0 * 128;
      const bf16_t* kb1 = krb + (size_t)kp0 * 64;
#pragma unroll
      for (int i = 0; i < 6; ++i) GLDS16(((kmask >> i) & 1u ? kb1 : kb0) + koff[i], dst + (6 * wu + i) * 1024);
    };
    auto issueV = [&](int t) {
      const int kp0 = t == 0 ? 0 : 16 + 64 * (t - 1);
      const bf16_t* vb0 = vtb + kp0;
#pragma unroll
      for (int i = 0; i < 4; ++i) GLDS16(vb0 + voff[i], Vs + (4 * wu + i) * 1024);
    };
    __syncthreads();
    issueK(0);
    asm volatile("s_waitcnt vmcnt(0)\n\ts_barrier" ::: "memory");
    for (int t = 0; t < ntiles; ++t) {
      const char* Ks = Kb + (t & 1) * 24576;
      issueV(t);
      if (t + 1 < ntiles) issueK(t + 1);
      bf16x8 pb[2][2];
      if (t < my_ntiles) {
        f32x4 s[4][2];
#pragma unroll
        for (int a = 0; a < 4; ++a) { s[a][0] = (f32x4){0.f, 0.f, 0.f, 0.f}; s[a][1] = (f32x4){0.f, 0.f, 0.f, 0.f}; }
#pragma unroll
        for (int ks = 0; ks < 6; ++ks) {
          const int slot = ks * 4 + g;
          const int so = ((slot & ~7) | ((slot ^ lane) & 7)) << 4;
#pragma unroll
          for (int mt = 0; mt < 4; ++mt) {
            const bf16x8 kf = *reinterpret_cast<const bf16x8*>(Ks + (mt * 16 + r16) * 384 + so);
            s[mt][0] = __builtin_amdgcn_mfma_f32_16x16x32_bf16(kf, qf[0][ks], s[mt][0], 0, 0, 0);
            s[mt][1] = __builtin_amdgcn_mfma_f32_16x16x32_bf16(kf, qf[1][ks], s[mt][1], 0, 0, 0);
          }
        }
        if (t == 0) {
#pragma unroll
          for (int mt = 1; mt < 4; ++mt) { s[mt][0] = (f32x4){-1e30f, -1e30f, -1e30f, -1e30f}; s[mt][1] = s[mt][0]; }
        }
#pragma unroll
        for (int nt = 0; nt < 2; ++nt) {
          float mx = -1e30f;
#pragma unroll
          for (int mt = 0; mt < 4; ++mt)
#pragma unroll
            for (int r = 0; r < 4; ++r) mx = fmaxf(mx, s[mt][nt][r]);
          mx = fmaxf(mx, __shfl_xor(mx, 16, 64));
          mx = fmaxf(mx, __shfl_xor(mx, 32, 64));
          const float mn = fmaxf(mrun[nt], mx);
          const float alpha = __builtin_amdgcn_exp2f(mrun[nt] - mn);
          mrun[nt] = mn;
          float rs = 0.f;
#pragma unroll
          for (int mt = 0; mt < 4; ++mt)
#pragma unroll
            for (int r = 0; r < 4; ++r) { const float pv = __builtin_amdgcn_exp2f(s[mt][nt][r] - mn); s[mt][nt][r] = pv; rs += pv; }
          lrun[nt] = lrun[nt] * alpha + rs;
#pragma unroll
          for (int a = 0; a < 8; ++a) o[a][nt] *= alpha;
#pragma unroll
          for (int k2 = 0; k2 < 2; ++k2) {
            const uint2 lo = pack4bf(s[2 * k2][nt][0], s[2 * k2][nt][1], s[2 * k2][nt][2], s[2 * k2][nt][3]);
            const uint2 hi = pack4bf(s[2 * k2 + 1][nt][0], s[2 * k2 + 1][nt][1], s[2 * k2 + 1][nt][2], s[2 * k2 + 1][nt][3]);
            u32x4 pk; pk[0] = lo.x; pk[1] = lo.y; pk[2] = hi.x; pk[3] = hi.y;
            pb[k2][nt] = __builtin_bit_cast(bf16x8, pk);
          }
        }
      }
      if (t + 1 < ntiles) asm volatile("s_waitcnt vmcnt(6)\n\ts_barrier" ::: "memory");
      else asm volatile("s_waitcnt vmcnt(0)\n\ts_barrier" ::: "memory");
      if (t < my_ntiles) {
#pragma unroll
        for (int k2 = 0; k2 < 2; ++k2) {
          const int sa = ((8 * k2 + g) ^ (r16 & 14)) << 3;
          const int sb = ((8 * k2 + 4 + g) ^ (r16 & 14)) << 3;
#pragma unroll
          for (int a = 0; a < 8; ++a) {
            const uint2 va = *reinterpret_cast<const uint2*>(Vs + (a * 16 + r16) * 128 + sa);
            const uint2 vb = *reinterpret_cast<const uint2*>(Vs + (a * 16 + r16) * 128 + sb);
            u32x4 pk; pk[0] = va.x; pk[1] = va.y; pk[2] = vb.x; pk[3] = vb.y;
            const bf16x8 vf = __builtin_bit_cast(bf16x8, pk);
            o[a][0] = __builtin_amdgcn_mfma_f32_16x16x32_bf16(vf, pb[k2][0], o[a][0], 0, 0, 0);
            o[a][1] = __builtin_amdgcn_mfma_f32_16x16x32_bf16(vf, pb[k2][1], o[a][1], 0, 0, 0);
          }
        }
      }
      asm volatile("s_waitcnt vmcnt(0)\n\ts_waitcnt lgkmcnt(0)\n\ts_barrier" ::: "memory");
    }
#pragma unroll
    for (int nt = 0; nt < 2; ++nt) {
      float l = lrun[nt];
      l += __shfl_xor(l, 16, 64);
      l += __shfl_xor(l, 32, 64);
      const float il = 1.0f / l;
      const int pos = qbase + 32 * w + 16 * nt + r16;
      float sq = 0.f;
#pragma unroll
      for (int a = 0; a < 8; ++a) { const f32x4 v = o[a][nt] * il; sq += v[0] * v[0] + v[1] * v[1] + v[2] * v[2] + v[3] * v[3]; }
      sq += __shfl_xor(sq, 16, 64);
      sq += __shfl_xor(sq, 32, 64);
      if (STORE && (!meta || pos < NM)) {
        bf16_t* dst = p.qf + (size_t)(b * L + pos) * 768 + h * 192 + 4 * g;
#pragma unroll
        for (int a = 0; a < 8; ++a) {
          const f32x4 v = o[a][nt] * il;
          *reinterpret_cast<uint2*>(dst + a * 16) = pack4bf(v[0], v[1], v[2], v[3]);
        }
        if (g == 0) p.ossq[(size_t)(b * L + pos) * 4 + h] = sq;
      }
    }
  }
}
__device__ __forceinline__ void ph_rwkv_pre(const Params& p, char* smem, int bid, int nb) {
  const int lane = threadIdx.x & 63, wv = threadIdx.x >> 6, g = lane >> 4, r16 = lane & 15;
  char* my = smem + wv * 16384;
  char* At = my;
  char* Bt = my + 2048;
  char* Kt = my + 4096;
  char* Rt = my + 6144;
  char* AtT = my + 8192;
  char* VtT = my + 10240;
  char* BhT = my + 12288;
  char* KhT = my + 14336;
  const int nitems = NB_ * 8 * NCH;
  for (int wi = bid * 4 + wv; wi < nitems; wi += nb * 4) {
    const int chunk = wi % NCH, bh = wi / NCH, b = bh >> 3, h = bh & 7;
    float btv[16], ktv[16];
    unsigned atp[8], vtp[8];
    float cum = 0.f;
    const size_t o0 = ((size_t)b * L + chunk * 16) * 512 + h * 64 + lane;
#pragma unroll
    for (int t = 0; t < 16; ++t) {
      const size_t o = o0 + (size_t)t * 512;
      const float lw = bf2f(p.rlw[o]);
      const float gp = __expf(cum);
      cum += lw;
      const float gc = __expf(cum), ig = __expf(-cum);
      const float av = -bf2f(p.rkk[o]) * gp;
      const float bv = bf2f(p.rbb[o]) * ig;
      const float kv = bf2f(p.rk2[o]) * ig;
      const float rv = bf2f(p.rr[o]) * gc;
      const bf16_t vb = p.rv[o];
      btv[t] = bv; ktv[t] = kv;
      const bf16_t ab = f2bf(av);
      *reinterpret_cast<bf16_t*>(At + t * 128 + lane * 2) = ab;
      *reinterpret_cast<bf16_t*>(Bt + t * 128 + lane * 2) = f2bf(bv);
      *reinterpret_cast<bf16_t*>(Kt + t * 128 + lane * 2) = f2bf(kv);
      *reinterpret_cast<bf16_t*>(Rt + t * 128 + lane * 2) = f2bf(rv);
      if (t & 1) { atp[t >> 1] |= (unsigned)ab << 16; vtp[t >> 1] |= (unsigned)vb << 16; }
      else { atp[t >> 1] = ab; vtp[t >> 1] = vb; }
    }
    const float gC = __expf(cum);
    p.cd_gc[(size_t)wi * 64 + lane] = gC;
    {
      u32x4 w0, w1;
#pragma unroll
      for (int q = 0; q < 4; ++q) { w0[q] = atp[q]; w1[q] = atp[4 + q]; }
      *reinterpret_cast<u32x4*>(AtT + lane * 32) = w0; *reinterpret_cast<u32x4*>(AtT + lane * 32 + 16) = w1;
#pragma unroll
      for (int q = 0; q < 4; ++q) { w0[q] = vtp[q]; w1[q] = vtp[4 + q]; }
      *reinterpret_cast<u32x4*>(VtT + lane * 32) = w0; *reinterpret_cast<u32x4*>(VtT + lane * 32 + 16) = w1;
#pragma unroll
      for (int q = 0; q < 4; ++q) {
        w0[q] = pk2bf(btv[2 * q] * gC, btv[2 * q + 1] * gC);
        w1[q] = pk2bf(btv[8 + 2 * q] * gC, btv[8 + 2 * q + 1] * gC);
      }
      *reinterpret_cast<u32x4*>(BhT + lane * 32) = w0; *reinterpret_cast<u32x4*>(BhT + lane * 32 + 16) = w1;
#pragma unroll
      for (int q = 0; q < 4; ++q) {
        w0[q] = pk2bf(ktv[2 * q] * gC, ktv[2 * q + 1] * gC);
        w1[q] = pk2bf(ktv[8 + 2 * q] * gC, ktv[8 + 2 * q + 1] * gC);
      }
      *reinterpret_cast<u32x4*>(KhT + lane * 32) = w0; *reinterpret_cast<u32x4*>(KhT + lane * 32 + 16) = w1;
    }
    __builtin_amdgcn_wave_barrier();
    f32x4 mab = {0.f, 0.f, 0.f, 0.f}, mak = mab, nbr = mab, nkr = mab;
#pragma unroll
    for (int ks = 0; ks < 2; ++ks) {
      const int off = r16 * 128 + ks * 64 + g * 16;
      const bf16x8 fa = *reinterpret_cast<const bf16x8*>(At + off);
      const bf16x8 fb = *reinterpret_cast<const bf16x8*>(Bt + off);
      const bf16x8 fk = *reinterpret_cast<const bf16x8*>(Kt + off);
      const bf16x8 fr = *reinterpret_cast<const bf16x8*>(Rt + off);
      mab = MFMA32(fb, fa, mab); mak = MFMA32(fk, fa, mak);
      nbr = MFMA32(fb, fr, nbr); nkr = MFMA32(fk, fr, nkr);
    }
#pragma unroll
    for (int r = 0; r < 4; ++r) {
      const int sidx = 4 * g + r;
      if (!(sidx < r16)) { mab[r] = 0.f; mak[r] = 0.f; }
      if (!(sidx <= r16)) { nbr[r] = 0.f; nkr[r] = 0.f; }
    }
    float Tc[16];
#pragma unroll
    for (int sidx = 15; sidx >= 0; --sidx) {
      float acc = (r16 == sidx) ? 1.0f : 0.0f;
#pragma unroll
      for (int u = sidx + 1; u < 16; ++u) {
        const float m = __int_as_float(__builtin_amdgcn_readlane(__float_as_int(mab[sidx & 3]), 16 * (sidx >> 2) + u));
        acc += m * Tc[u];
      }
      Tc[sidx] = acc;
    }
    f32x4 tqf;
#pragma unroll
    for (int r = 0; r < 4; ++r) tqf[r] = g == 0 ? Tc[r] : (g == 1 ? Tc[4 + r] : (g == 2 ? Tc[8 + r] : Tc[12 + r]));
    const bf16x4 tq = pk4(tqf);
    const bf16x4 makA = pk4(mak), nbrA = pk4(nbr), nkrA = pk4(nkr);
    f32x4 ah[4], qm[4], wt[4], zt[4];
    bf16x4 vfr[4];
#pragma unroll
    for (int q = 0; q < 4; ++q) {
      const f32x4 z4 = {0.f, 0.f, 0.f, 0.f};
      const bf16x4 atf = *reinterpret_cast<const bf16x4*>(AtT + (16 * q + r16) * 32 + g * 8);
      vfr[q] = *reinterpret_cast<const bf16x4*>(VtT + (16 * q + r16) * 32 + g * 8);
      ah[q] = MFMA16(tq, atf, z4);
      const f32x4 xt = MFMA16(makA, vfr[q], z4);
      wt[q] = MFMA16(tq, pk4(xt), z4);
      qm[q] = MFMA16(nbrA, pk4(ah[q]), z4);
      zt[q] = MFMA16(nbrA, pk4(wt[q]), z4);
      zt[q] = MFMA16(nkrA, vfr[q], zt[q]);
    }
    unsigned char* oah = p.cd_ah + (size_t)wi * 2048;
    unsigned char* oqm = p.cd_qm + (size_t)wi * 2048;
    unsigned char* obk = p.cd_bk + (size_t)wi * 4096;
    unsigned char* owt = p.cd_wt + (size_t)wi * 2048;
    unsigned char* ozt = p.cd_zt + (size_t)wi * 2048;
    unsigned char* ovb = p.cd_vb + (size_t)wi * 2048;
#pragma unroll
    for (int q = 0; q < 4; ++q) {
      *reinterpret_cast<bf16x4*>(owt + (q * 64 + lane) * 8) = pk4(wt[q]);
      *reinterpret_cast<bf16x4*>(ozt + (q * 64 + lane) * 8) = pk4(zt[q]);
      *reinterpret_cast<bf16x4*>(ovb + (q * 64 + lane) * 8) = vfr[q];
      const u32x2 bh2 = *reinterpret_cast<const u32x2*>(BhT + (16 * q + r16) * 32 + g * 8);
      const u32x2 kh2 = *reinterpret_cast<const u32x2*>(KhT + (16 * q + r16) * 32 + g * 8);
      u32x4 bk; bk[0] = bh2[0]; bk[1] = bh2[1]; bk[2] = kh2[0]; bk[3] = kh2[1];
      *reinterpret_cast<u32x4*>(obk + (q * 64 + lane) * 16) = bk;
    }
    __builtin_amdgcn_wave_barrier();
#pragma unroll
    for (int q = 0; q < 4; ++q)
#pragma unroll
      for (int r = 0; r < 4; ++r) *reinterpret_cast<bf16_t*>(Bt + (4 * g + r) * 128 + (16 * q + r16) * 2) = f2bf(ah[q][r]);
    __builtin_amdgcn_wave_barrier();
#pragma unroll
    for (int ks = 0; ks < 2; ++ks) {
      const u32x2 lo = *reinterpret_cast<const u32x2*>(Bt + r16 * 128 + (32 * ks + 4 * g) * 2);
      const u32x2 hi = *reinterpret_cast<const u32x2*>(Bt + r16 * 128 + (32 * ks + 16 + 4 * g) * 2);
      u32x4 v; v[0] = lo[0]; v[1] = lo[1]; v[2] = hi[0]; v[3] = hi[1];
      *reinterpret_cast<u32x4*>(oah + (ks * 64 + lane) * 16) = v;
    }
    __builtin_amdgcn_wave_barrier();
#pragma unroll
    for (int q = 0; q < 4; ++q)
#pragma unroll
      for (int r = 0; r < 4; ++r) *reinterpret_cast<bf16_t*>(Bt + (4 * g + r) * 128 + (16 * q + r16) * 2) = f2bf(qm[q][r]);
    __builtin_amdgcn_wave_barrier();
#pragma unroll
    for (int ks = 0; ks < 2; ++ks) {
      const int o1 = r16 * 128 + (32 * ks + 4 * g) * 2, o2 = r16 * 128 + (32 * ks + 16 + 4 * g) * 2;
      const f32x4 a1 = unpk4(*reinterpret_cast<const u32x2*>(Bt + o1)) + unpk4(*reinterpret_cast<const u32x2*>(Rt + o1));
      const f32x4 a2 = unpk4(*reinterpret_cast<const u32x2*>(Bt + o2)) + unpk4(*reinterpret_cast<const u32x2*>(Rt + o2));
      const uint2 lo = pack4bf(a1[0], a1[1], a1[2], a1[3]), hi = pack4bf(a2[0], a2[1], a2[2], a2[3]);
      u32x4 v; v[0] = lo.x; v[1] = lo.y; v[2] = hi.x; v[3] = hi.y;
      *reinterpret_cast<u32x4*>(oqm + (ks * 64 + lane) * 16) = v;
    }
    __builtin_amdgcn_wave_barrier();
  }
}
__device__ __forceinline__ void ph_rwkv_pq(const Params& p, int bid, int nb) {
  const int lane = threadIdx.x & 63, wv = threadIdx.x >> 6;
  const int nitems = NB_ * 8 * NCH;
  for (int wi = bid * 4 + wv; wi < nitems; wi += nb * 4) {
    const int chunk = wi % NCH, bh = wi / NCH, b = bh >> 3, h = bh & 7;
    const size_t o0 = ((size_t)b * L + chunk * 16) * 512 + h * 64 + lane;
    float pdv[16];
    const float rkc = p.r_k[h * 64 + lane];
#pragma unroll
    for (int t = 0; t < 16; ++t) { const size_t o = o0 + (size_t)t * 512; pdv[t] = bf2f(p.rr[o]) * bf2f(p.rk2[o]) * rkc; }
    const float s3l = tr_reduce16(pdv, lane);
    const float lnw = p.ln_w[h * 64 + lane], lnb = p.ln_b[h * 64 + lane];
    bf16_t gtv[16], vtv[16];
#pragma unroll
    for (int t = 0; t < 16; ++t) { const size_t o = o0 + (size_t)t * 512; gtv[t] = p.rg[o]; vtv[t] = p.rv[o]; }
#pragma unroll
    for (int t = 0; t < 16; ++t) {
      const float s3 = __int_as_float(__builtin_amdgcn_readlane(__float_as_int(s3l), 4 * t));
      const size_t o = o0 + (size_t)t * 512;
      const float gt = bf2f(gtv[t]), vt_ = bf2f(vtv[t]);
      p.rlw[o] = f2bf(lnw * gt);
      p.rbb[o] = f2bf((lnb + s3 * vt_) * gt);
    }
  }
}
struct ChainRegs { u32x4 s0, s1; u32x2 wt, zt, vb, pp, qq; float gcs; };
__device__ __forceinline__ void chain_load(const Params& p, int wi, unsigned ytok, int it, int lane, ChainRegs& c) {
  const unsigned char* q0 = (it < 2 ? p.cd_ah : p.cd_qm) + (size_t)wi * 2048 + (it & 1) * 1024;
  c.gcs = p.cd_gc[(size_t)wi * 64 + lane];
  c.s0 = *reinterpret_cast<const u32x4*>(q0 + lane * 16);
  c.s1 = *reinterpret_cast<const u32x4*>(p.cd_bk + (size_t)wi * 4096 + it * 1024 + lane * 16);
  c.wt = *reinterpret_cast<const u32x2*>(p.cd_wt + (size_t)wi * 2048 + (it * 64 + lane) * 8);
  c.zt = *reinterpret_cast<const u32x2*>(p.cd_zt + (size_t)wi * 2048 + (it * 64 + lane) * 8);
  c.vb = *reinterpret_cast<const u32x2*>(p.cd_vb + (size_t)wi * 2048 + (it * 64 + lane) * 8);
  c.pp = *reinterpret_cast<const u32x2*>(p.rlw + ytok);
  c.qq = *reinterpret_cast<const u32x2*>(p.rbb + ytok);
}
__device__ __forceinline__ void chain_publish(char* sh, int it, int lane, const ChainRegs& c) {
  *reinterpret_cast<u32x4*>(sh + it * 1024 + lane * 16) = c.s0;
  *reinterpret_cast<u32x4*>(sh + 4096 + it * 1024 + lane * 16) = c.s1;
  if (it == 0) reinterpret_cast<float*>(sh + 8192)[lane] = c.gcs;
}
__device__ __forceinline__ float dpp_sum16(float v) {
  v += __int_as_float(__builtin_amdgcn_update_dpp(0, __float_as_int(v), 0xB1, 0xF, 0xF, true));
  v += __int_as_float(__builtin_amdgcn_update_dpp(0, __float_as_int(v), 0x4E, 0xF, 0xF, true));
  v += __int_as_float(__builtin_amdgcn_update_dpp(0, __float_as_int(v), 0x141, 0xF, 0xF, true));
  v += __int_as_float(__builtin_amdgcn_update_dpp(0, __float_as_int(v), 0x140, 0xF, 0xF, true));
  return v;
}
template <bool STORE>
__device__ __forceinline__ void chain_finalize(const Params& p, const char* otile, unsigned ytok, u32x2 pp, u32x2 qq) {
  const int tid = threadIdx.x;
  const f32x4 o4 = *reinterpret_cast<const f32x4*>(otile + (tid >> 4) * 256 + (tid & 15) * 16);
  const float s1 = dpp_sum16(o4[0] + o4[1] + o4[2] + o4[3]);
  const float s2 = dpp_sum16(o4[0] * o4[0] + o4[1] * o4[1] + o4[2] * o4[2] + o4[3] * o4[3]);
  const float mean = s1 * (1.0f / 64);
  const float var = fmaxf(s2 * (1.0f / 64) - mean * mean, 0.0f);
  const float istd = rsqrtf(var + 64e-5f);
  const f32x4 y = (o4 - mean) * istd * unpk4(pp) + unpk4(qq);
  if (STORE) *reinterpret_cast<uint2*>(p.rkk + ytok) = pack4bf(y[0], y[1], y[2], y[3]);
  else asm volatile("" :: "v"(y[0]), "v"(y[1]), "v"(y[2]), "v"(y[3]));
}
template <bool STORE>
__device__ __forceinline__ void chain_step(const Params& p, char* otile, const char* otile_prev, bool have_prev, unsigned ytok_prev, u32x2 pp_prev, u32x2 qq_prev,
                                           const char* sh, char* shn, int it, int lane,
                                           const ChainRegs& c, const ChainRegs& cn, f32x4 (&st)[4]) {
  const int g = lane >> 4, r16 = lane & 15;
  const float* gcur = reinterpret_cast<const float*>(sh + 8192);
  u32x4 s0, s1;
  {
    const uint2 a = pack4bf(st[0][0], st[0][1], st[0][2], st[0][3]), b = pack4bf(st[1][0], st[1][1], st[1][2], st[1][3]);
    const uint2 cc = pack4bf(st[2][0], st[2][1], st[2][2], st[2][3]), d = pack4bf(st[3][0], st[3][1], st[3][2], st[3][3]);
    s0[0] = a.x; s0[1] = a.y; s0[2] = b.x; s0[3] = b.y;
    s1[0] = cc.x; s1[1] = cc.y; s1[2] = d.x; s1[3] = d.y;
  }
  const bf16x8 sb0 = __builtin_bit_cast(bf16x8, s0), sb1 = __builtin_bit_cast(bf16x8, s1);
  f32x4 ut = unpk4(c.wt), ot = unpk4(c.zt);
  ut = MFMA32(*reinterpret_cast<const bf16x8*>(sh + lane * 16), sb0, ut);
  ot = MFMA32(*reinterpret_cast<const bf16x8*>(sh + 2048 + lane * 16), sb0, ot);
  ut = MFMA32(*reinterpret_cast<const bf16x8*>(sh + 1024 + lane * 16), sb1, ut);
  ot = MFMA32(*reinterpret_cast<const bf16x8*>(sh + 3072 + lane * 16), sb1, ot);
  chain_publish(shn, it, lane, cn);
  if (have_prev) chain_finalize<STORE>(p, otile_prev, ytok_prev, pp_prev, qq_prev);
#pragma unroll
  for (int r = 0; r < 4; ++r) *reinterpret_cast<float*>(otile + (4 * g + r) * 256 + (16 * it + r16) * 4) = ot[r];
  const uint2 u2 = pack4bf(ut[0], ut[1], ut[2], ut[3]);
  u32x4 uv; uv[0] = u2.x; uv[1] = u2.y; uv[2] = c.vb[0]; uv[3] = c.vb[1];
  const bf16x8 uvb = __builtin_bit_cast(bf16x8, uv);
#pragma unroll
  for (int q = 0; q < 4; ++q)
    st[q] = MFMA32(*reinterpret_cast<const bf16x8*>(sh + 4096 + q * 1024 + lane * 16), uvb, st[q] * *reinterpret_cast<const f32x4*>(gcur + 16 * q + 4 * g));
  __syncthreads();
}
template <bool STORE = true>
__device__ __forceinline__ void ph_chain(const Params& p, char* smem, int bid, int nb) {
  const int tid = threadIdx.x, lane = tid & 63, it = tid >> 6;
  char* shb = smem + 8192;
  for (int bh = bid; bh < NB_ * 8; bh += nb) {
    f32x4 st[4];
#pragma unroll
    for (int q = 0; q < 4; ++q) st[q] = (f32x4){0.f, 0.f, 0.f, 0.f};
    const int w0 = bh * NCH;
    const int b = bh >> 3, h = bh & 7;
    const unsigned y0 = (unsigned)((b * L + (tid >> 4)) * 512 + h * 64 + (tid & 15) * 4);
    ChainRegs c0, c1, c2, c3, c4, c5, c6, c7;
#define CH_LOAD(cc, set) chain_load(p, w0 + min((cc), NCH - 1), y0 + (unsigned)min((cc), NCH - 1) * 8192u, it, lane, set)
    CH_LOAD(0, c0); CH_LOAD(1, c1); CH_LOAD(2, c2); CH_LOAD(3, c3); CH_LOAD(4, c4); CH_LOAD(5, c5); CH_LOAD(6, c6); CH_LOAD(7, c7);
    __syncthreads();
    chain_publish(shb, it, lane, c0);
    __syncthreads();
    u32x2 ppp = {0u, 0u}, qqp = {0u, 0u};
#define CH_STEP(cc, cur, nxt) { const int par = (cc) & 1; \
      chain_step<STORE>(p, smem + par * 4096, smem + (1 - par) * 4096, (cc) > 0, y0 + (unsigned)((cc) - 1) * 8192u, ppp, qqp, \
                        shb + par * 8448, shb + (1 - par) * 8448, it, lane, cur, nxt, st); \
      ppp = cur.pp; qqp = cur.qq; CH_LOAD((cc) + 8, cur); }
    for (int ch = 0; ch < 128; ch += 8) {
      CH_STEP(ch, c0, c1) CH_STEP(ch + 1, c1, c2) CH_STEP(ch + 2, c2, c3) CH_STEP(ch + 3, c3, c4)
      CH_STEP(ch + 4, c4, c5) CH_STEP(ch + 5, c5, c6) CH_STEP(ch + 6, c6, c7) CH_STEP(ch + 7, c7, c0)
    }
    CH_STEP(128, c0, c1)
#undef CH_STEP
#undef CH_LOAD
    chain_finalize<STORE>(p, smem + ((NCH - 1) & 1) * 4096, y0 + (unsigned)(NCH - 1) * 8192u, ppp, qqp);
    __syncthreads();
  }
}
__device__ __forceinline__ void ph_tabconv(const Params& p, int bid, int nb) {
  const int nvec = 2 * 16384 * 256;
  const int stride = nb * NTHR;
  for (int base = bid * NTHR + threadIdx.x; base < nvec; base += 8 * stride) {
    f32x4 v[8];
#pragma unroll
    for (int k = 0; k < 8; ++k) {
      const int i = min(base + k * stride, nvec - 1);
      const bool tab = i >= 16384 * 256;
      v[k] = *reinterpret_cast<const f32x4*>((tab ? p.pv : p.pu) + (size_t)(tab ? i - 16384 * 256 : i) * 4);
    }
#pragma unroll
    for (int k = 0; k < 8; ++k) {
      const int i = min(base + k * stride, nvec - 1);
      const bool tab = i >= 16384 * 256;
      f32x4 w = v[k] * (tab ? 16.0f : 256.0f);
      if (!tab) w *= *reinterpret_cast<const f32x4*>(p.g_ffn + (i & 255) * 4);
      int wv = __builtin_amdgcn_cvt_pk_fp8_f32(w[0], w[1], 0, false);
      wv = __builtin_amdgcn_cvt_pk_fp8_f32(w[2], w[3], wv, true);
      *reinterpret_cast<unsigned*>((tab ? p.v8 : p.u8) + (size_t)(tab ? i - 16384 * 256 : i) * 4) = (unsigned)wv;
    }
  }
}
__device__ __forceinline__ void ph_outproj(const Params& p, char* smem, int bid, int nb) {
  const int lane = threadIdx.x & 63, w = threadIdx.x >> 6, wm = w >> 1, wn = w & 1, g = lane >> 4, r16 = lane & 15;
  for_tiles_xcd(TR / 128, 4, bid, nb, [&](int tm, int tn) {
    const int m0 = tm * 128, n0 = tn * 256;
    f32x4 acc[4][8];
    gemm_tile_wide(smem, m0, n0, 32,
        [&](int r, int k) {
          const size_t tt = (size_t)rt2tt(r);
          return k < 512 ? p.qf + tt * 768 + (k >> 7) * 192 + (k & 127) : p.rkk + tt * 512 + (k - 512);
        },
        [&](int n, int k) { return p.w_outT + (size_t)n * 1024 + k; }, acc,
        [&](int kt, f32x4 (&a)[4][8]) {
          if (kt == 16) {
#pragma unroll
            for (int i = 0; i < 4; ++i) {
              const f32x4 q4 = *reinterpret_cast<const f32x4*>(p.ossq + (size_t)rt2tt(m0 + wm * 64 + 16 * i + r16) * 4);
              const float rs = rsqrtf((q4[0] + q4[1] + q4[2] + q4[3]) * (1.0f / 512) + RMS_EPS);
#pragma unroll
              for (int j = 0; j < 8; ++j) a[i][j] *= rs;
            }
          }
        });
#pragma unroll 1
    for (int half = 0; half < 2; ++half) {
      stage_acc_half(smem, acc, half);
#pragma unroll 1
      for (int qb = 0; qb < 8; qb += 4) {
      f32x4 hh[4][2];
#pragma unroll
      for (int qi = 0; qi < 4; ++qi) {
        const int c = threadIdx.x + 256 * (qb + qi);
        const float* hr = hrow(p, rt2tt(m0 + (c >> 4))) + n0 + half * 128 + (c & 15) * 8;
        hh[qi][0] = *reinterpret_cast<const f32x4*>(hr); hh[qi][1] = *reinterpret_cast<const f32x4*>(hr + 4);
      }
#pragma unroll
      for (int qi = 0; qi < 4; ++qi) {
        const int q = qb + qi;
        const int c = threadIdx.x + 256 * q;
        const int row = c >> 4, col8 = (c & 15) * 8;
        const int m = m0 + row, n = n0 + half * 128 + col8;
        const f32x4 h0 = hh[qi][0], h1 = hh[qi][1];
        float v[8];
        ld8(smem, row, col8, v);
        float sq = 0.f;
#pragma unroll
        for (int e = 0; e < 8; ++e) { v[e] += e < 4 ? h0[e] : h1[e - 4]; sq += v[e] * v[e]; }
        f32x4 o0, o1;
#pragma unroll
        for (int e = 0; e < 4; ++e) { o0[e] = v[e]; o1[e] = v[4 + e]; }
        *reinterpret_cast<f32x4*>(p.out + (size_t)m * D + n) = o0;
        *reinterpret_cast<f32x4*>(p.out + (size_t)m * D + n + 4) = o1;
        st8f(p.h2b + (size_t)m * D + n, v);
        sq += __shfl_xor(sq, 1, 64); sq += __shfl_xor(sq, 2, 64); sq += __shfl_xor(sq, 4, 64); sq += __shfl_xor(sq, 8, 64);
        if ((threadIdx.x & 15) == 0) atomicAdd(p.h2ss + m, sq);
      }
      }
    }
  });
}
#define CE_(a, b) { const int t_ = max(a, b); b = min(a, b); a = t_; }
__device__ __forceinline__ int fkey7(float x, int idx) {
  int b = __float_as_int(x);
  b ^= (b >> 31) & 0x7fffffff;
  return (b & ~127) | (127 - idx);
}
__device__ __forceinline__ float fvalm(int k, int mask) {
  int b = k & ~mask;
  b ^= (b >> 31) & 0x7fffffff;
  return __int_as_float(b);
}
__device__ __forceinline__ void bitonic_sort16(int (&v)[16]) {
#pragma unroll
  for (int k = 2; k <= 16; k <<= 1)
#pragma unroll
    for (int j = k >> 1; j > 0; j >>= 1)
#pragma unroll
      for (int i = 0; i < 16; ++i) {
        const int l = i ^ j;
        if (l > i) {
          if ((i & k) == 0) { CE_(v[i], v[l]); } else { CE_(v[l], v[i]); }
        }
      }
}
__device__ __forceinline__ void bitonic_merge16(int (&v)[16]) {
#pragma unroll
  for (int j = 8; j > 0; j >>= 1)
#pragma unroll
    for (int i = 0; i < 16; ++i) {
      const int l = i ^ j;
      if (l > i) { CE_(v[i], v[l]); }
    }
}
__device__ __forceinline__ void ph_route(const Params& p, char* smem, int bid, int nb) {
  const int tid = threadIdx.x, lane = tid & 63, w = tid >> 6, wm = w >> 1, wn = w & 1, g = lane >> 4, r16 = lane & 15;
  int* L2l = reinterpret_cast<int*>(smem);
  int* Lx = reinterpret_cast<int*>(smem + 8192);
  int* L1l = reinterpret_cast<int*>(smem + 67584);
  for_tiles_xcd(TR / 128, 8, bid, nb, [&](int mt, int h) {
    const int m0 = mt * 128;
    for (int c = 0; c < 2; ++c) {
      f32x4 acc[4][4];
      gemm_tile_glds<true>(smem, m0, (2 * h + c) * 128, 32,
          [&](int r, int k) { return p.h2b + (size_t)r * D + k; },
          [&](int n, int k) { return p.w_qT + (size_t)n * 1024 + k; }, acc);
      float* Et = reinterpret_cast<float*>(smem);
#pragma unroll
      for (int i = 0; i < 4; ++i)
#pragma unroll
        for (int j = 0; j < 4; ++j)
          *reinterpret_cast<f32x4*>(Et + (wm * 64 + 16 * i + r16) * 132 + wn * 64 + 16 * j + 4 * g) = acc[i][j];
      __syncthreads();
      f32x4 sc[2][8];
#pragma unroll
      for (int tt = 0; tt < 2; ++tt)
#pragma unroll
        for (int kt = 0; kt < 8; ++kt) sc[tt][kt] = *reinterpret_cast<const f32x4*>(Et + (32 * w + 16 * tt + r16) * 132 + 16 * kt + 4 * g);
      __syncthreads();
#pragma unroll
      for (int tt = 0; tt < 2; ++tt) {
        int lo[16], hi[16];
#pragma unroll
        for (int kt = 0; kt < 4; ++kt)
#pragma unroll
          for (int r = 0; r < 4; ++r) {
            lo[kt * 4 + r] = fkey7(sc[tt][kt][r], 16 * kt + 4 * g + r);
            hi[kt * 4 + r] = fkey7(sc[tt][kt + 4][r], 16 * (kt + 4) + 4 * g + r);
          }
        bitonic_sort16(lo);
        bitonic_sort16(hi);
#pragma unroll
        for (int i = 0; i < 16; ++i) lo[i] = max(lo[i], hi[15 - i]);
        bitonic_merge16(lo);
#pragma unroll
        for (int st = 16; st <= 32; st <<= 1) {
          int ot[16];
#pragma unroll
          for (int i = 0; i < 16; ++i) ot[i] = __shfl_xor(lo[15 - i], st, 64);
#pragma unroll
          for (int i = 0; i < 16; ++i) lo[i] = max(lo[i], ot[i]);
          bitonic_merge16(lo);
        }
        if (g == 0) {
          int* dst = (c ? L2l : L1l) + (32 * w + 16 * tt + r16) * 16;
#pragma unroll
          for (int q = 0; q < 4; ++q) {
            u32x4 v; v[0] = lo[4 * q]; v[1] = lo[4 * q + 1]; v[2] = lo[4 * q + 2]; v[3] = lo[4 * q + 3];
            *reinterpret_cast<u32x4*>(dst + 4 * q) = v;
          }
        }
      }
      __syncthreads();
    }
    {
      const int tok = tid & 127, half = tid >> 7;
      int k1[16], k2[16];
      float v1[16], v2[16];
#pragma unroll
      for (int q = 0; q < 4; ++q) {
        const u32x4 a = *reinterpret_cast<const u32x4*>(L1l + tok * 16 + 4 * q);
        const u32x4 b = *reinterpret_cast<const u32x4*>(L2l + tok * 16 + 4 * q);
#pragma unroll
        for (int e = 0; e < 4; ++e) { k1[4 * q + e] = (int)a[e]; k2[4 * q + e] = (int)b[e]; }
      }
#pragma unroll
      for (int i = 0; i < 16; ++i) { v1[i] = fvalm(k1[i], 127); v2[i] = fvalm(k2[i], 127); }
      int lst[16];
#pragma unroll
      for (int i = 0; i < 16; ++i) lst[i] = (int)0x80000000;
      if (half == 0) {
#pragma unroll
        for (int a = 0; a < 2; ++a)
#pragma unroll
          for (int b = 0; b < 16 / (a + 1); ++b) {
            int x = __float_as_int(v1[a] + v2[b]);
            x ^= (x >> 31) & 0x7fffffff;
            x = (x & ~255) | (255 - (a * 16 + b));
#pragma unroll
            for (int i = 0; i < 16; ++i) CE_(lst[i], x);
          }
      } else {
#pragma unroll
        for (int a = 2; a < 16; ++a)
#pragma unroll
          for (int b = 0; b < 16 / (a + 1); ++b) {
            int x = __float_as_int(v1[a] + v2[b]);
            x ^= (x >> 31) & 0x7fffffff;
            x = (x & ~255) | (255 - (a * 16 + b));
#pragma unroll
            for (int i = 0; i < 16; ++i) CE_(lst[i], x);
          }
      }
#pragma unroll
      for (int q = 0; q < 4; ++q) {
        u32x4 v; v[0] = lst[4 * q]; v[1] = lst[4 * q + 1]; v[2] = lst[4 * q + 2]; v[3] = lst[4 * q + 3];
        *reinterpret_cast<u32x4*>(Lx + (half * 128 + tok) * 16 + 4 * q) = v;
      }
      __syncthreads();
      int fin[16];
#pragma unroll
      for (int q = 0; q < 4; ++q) {
        const u32x4 o = *reinterpret_cast<const u32x4*>(Lx + ((1 - half) * 128 + tok) * 16 + 4 * q);
#pragma unroll
        for (int e = 0; e < 4; ++e) fin[4 * q + e] = (int)o[e];
      }
#pragma unroll
      for (int i = 0; i < 8; ++i) { const int t_ = fin[i]; fin[i] = fin[15 - i]; fin[15 - i] = t_; }
#pragma unroll
      for (int i = 0; i < 16; ++i) fin[i] = max(fin[i], lst[i]);
      float sv[16], mx = -1e30f;
      const float rs2 = rsqrtf(p.h2ss[m0 + tok] * (1.0f / D) + RMS_EPS);
#pragma unroll
      for (int i = 0; i < 16; ++i) { sv[i] = fvalm(fin[i], 255); mx = fmaxf(mx, sv[i]); }
      float sum = 0.f;
#pragma unroll
      for (int i = 0; i < 16; ++i) { sv[i] = __expf((sv[i] - mx) * rs2); sum += sv[i]; }
      const float isum = 1.0f / sum;
      const size_t ob = (size_t)(m0 + tok) * 128 + h * 16 + half * 8;
#pragma unroll
      for (int i = 0; i < 8; ++i) {
        const int code = 255 - (fin[i] & 255);
        const int a = code >> 4, b = code & 15;
        const int i1 = 127 - (L1l[tok * 16 + a] & 127), i2 = 127 - (L2l[tok * 16 + b] & 127);
        p.pidx[ob + i] = i1 * 128 + i2;
        p.pgate[ob + i] = sv[i] * isum;
      }
    }
    __syncthreads();
  });
}
__device__ __forceinline__ void ph_expert(const Params& p, char* smem, int bid, int nb) {
  const int lane = threadIdx.x & 63, wv = threadIdx.x >> 6;
  const int g3 = lane >> 3, p8 = lane & 7;
  const bool b5 = lane & 32, b4 = lane & 16, b3 = lane & 8;
  const bool pb2 = lane & 4, pb1 = lane & 2, pb0 = lane & 1;
  unsigned* idxl = reinterpret_cast<unsigned*>(smem + wv * 8192);
  float* al = reinterpret_cast<float*>(smem + wv * 8192 + 4096);
  for (int grp = bid * 4 + wv; grp < TR / 8; grp += nb * 4) {
    const int rt0 = grp * 8;
    float rs2[8];
#pragma unroll
    for (int t = 0; t < 8; ++t) {
      rs2[t] = rsqrtf(p.h2ss[rt0 + t] * (1.0f / D) + RMS_EPS);
      const size_t pb = (size_t)(rt0 + t) * 128;
      idxl[t * 128 + lane] = (unsigned)p.pidx[pb + lane] << 10;
      idxl[t * 128 + 64 + lane] = (unsigned)p.pidx[pb + 64 + lane] << 10;
      al[t * 128 + lane] = p.pgate[pb + lane];
      al[t * 128 + 64 + lane] = p.pgate[pb + 64 + lane];
    }
    __builtin_amdgcn_wave_barrier();
    float dacc[8][2];
#pragma unroll
    for (int t = 0; t < 8; ++t) { dacc[t][0] = 0.f; dacc[t][1] = 0.f; }
#pragma unroll 1
    for (int x = 0; x < 8; ++x) {
      const unsigned coff = 128u * x + 16u * p8;
#pragma unroll 1
      for (int t = 0; t < 8; ++t) {
        f32x2 xp[8];
        {
          const bf16_t* hr = p.h2b + (size_t)(rt0 + t) * D + coff;
          const u32x4 a = *reinterpret_cast<const u32x4*>(hr);
          const u32x4 b = *reinterpret_cast<const u32x4*>(hr + 8);
#pragma unroll
          for (int q = 0; q < 4; ++q) {
            xp[q][0] = __uint_as_float(a[q] << 16); xp[q][1] = __uint_as_float(a[q] & 0xffff0000u);
            xp[4 + q][0] = __uint_as_float(b[q] << 16); xp[4 + q][1] = __uint_as_float(b[q] & 0xffff0000u);
          }
        }
        u32x4 rows[16];
#pragma unroll
        for (int j = 0; j < 16; ++j) {
          const unsigned off = idxl[t * 128 + 8 * j + g3];
          rows[j] = *reinterpret_cast<const u32x4*>(p.u8 + off + coff);
        }
        float sj[16];
#pragma unroll
        for (int j = 0; j < 16; ++j) {
          f32x2 acc2 = {0.f, 0.f};
#pragma unroll
          for (int q = 0; q < 4; ++q) {
            acc2 += xp[2 * q] * __builtin_amdgcn_cvt_pk_f32_fp8((int)rows[j][q], false);
            acc2 += xp[2 * q + 1] * __builtin_amdgcn_cvt_pk_f32_fp8((int)rows[j][q], true);
          }
          sj[j] = acc2[0] + acc2[1];
        }
#pragma unroll
        for (int jj = 0; jj < 2; ++jj) {
          float r4[4], r2[2];
#pragma unroll
          for (int i = 0; i < 4; ++i) {
            const float kp = pb2 ? sj[8 * jj + i + 4] : sj[8 * jj + i], sd = pb2 ? sj[8 * jj + i] : sj[8 * jj + i + 4];
            r4[i] = kp + __int_as_float(__builtin_amdgcn_update_dpp(0, __float_as_int(sd), 0x141, 0xF, 0xF, true));
          }
#pragma unroll
          for (int i = 0; i < 2; ++i) {
            const float kp = pb1 ? r4[i + 2] : r4[i], sd = pb1 ? r4[i] : r4[i + 2];
            r2[i] = kp + __int_as_float(__builtin_amdgcn_update_dpp(0, __float_as_int(sd), 0x4E, 0xF, 0xF, true));
          }
          {
            const float kp = pb0 ? r2[1] : r2[0], sd = pb0 ? r2[0] : r2[1];
            dacc[0][jj] += kp + __int_as_float(__builtin_amdgcn_update_dpp(0, __float_as_int(sd), 0xB1, 0xF, 0xF, true));
          }
        }
        {
          const float r0 = dacc[0][0], r1 = dacc[0][1];
#pragma unroll
          for (int q = 0; q < 7; ++q) { dacc[q][0] = dacc[q + 1][0]; dacc[q][1] = dacc[q + 1][1]; }
          dacc[7][0] = r0; dacc[7][1] = r1;
        }
      }
    }
#pragma unroll
    for (int t = 0; t < 8; ++t)
#pragma unroll
      for (int jj = 0; jj < 2; ++jj) {
        const int slot = 8 * (p8 + 8 * jj) + g3;
        const float dot = dacc[t][jj] * rs2[t] * (1.0f / 256.0f);
        const float gt = al[t * 128 + slot];
        al[t * 128 + slot] = 0.5f * dot * (1.0f + erff(dot * 0.7071067811865476f)) * gt * (1.0f / 16.0f);
      }
    __builtin_amdgcn_wave_barrier();
    float ssq[8];
#pragma unroll
    for (int t = 0; t < 8; ++t) ssq[t] = 0.f;
    const int cw = 8 * (b5 ? 1 : 0) + 4 * (b4 ? 1 : 0) + 2 * (b3 ? 1 : 0);
#pragma unroll 1
    for (int x = 0; x < 8; ++x) {
      const unsigned coff = 128u * x + 16u * p8;
#pragma unroll 1
      for (int t = 0; t < 8; ++t) {
        u32x4 rows[16];
        float av[16];
#pragma unroll
        for (int j = 0; j < 16; ++j) {
          const unsigned off = idxl[t * 128 + 8 * j + g3];
          av[j] = al[t * 128 + 8 * j + g3];
          rows[j] = *reinterpret_cast<const u32x4*>(p.v8 + off + coff);
        }
        f32x2 oa[8];
#pragma unroll
        for (int q = 0; q < 8; ++q) oa[q] = (f32x2){0.f, 0.f};
#pragma unroll
        for (int j = 0; j < 16; ++j) {
          const f32x2 a2 = {av[j], av[j]};
#pragma unroll
          for (int q = 0; q < 4; ++q) {
            oa[2 * q] += a2 * __builtin_amdgcn_cvt_pk_f32_fp8((int)rows[j][q], false);
            oa[2 * q + 1] += a2 * __builtin_amdgcn_cvt_pk_f32_fp8((int)rows[j][q], true);
          }
        }
        f32x2 q4v[4], q2v[2], q1v;
#pragma unroll
        for (int i = 0; i < 4; ++i)
#pragma unroll
          for (int c = 0; c < 2; ++c) {
            const auto r = __builtin_amdgcn_permlane32_swap(__float_as_uint(oa[i][c]), __float_as_uint(oa[i + 4][c]), false, false);
            q4v[i][c] = __uint_as_float(r[0]) + __uint_as_float(r[1]);
          }
#pragma unroll
        for (int i = 0; i < 2; ++i)
#pragma unroll
          for (int c = 0; c < 2; ++c) {
            const auto r = __builtin_amdgcn_permlane16_swap(__float_as_uint(q4v[i][c]), __float_as_uint(q4v[i + 2][c]), false, false);
            q2v[i][c] = __uint_as_float(r[0]) + __uint_as_float(r[1]);
          }
        {
          const f32x2 sd = b3 ? q2v[0] : q2v[1], kp = b3 ? q2v[1] : q2v[0];
          q1v[0] = kp[0] + __int_as_float(__builtin_amdgcn_update_dpp(0, __float_as_int(sd[0]), 0x128, 0xF, 0xF, true));
          q1v[1] = kp[1] + __int_as_float(__builtin_amdgcn_update_dpp(0, __float_as_int(sd[1]), 0x128, 0xF, 0xF, true));
        }
        float* hp = p.out + (size_t)(rt0 + t) * D + coff + cw;
        const f32x2 h3 = *reinterpret_cast<const f32x2*>(hp) + q1v;
        *reinterpret_cast<f32x2*>(hp) = h3;
        {
          const float r0 = ssq[0] + h3[0] * h3[0] + h3[1] * h3[1];
#pragma unroll
          for (int q = 0; q < 7; ++q) ssq[q] = ssq[q + 1];
          ssq[7] = r0;
        }
      }
    }
    asm volatile("s_waitcnt vmcnt(0)" ::: "memory");
    {
      float rsv[8];
#pragma unroll
      for (int t = 0; t < 8; ++t) rsv[t] = rsqrtf(wave_sum(ssq[t]) * (1.0f / D) + RMS_EPS);
      f32x2 gfv[8];
#pragma unroll
      for (int x = 0; x < 8; ++x) gfv[x] = *reinterpret_cast<const f32x2*>(p.g_fin + 128 * x + 16 * p8 + cw);
      unsigned long long hv[8][8];
#pragma unroll
      for (int t = 0; t < 8; ++t)
#pragma unroll
        for (int x = 0; x < 8; ++x)
          hv[t][x] = __hip_atomic_load(reinterpret_cast<unsigned long long*>(p.out + (size_t)(rt0 + t) * D + 128 * x + 16 * p8 + cw),
                                       __ATOMIC_RELAXED, __HIP_MEMORY_SCOPE_AGENT);
#pragma unroll
      for (int t = 0; t < 8; ++t)
#pragma unroll
        for (int x = 0; x < 8; ++x) {
          f32x2 o2;
          o2[0] = __uint_as_float((unsigned)hv[t][x]) * rsv[t] * gfv[x][0];
          o2[1] = __uint_as_float((unsigned)(hv[t][x] >> 32)) * rsv[t] * gfv[x][1];
          *reinterpret_cast<f32x2*>(p.out + (size_t)(rt0 + t) * D + 128 * x + 16 * p8 + cw) = o2;
        }
    }
    __builtin_amdgcn_wave_barrier();
  }
}

#define XB_TMO      128
#define XB_XCNT(j)  (256  + 64 * (j))
#define XB_XSUB(j)  (1280 + 64 * (j))
#define XB_XGEN(j)  (2304 + 64 * (j))
#define XB_TOP      3328
#define XB_TOPGEN   3392
#define XCD_BAR_WORDS 3456
#define XB_SPIN_CAP (1u << 18)
#define LAS __attribute__((address_space(3)))
__device__ __forceinline__ unsigned xb_ld(unsigned* p) { return __hip_atomic_load(p, __ATOMIC_RELAXED, __HIP_MEMORY_SCOPE_AGENT); }
__device__ __forceinline__ unsigned xb_add(unsigned* p, unsigned v) { return __hip_atomic_fetch_add(p, v, __ATOMIC_RELAXED, __HIP_MEMORY_SCOPE_AGENT); }
__device__ __forceinline__ unsigned xb_xcc_id() { return (unsigned)__builtin_amdgcn_s_getreg((3 << 11) | 20) & 0xFu; }
#define XB_SPIN(cond, bar) do { unsigned _sp = 0; while (cond) { __builtin_amdgcn_s_sleep(1); \
    if ((++_sp & 255u) == 0u) { if (xb_ld(&(bar)[XB_TMO])) break; if (_sp > XB_SPIN_CAP) { atomicAdd(&(bar)[XB_TMO], 1u); break; } } } } while (0)
struct XcdBarrier { unsigned* bar; unsigned x; volatile LAS unsigned* st; };
__device__ __forceinline__ XcdBarrier xcd_barrier_post(unsigned* bar, volatile LAS unsigned* st) {
  XcdBarrier b; b.bar = bar; b.x = xb_xcc_id(); b.st = st;
  if (threadIdx.x == 0) (void)xb_add(&bar[XB_XCNT(b.x)], 1u);
  return b;
}
__device__ __forceinline__ void xcd_barrier_complete(unsigned* bar, unsigned x, unsigned& nloc, unsigned& nx) {
  const unsigned G = gridDim.x * gridDim.y * gridDim.z;
  unsigned sum, cnt, mine, sp = 0u;
  for (;;) {
    sum = 0u; cnt = 0u; mine = 0u;
#pragma unroll
    for (unsigned j = 0; j < 16; ++j) { const unsigned c = xb_ld(&bar[XB_XCNT(j)]); sum += c; cnt += (c > 0u) ? 1u : 0u; mine = (j == x) ? c : mine; }
    if (sum == G) break;
    __builtin_amdgcn_s_sleep(1);
    if ((++sp & 255u) == 0u) { if (xb_ld(&bar[XB_TMO])) break; if (sp > XB_SPIN_CAP) { atomicAdd(&bar[XB_TMO], 1u); break; } }
  }
  nloc = mine > 0u ? mine : 1u; nx = cnt > 0u ? cnt : 1u;
}
__device__ __forceinline__ void xcd_barrier(const XcdBarrier& b) {
  asm volatile("s_waitcnt vmcnt(0)" ::: "memory");
  __syncthreads();
  if (threadIdx.x == 0) {
    unsigned* bar = b.bar;
    __builtin_amdgcn_s_waitcnt(0);
    unsigned nloc = b.st[0], nx = b.st[1];
    if (nloc == 0u) { xcd_barrier_complete(bar, b.x, nloc, nx); b.st[0] = nloc; b.st[1] = nx; }
    const unsigned old = xb_add(&bar[XB_XSUB(b.x)], 1u);
    const unsigned gen = old / nloc;
    if (old + 1u == (gen + 1u) * nloc) {
      __builtin_amdgcn_fence(__ATOMIC_RELEASE, "agent");
      asm volatile("s_waitcnt vmcnt(0)" ::: "memory");
      const unsigned og = xb_add(&bar[XB_TOP], 1u);
      const unsigned tg = og / nx;
      if (og + 1u == (tg + 1u) * nx) xb_add(&bar[XB_TOPGEN], 1u);
      else XB_SPIN(xb_ld(&bar[XB_TOPGEN]) == tg, bar);
      __builtin_amdgcn_fence(__ATOMIC_ACQUIRE, "agent");
      xb_add(&bar[XB_XGEN(b.x)], 1u);
      asm volatile("s_waitcnt vmcnt(0)" ::: "memory");
    } else {
      XB_SPIN(xb_ld(&bar[XB_XGEN(b.x)]) == gen, bar);
      __builtin_amdgcn_fence(__ATOMIC_ACQUIRE, "agent");
      asm volatile("s_waitcnt vmcnt(0)" ::: "memory");
    }
  }
  __syncthreads();
}

constexpr int SMEM_FLOATS = 18944 + 4;


__global__ void __launch_bounds__(NTHR, 2) k_mega(Params p) {
  __shared__ __attribute__((aligned(16))) float smem[SMEM_FLOATS];
  if (threadIdx.x == 0) { smem[18944] = 0.f; smem[18945] = 0.f; smem[18946] = 0.f; smem[18947] = 0.f; }
  __syncthreads();
  const XcdBarrier xb = xcd_barrier_post(p.bar, (volatile LAS unsigned*)&smem[18944]);
  if (p.never) { cg::grid_group grid = cg::this_grid(); grid.sync(); }
  const int bid = blockIdx.x, nb = gridDim.x;
  ph_prep(p, bid, nb);
  xcd_barrier(xb);
  ph_inproj(p, (char*)smem, bid, nb);
  if (nb > 384) { if (bid >= 256) ph_w2(p, (char*)smem, bid - 256, nb - 256); }
  else ph_w2(p, (char*)smem, bid, nb);
  xcd_barrier(xb);
  ph_rwkv_prep(p, (char*)smem, bid, nb);
  ph_q_up(p, (char*)smem, bid, nb);
  ph_kv_up(p, (char*)smem, bid, nb);
  xcd_barrier(xb);
  ph_rwkv_pre(p, (char*)smem, bid, nb);
  ph_rwkv_pq(p, bid, nb);
  xcd_barrier(xb);
  if (bid < 64) ph_chain(p, (char*)smem, bid, 64);
  else { ph_attn(p, (char*)smem, bid - 64, nb - 64); ph_tabconv(p, bid - 64, nb - 64); }
  xcd_barrier(xb);
  ph_outproj(p, (char*)smem, bid, nb);
  xcd_barrier(xb);
  ph_route(p, (char*)smem, bid, nb);
  xcd_barrier(xb);
  ph_expert(p, (char*)smem, bid, nb);
}

extern "C" void kernel_launch(void* const* d_in, const int* in_sizes, int n_in, void* d_out, int out_size, void* d_ws,
                              size_t ws_size, hipStream_t stream) {
  Params p{};
  const float* const* in = reinterpret_cast<const float* const*>(d_in);
  p.x = in[0]; p.meta = in[1]; p.g_mix = in[2]; p.w_in = in[3]; p.g_q = in[4]; p.w_uq = in[5]; p.g_kv = in[6];
  p.w_ukv = in[7]; p.g_out = in[8]; p.mu = in[9]; p.w0 = in[10]; p.w_up = in[11]; p.a0 = in[12]; p.a_up = in[13];
  p.g_up = in[14]; p.k_k = in[15]; p.k_a = in[16]; p.r_k = in[17]; p.ln_w = in[18]; p.ln_b = in[19]; p.w_out = in[20];
  p.g_ffn = in[21]; p.w_q = in[22]; p.subk = in[23]; p.pu = in[24]; p.pv = in[25]; p.g_fin = in[26];
  p.out = (float*)d_out;
  char* ws = (char*)d_ws;
  size_t off = 0;
  auto take = [&](size_t bytes) { char* r = ws + off; off += (bytes + 255) & ~(size_t)255; return r; };
  p.bar = (unsigned*)take((size_t)XCD_BAR_WORDS * 4);
  p.h2ss = (float*)take((size_t)TR * 4);
  const size_t zero_bytes = off;
  p.rstd1 = (float*)take((size_t)T * 4);
  p.ossq = (float*)take((size_t)T * 4 * 4);
  p.w_inT = (bf16_t*)take((size_t)DIN * 1024 * 2);
  p.w_uqT = (bf16_t*)take((size_t)768 * 256 * 2);
  p.w_ukvT = (bf16_t*)take((size_t)1024 * 128 * 2);
  p.w_outT = (bf16_t*)take((size_t)1024 * 1024 * 2);
  p.w_qT = (bf16_t*)take((size_t)2048 * 1024 * 2);
  p.subkb = (bf16_t*)take((size_t)8 * 2 * 128 * 128 * 2);
  p.w_lrT = (bf16_t*)take((size_t)1536 * 128 * 2);
  p.ropec = (float*)take((size_t)L * 32 * 4);
  p.ropes = (float*)take((size_t)L * 32 * 4);
  char* regA = take((size_t)T * DIN * 2);
  char* regB = take((size_t)T * (768 + 1024 + 64) * 2);
  char* regBend = ws + off;
  char* regC = take((size_t)T * 512 * 2 * 7);
  if (off > ws_size) fprintf(stderr, "workspace too small: need %zu have %zu\n", off, ws_size);
  p.proj = (bf16_t*)regA;
  {
    const size_t NW = (size_t)NB_ * 8 * NCH;
    p.cd_qm = (unsigned char*)regA;
    p.cd_wt = p.cd_qm + NW * 2048;
    p.cd_zt = p.cd_wt + NW * 2048;
    p.cd_vb = p.cd_zt + NW * 2048;
    p.cd_bk = (unsigned char*)d_out;
    p.cd_ah = p.cd_bk + NW * 4096;
    p.cd_gc = (float*)(p.cd_ah + NW * 2048);
  }
  p.h2b = (bf16_t*)regA;
  p.pidx = (int*)(regA + (size_t)TR * D * 2);
  p.pgate = (float*)(regA + (size_t)TR * D * 2 + (size_t)TR * 128 * 4);
  p.qf = (bf16_t*)regB;
  p.kn = (bf16_t*)(regB + (size_t)T * 768 * 2);
  p.vt = (bf16_t*)(regB + (size_t)T * (768 + 512) * 2);
  p.kr = (bf16_t*)(regB + (size_t)T * (768 + 1024) * 2);
  p.hb = (bf16_t*)regC;
  p.w_qb = (bf16_t*)(regC + (size_t)40 * 1024 * 1024);
  bf16_t* c = (bf16_t*)regC;
  const size_t a512 = (size_t)T * 512;
  p.rr = c; p.rk2 = c + a512; p.rv = c + 2 * a512; p.rkk = c + 3 * a512; p.rbb = c + 4 * a512; p.rg = c + 5 * a512; p.rlw = c + 6 * a512;
  p.u8 = (unsigned char*)regC;
  p.v8 = p.u8 + (size_t)16384 * 1024;
  static int grid_blocks = 0;
  if (!grid_blocks) {
    int dev = 0, cus = 0, per_cu = 0;
    (void)hipGetDevice(&dev);
    (void)hipDeviceGetAttribute(&cus, hipDeviceAttributeMultiprocessorCount, dev);
    (void)hipOccupancyMaxActiveBlocksPerMultiprocessor(&per_cu, k_mega, NTHR, 0);
    if (per_cu > 2) per_cu = 2;
    grid_blocks = cus * per_cu;
  }
  (void)hipMemsetAsync(p.bar, 0, zero_bytes, stream);
  void* args[] = {&p};
  hipError_t e = hipLaunchCooperativeKernel((void*)k_mega, dim3(grid_blocks), dim3(NTHR), args, 0, stream);
  if (e != hipSuccess) fprintf(stderr, "cooperative launch failed: %s (grid %d)\n", hipGetErrorString(e), grid_blocks);
}
```

```cpp
#include <hip/hip_runtime.h>
#include <hip/hip_cooperative_groups.h>
#include <stdint.h>
#include <stdio.h>
#include <math.h>

constexpr int NB_ = 8, SEQ = 2048, NM = 16, L = 2064, T = NB_ * L, TR = NB_ * SEQ, D = 1024, DIN = 2240;
constexpr int NTHR = 256;
constexpr float RMS_EPS = 1e-6f;
typedef unsigned short bf16_t;
namespace cg = cooperative_groups;

struct Params {
  const float *x, *meta, *g_mix, *w_in, *g_q, *w_uq, *g_kv, *w_ukv, *g_out, *mu, *w0, *w_up, *a0, *a_up, *g_up,
      *k_k, *k_a, *r_k, *ln_w, *ln_b, *w_out, *g_ffn, *w_q, *subk, *pu, *pv, *g_fin;
  float* out;
  float *rstd1;
  float *ossq;
  float *h2ss;
  bf16_t* proj;
  bf16_t *qf, *kn, *vt, *kr;
  float *ropec, *ropes;
  bf16_t *rr, *rk2, *rv, *rkk, *rbb, *rg, *rlw;
  unsigned char *cd_ah, *cd_qm, *cd_bk, *cd_wt, *cd_zt, *cd_vb;
  float* cd_gc;
  bf16_t* h2b;
  int* pidx;
  float* pgate;
  unsigned* bar;
  int never;
  int pad0;
  bf16_t* hb;
  unsigned char *u8, *v8;
  bf16_t *w_inT, *w_uqT, *w_ukvT, *w_outT, *w_qT;
  bf16_t *w_qb;
  bf16_t *subkb;
  bf16_t *w_lrT;
};

typedef float f32x2_cv __attribute__((ext_vector_type(2)));
typedef __bf16 bf16x2_cv __attribute__((ext_vector_type(2)));
__device__ __forceinline__ unsigned pk2bf(float a, float b) {
  const f32x2_cv v = {a, b};
  return __builtin_bit_cast(unsigned, __builtin_convertvector(v, bf16x2_cv));
}
__device__ __forceinline__ bf16_t f2bf(float f) { return (bf16_t)(pk2bf(f, 0.0f) & 0xffffu); }
__device__ __forceinline__ float bf2f(bf16_t h) { return __uint_as_float(((unsigned)h) << 16); }
__device__ __forceinline__ float wave_sum(float v) {
#pragma unroll
  for (int o = 32; o > 0; o >>= 1) v += __shfl_xor(v, o, 64);
  return v;
}
__device__ __forceinline__ const float* hrow(const Params& p, int tt) {
  int b = tt / L, pos = tt - b * L;
  return pos < NM ? p.meta + (size_t)pos * D : p.x + ((size_t)(b * SEQ + pos - NM)) * D;
}
__device__ __forceinline__ int rt2tt(int rt) { return (rt >> 11) * L + NM + (rt & 2047); }

template <class AF, class BF, class EF>
__device__ __forceinline__ void gemm_naive(int M, int N, int K, AF af, BF bf, EF ef, int bid, int nb) {
  const int ncb = (N + 255) / 256;
  const int ntiles = (M / 8) * ncb;
  for (int tile = bid; tile < ntiles; tile += nb) {
    const int r0 = (tile / ncb) * 8;
    const int n = (tile % ncb) * 256 + threadIdx.x;
    if (n < N) {
      float a0 = 0, a1 = 0, a2 = 0, a3 = 0, a4 = 0, a5 = 0, a6 = 0, a7 = 0;
      for (int k = 0; k < K; ++k) {
        const float bv = bf(k, n);
        a0 += af(r0 + 0, k) * bv; a1 += af(r0 + 1, k) * bv; a2 += af(r0 + 2, k) * bv; a3 += af(r0 + 3, k) * bv;
        a4 += af(r0 + 4, k) * bv; a5 += af(r0 + 5, k) * bv; a6 += af(r0 + 6, k) * bv; a7 += af(r0 + 7, k) * bv;
      }
      ef(r0 + 0, n, a0); ef(r0 + 1, n, a1); ef(r0 + 2, n, a2); ef(r0 + 3, n, a3);
      ef(r0 + 4, n, a4); ef(r0 + 5, n, a5); ef(r0 + 6, n, a6); ef(r0 + 7, n, a7);
    }
  }
}


typedef __attribute__((ext_vector_type(8))) short bf16x8;
typedef __attribute__((ext_vector_type(4))) float f32x4;
typedef __attribute__((ext_vector_type(4))) unsigned u32x4;
typedef __attribute__((ext_vector_type(2))) float f32x2;
typedef __attribute__((ext_vector_type(4))) short bf16x4;
typedef __attribute__((ext_vector_type(2))) unsigned u32x2;
constexpr int NCH = 129;

__device__ __forceinline__ uint2 pack4bf(float a, float b, float c, float d) {
  uint2 r;
  r.x = pk2bf(a, b);
  r.y = pk2bf(c, d);
  return r;
}

__device__ __forceinline__ bf16x4 pk4(const f32x4 v) {
  const uint2 t = pack4bf(v[0], v[1], v[2], v[3]);
  u32x2 u; u[0] = t.x; u[1] = t.y;
  return __builtin_bit_cast(bf16x4, u);
}
__device__ __forceinline__ f32x4 unpk4(const u32x2 u) {
  f32x4 r;
  r[0] = __uint_as_float(u[0] << 16); r[1] = __uint_as_float(u[0] & 0xffff0000u);
  r[2] = __uint_as_float(u[1] << 16); r[3] = __uint_as_float(u[1] & 0xffff0000u);
  return r;
}
#define MFMA16(a, b, c) __builtin_amdgcn_mfma_f32_16x16x16bf16_1k(a, b, c, 0, 0, 0)
#define MFMA32(a, b, c) __builtin_amdgcn_mfma_f32_16x16x32_bf16(a, b, c, 0, 0, 0)

__device__ __forceinline__ float dpp_sum8(float v) {
  v += __int_as_float(__builtin_amdgcn_update_dpp(0, __float_as_int(v), 0xB1, 0xF, 0xF, true));
  v += __int_as_float(__builtin_amdgcn_update_dpp(0, __float_as_int(v), 0x4E, 0xF, 0xF, true));
  v += __int_as_float(__builtin_amdgcn_update_dpp(0, __float_as_int(v), 0x141, 0xF, 0xF, true));
  return v;
}
__device__ __forceinline__ float tr_reduce16(const float (&pd)[16], int lane) {
  const bool b5 = lane & 32, b4 = lane & 16, b3 = lane & 8, b2 = lane & 4;
  float q8[8], q4[4], q2[2], q1;
#pragma unroll
  for (int i = 0; i < 8; ++i) { const float sd = b5 ? pd[i] : pd[i + 8], kp = b5 ? pd[i + 8] : pd[i]; q8[i] = kp + __shfl_xor(sd, 32, 64); }
#pragma unroll
  for (int i = 0; i < 4; ++i) { const float sd = b4 ? q8[i] : q8[i + 4], kp = b4 ? q8[i + 4] : q8[i]; q4[i] = kp + __shfl_xor(sd, 16, 64); }
#pragma unroll
  for (int i = 0; i < 2; ++i) { const float sd = b3 ? q4[i] : q4[i + 2], kp = b3 ? q4[i + 2] : q4[i]; q2[i] = kp + __shfl_xor(sd, 8, 64); }
  { const float sd = b2 ? q2[0] : q2[1], kp = b2 ? q2[1] : q2[0]; q1 = kp + __shfl_xor(sd, 4, 64); }
  q1 += __shfl_xor(q1, 2, 64);
  q1 += __shfl_xor(q1, 1, 64);
  return q1;
}

struct NoMid { __device__ __forceinline__ void operator()(int, f32x4 (&)[4][4]) const {} };
template <bool TRANS, bool ZERO = true, bool SPLITA = false, class ALoad, class BLoad, class Mid = NoMid>
__device__ __forceinline__ void gemm_tile(char* smem, int m0, int n0, int kt0, int kt1, ALoad aload, BLoad bload, f32x4 (&acc)[4][4], Mid mid = Mid()) {
  const int tid = threadIdx.x, lane = tid & 63, w = tid >> 6, wm = w >> 1, wn = w & 1;
  const int srow = tid >> 3, sslot = tid & 7;
  const int swz = (sslot ^ (srow & 7)) << 4;
  char* sA = smem;
  char* sB = smem + 32768;
  const int g = lane >> 4, r16 = lane & 15;
  const int fa0 = (wm * 64 + r16) * 128 + (((0 + g) ^ (lane & 7)) << 4);
  const int fa1 = (wm * 64 + r16) * 128 + (((4 + g) ^ (lane & 7)) << 4);
  const int fb0 = (wn * 64 + r16) * 128 + (((0 + g) ^ (lane & 7)) << 4);
  const int fb1 = (wn * 64 + r16) * 128 + (((4 + g) ^ (lane & 7)) << 4);
  u32x4 ra[4], rb[4];
#pragma unroll
  for (int i = 0; i < 4; ++i) {
    ra[i] = aload(m0 + srow + 32 * i, kt0 * 64 + sslot * 8, i);
    rb[i] = bload(n0 + srow + 32 * i, kt0 * 64 + sslot * 8);
  }
  if constexpr (ZERO) {
#pragma unroll
    for (int i = 0; i < 4; ++i)
#pragma unroll
      for (int j = 0; j < 4; ++j) acc[i][j] = (f32x4){0.f, 0.f, 0.f, 0.f};
  }
  __syncthreads();
#pragma unroll
  for (int i = 0; i < 4; ++i) {
    *reinterpret_cast<u32x4*>(sA + (srow + 32 * i) * 128 + swz) = ra[i];
    *reinterpret_cast<u32x4*>(sB + (srow + 32 * i) * 128 + swz) = rb[i];
  }
  __syncthreads();
  for (int kt = kt0; kt < kt1; ++kt) {
    const int cur = ((kt - kt0) & 1) * 16384;
    mid(kt, acc);
    if (kt + 1 < kt1) {
#pragma unroll
      for (int i = 0; i < 4; ++i) {
        if (!SPLITA || i < 2) ra[i] = aload(m0 + srow + 32 * i, (kt + 1) * 64 + sslot * 8, i);
        rb[i] = bload(n0 + srow + 32 * i, (kt + 1) * 64 + sslot * 8);
      }
    }
#pragma unroll
    for (int ks = 0; ks < 2; ++ks) {
      if (SPLITA && ks == 1 && kt + 1 < kt1) {
#pragma unroll
        for (int i = 2; i < 4; ++i) ra[i] = aload(m0 + srow + 32 * i, (kt + 1) * 64 + sslot * 8, i);
      }
      bf16x8 af[4], bfr[4];
#pragma unroll
      for (int i = 0; i < 4; ++i) af[i] = *reinterpret_cast<const bf16x8*>(sA + cur + (ks ? fa1 : fa0) + i * 2048);
#pragma unroll
      for (int j = 0; j < 4; ++j) bfr[j] = *reinterpret_cast<const bf16x8*>(sB + cur + (ks ? fb1 : fb0) + j * 2048);
#pragma unroll
      for (int i = 0; i < 4; ++i)
#pragma unroll
        for (int j = 0; j < 4; ++j) {
          if constexpr (TRANS) acc[i][j] = __builtin_amdgcn_mfma_f32_16x16x32_bf16(bfr[j], af[i], acc[i][j], 0, 0, 0);
          else acc[i][j] = __builtin_amdgcn_mfma_f32_16x16x32_bf16(af[i], bfr[j], acc[i][j], 0, 0, 0);
        }
    }
    if (kt + 1 < kt1) {
      const int nxt = 16384 - cur;
#pragma unroll
      for (int i = 0; i < 4; ++i) {
        *reinterpret_cast<u32x4*>(sA + nxt + (srow + 32 * i) * 128 + swz) = ra[i];
        *reinterpret_cast<u32x4*>(sB + nxt + (srow + 32 * i) * 128 + swz) = rb[i];
      }
    }
    __syncthreads();
  }
}
#define GLDS16(gp, lp) __builtin_amdgcn_global_load_lds((const __attribute__((address_space(1))) void*)(gp), (__attribute__((address_space(3))) void*)(lp), 16, 0, 0)
template <bool TRANS, class APtr, class BPtr, class Mid = NoMid>
__device__ __forceinline__ void gemm_tile_glds(char* smem, int m0, int n0, int nk32, APtr aptr, BPtr bptr, f32x4 (&acc)[4][4], Mid mid = Mid()) {
  const int tid = threadIdx.x, lane = tid & 63, w = tid >> 6, wm = w >> 1, wn = w & 1;
  const int lrow = lane >> 2;
  const int schunk = ((lane & 3) ^ ((lrow >> 2) & 3)) * 8;
  const int wb = (__builtin_amdgcn_readfirstlane(tid) >> 6);
  const int g = lane >> 4, r16 = lane & 15;
  const int fsl = (g ^ ((r16 >> 2) & 3)) << 4;
  const int fa = (wm * 64 + r16) * 64 + fsl;
  const int fb = 8192 + (wn * 64 + r16) * 64 + fsl;
#pragma unroll
  for (int i = 0; i < 4; ++i)
#pragma unroll
    for (int j = 0; j < 4; ++j) acc[i][j] = (f32x4){0.f, 0.f, 0.f, 0.f};
  __syncthreads();
  auto issue = [&](int kt) {
    char* st = smem + (kt & 3) * 16384;
#pragma unroll
    for (int i = 0; i < 2; ++i) {
      const int row = 16 * wb + 64 * i + lrow;
      GLDS16(aptr(m0 + row, kt * 32 + schunk), st + (16 * wb + 64 * i) * 64);
      GLDS16(bptr(n0 + row, kt * 32 + schunk), st + 8192 + (16 * wb + 64 * i) * 64);
    }
  };
  issue(0);
  if (nk32 > 1) issue(1);
  if (nk32 > 2) issue(2);
  __builtin_amdgcn_s_setprio(1);
  for (int kt = 0; kt < nk32; ++kt) {
    if (kt + 2 < nk32) asm volatile("s_waitcnt vmcnt(8)\n\ts_barrier" ::: "memory");
    else if (kt + 1 < nk32) asm volatile("s_waitcnt vmcnt(4)\n\ts_barrier" ::: "memory");
    else asm volatile("s_waitcnt vmcnt(0)\n\ts_barrier" ::: "memory");
    if (kt + 3 < nk32) issue(kt + 3);
    mid(kt, acc);
    const char* st = smem + (kt & 3) * 16384;
    bf16x8 af[4], bfr[4];
#pragma unroll
    for (int i = 0; i < 4; ++i) af[i] = *reinterpret_cast<const bf16x8*>(st + fa + i * 1024);
#pragma unroll
    for (int j = 0; j < 4; ++j) bfr[j] = *reinterpret_cast<const bf16x8*>(st + fb + j * 1024);
#pragma unroll
    for (int i = 0; i < 4; ++i)
#pragma unroll
      for (int j = 0; j < 4; ++j) {
        if constexpr (TRANS) acc[i][j] = __builtin_amdgcn_mfma_f32_16x16x32_bf16(bfr[j], af[i], acc[i][j], 0, 0, 0);
        else acc[i][j] = __builtin_amdgcn_mfma_f32_16x16x32_bf16(af[i], bfr[j], acc[i][j], 0, 0, 0);
      }
  }
  __builtin_amdgcn_s_setprio(0);
  __syncthreads();
}
struct NoMidW { __device__ __forceinline__ void operator()(int, f32x4 (&)[4][8]) const {} };
template <class APtr, class BPtr, class Mid = NoMidW>
__device__ __forceinline__ void gemm_tile_wide(char* smem, int m0, int n0, int nk32, APtr aptr, BPtr bptr, f32x4 (&acc)[4][8], Mid mid = Mid()) {
  const int tid = threadIdx.x, lane = tid & 63, w = tid >> 6, wm = w >> 1, wn = w & 1;
  const int lrow = lane >> 2;
  const int schunk = ((lane & 3) ^ ((lrow >> 2) & 3)) * 8;
  const int wb = (__builtin_amdgcn_readfirstlane(tid) >> 6);
  const int g = lane >> 4, r16 = lane & 15;
  const int fsl = (g ^ ((r16 >> 2) & 3)) << 4;
  const int fa = (wm * 64 + r16) * 64 + fsl;
  const int fb = 8192 + (wn * 128 + r16) * 64 + fsl;
#pragma unroll
  for (int i = 0; i < 4; ++i)
#pragma unroll
    for (int j = 0; j < 8; ++j) acc[i][j] = (f32x4){0.f, 0.f, 0.f, 0.f};
  __syncthreads();
  auto issue = [&](int kt) {
    char* st = smem + (kt % 3) * 24576;
#pragma unroll
    for (int i = 0; i < 2; ++i) GLDS16(aptr(m0 + 16 * wb + 64 * i + lrow, kt * 32 + schunk), st + (16 * wb + 64 * i) * 64);
#pragma unroll
    for (int i = 0; i < 4; ++i) GLDS16(bptr(n0 + 16 * wb + 64 * i + lrow, kt * 32 + schunk), st + 8192 + (16 * wb + 64 * i) * 64);
  };
  issue(0);
  if (nk32 > 1) issue(1);
  __builtin_amdgcn_s_setprio(1);
  for (int kt = 0; kt < nk32; ++kt) {
    if (kt + 1 < nk32) asm volatile("s_waitcnt vmcnt(6)\n\ts_barrier" ::: "memory");
    else asm volatile("s_waitcnt vmcnt(0)\n\ts_barrier" ::: "memory");
    if (kt + 2 < nk32) issue(kt + 2);
    mid(kt, acc);
    const char* st = smem + (kt % 3) * 24576;
    bf16x8 af[4], bfr[8];
#pragma unroll
    for (int i = 0; i < 4; ++i) af[i] = *reinterpret_cast<const bf16x8*>(st + fa + i * 1024);
#pragma unroll
    for (int j = 0; j < 8; ++j) bfr[j] = *reinterpret_cast<const bf16x8*>(st + fb + j * 1024);
#pragma unroll
    for (int i = 0; i < 4; ++i)
#pragma unroll
      for (int j = 0; j < 8; ++j) acc[i][j] = __builtin_amdgcn_mfma_f32_16x16x32_bf16(bfr[j], af[i], acc[i][j], 0, 0, 0);
  }
  __builtin_amdgcn_s_setprio(0);
  __syncthreads();
}
__device__ __forceinline__ void stage_acc_half(char* smem, const f32x4 (&acc)[4][8], int half) {
  const int lane = threadIdx.x & 63, w = threadIdx.x >> 6, wm = w >> 1, wn = w & 1, g = lane >> 4, r16 = lane & 15;
  float* Et = reinterpret_cast<float*>(smem);
  __syncthreads();
  if (wn == half) {
#pragma unroll
    for (int i = 0; i < 4; ++i)
#pragma unroll
      for (int j = 0; j < 8; ++j)
        *reinterpret_cast<f32x4*>(Et + (wm * 64 + 16 * i + r16) * 132 + 16 * j + 4 * g) = acc[i][j];
  }
  __syncthreads();
}
template <class Body>
__device__ __forceinline__ void for_tiles_xcd(int MT, int NT, int bid, int nb, Body body, int rshift = 0) {
  if (nb & 7) {
    for (int e = bid; e < MT * NT; e += nb) body(e / NT, e % NT);
    return;
  }
  const int x = bid & 7, lb = bid >> 3, nlb = nb >> 3;
  const int mper = (MT >> 3) & ~3;
  const int main_cnt = mper * NT;
  for (int q = lb; q < main_cnt; q += nlb) {
    const int patch = q / (4 * NT), r = q - patch * (4 * NT);
    body(x * mper + patch * 4 + (r & 3), r >> 2);
  }
  const int rem = (MT - 8 * mper) * NT;
  const int rb = ((nb - 1 - bid - rshift) % nb + nb) % nb;
  for (int e = rb; e < rem; e += nb) body(8 * mper + e / NT, e % NT);
}
__device__ __forceinline__ void st8f(bf16_t* dst, const float (&v)[8]) {
  u32x4 w;
#pragma unroll
  for (int e = 0; e < 4; ++e) w[e] = pk2bf(v[2 * e], v[2 * e + 1]);
  *reinterpret_cast<u32x4*>(dst) = w;
}
__device__ __forceinline__ void stage_acc(char* smem, const f32x4 (&acc)[4][4]) {
  const int lane = threadIdx.x & 63, w = threadIdx.x >> 6, wm = w >> 1, wn = w & 1, g = lane >> 4, r16 = lane & 15;
  float* Et = reinterpret_cast<float*>(smem);
#pragma unroll
  for (int i = 0; i < 4; ++i)
#pragma unroll
    for (int j = 0; j < 4; ++j)
      *reinterpret_cast<f32x4*>(Et + (wm * 64 + 16 * i + r16) * 132 + wn * 64 + 16 * j + 4 * g) = acc[i][j];
  __syncthreads();
}
__device__ __forceinline__ void ld8(const char* smem, int row, int col8, float (&v)[8]) {
  const float* Et = reinterpret_cast<const float*>(smem);
  const f32x4 a = *reinterpret_cast<const f32x4*>(Et + row * 132 + col8), b = *reinterpret_cast<const f32x4*>(Et + row * 132 + col8 + 4);
#pragma unroll
  for (int e = 0; e < 4; ++e) { v[e] = a[e]; v[4 + e] = b[e]; }
}
__device__ __forceinline__ float sumsq8(const u32x4 v) {
  float s = 0.f;
#pragma unroll
  for (int q = 0; q < 4; ++q) {
    const float lo = __uint_as_float(v[q] << 16), hi = __uint_as_float(v[q] & 0xffff0000u);
    s += lo * lo + hi * hi;
  }
  return s;
}
__device__ __forceinline__ void rowss_publish(float* rowss, const float (&ss)[4]) {
  const int srow = threadIdx.x >> 3, sslot = threadIdx.x & 7;
#pragma unroll
  for (int i = 0; i < 4; ++i) {
    float v = ss[i];
    v += __shfl_xor(v, 1, 64); v += __shfl_xor(v, 2, 64); v += __shfl_xor(v, 4, 64);
    if (sslot == 0) rowss[srow + 32 * i] = v;
  }
  __syncthreads();
}
template <bool TRANS, class ARow, class BRow, class Epi>
__device__ __forceinline__ void gemm_bf16(char* smem, int mtiles, int N, int K, ARow arow, BRow brow,
                                          Epi epi, int bid, int nb) {
  const int lane = threadIdx.x & 63, w = threadIdx.x >> 6, wm = w >> 1, wn = w & 1, g = lane >> 4, r16 = lane & 15;
  const int ntn = (N + 127) >> 7;
  for (int tile = bid; tile < mtiles * ntn; tile += nb) {
    const int tm = tile / ntn, tn = tile - tm * ntn;
    const int m0 = tm * 128, n0 = tn * 128;
    f32x4 acc[4][4];
    gemm_tile<TRANS>(smem, m0, n0, 0, K >> 6,
        [&](int r, int k, int) { return *reinterpret_cast<const u32x4*>(arow(r) + k); },
        [&](int n, int k) { return *reinterpret_cast<const u32x4*>(brow(min(n, N - 1)) + k); }, acc);
    if constexpr (TRANS) epi(acc, m0 + wm * 64 + r16, n0 + wn * 64 + 4 * g);
    else epi(acc, m0 + wm * 64 + 4 * g, n0 + wn * 64 + r16);
  }
}

__device__ __forceinline__ void wtrans(const float* __restrict__ W, const float* __restrict__ gk, int K, int N, bf16_t* out,
                                       int gtid, int gthreads, int glim = 1 << 30) {
  const int total = N * (K >> 3);
#pragma unroll 2
  for (int idx = gtid; idx < total; idx += gthreads) {
    const int n = idx % N, kc = idx / N;
    float v[8];
#pragma unroll
    for (int i = 0; i < 8; ++i) {
      const int k = kc * 8 + i;
      v[i] = W[(size_t)k * N + n] * ((gk && k < glim) ? gk[k] : 1.0f);
    }
    uint4 o;
    uint2 lo = pack4bf(v[0], v[1], v[2], v[3]), hi = pack4bf(v[4], v[5], v[6], v[7]);
    o.x = lo.x; o.y = lo.y; o.z = hi.x; o.w = hi.y;
    *reinterpret_cast<uint4*>(out + (size_t)n * K + kc * 8) = o;
  }
}

__device__ __forceinline__ void ph_prep(const Params& p, int bid, int nb) {
  const int lane = threadIdx.x & 63, wv = threadIdx.x >> 6;
#pragma unroll 4
  for (int tt = bid * 4 + wv; tt < T; tt += nb * 4) {
    const float4* hr = reinterpret_cast<const float4*>(hrow(p, tt));
    float s = 0;
#pragma unroll
    for (int j = 0; j < 4; ++j) {
      const f32x4 v = __builtin_nontemporal_load(reinterpret_cast<const f32x4*>(hr) + j * 64 + lane);
      s += v[0] * v[0] + v[1] * v[1] + v[2] * v[2] + v[3] * v[3];
      *reinterpret_cast<uint2*>(p.hb + (size_t)tt * D + (j * 64 + lane) * 4) = pack4bf(v[0], v[1], v[2], v[3]);
    }
    s = wave_sum(s);
    if (lane == 0) p.rstd1[tt] = rsqrtf(s * (1.0f / D) + RMS_EPS);
  }
  const int gtid = bid * NTHR + threadIdx.x, gth = nb * NTHR;
  for (int e = gtid; e < L * 32; e += gth) {
    const int i = e & 31, pos = e >> 5;
    const float inv = exp2f(-(float)i * (13.287712379549449f / 32.0f));
    float sn, cs; sincosf((float)pos * inv, &sn, &cs);
    p.ropec[e] = cs; p.ropes[e] = sn;
  }
  wtrans(p.w_in, p.g_mix, 1024, DIN, p.w_inT, gtid, gth);
  wtrans(p.w_uq, p.g_q, 256, 768, p.w_uqT, gtid, gth);
  wtrans(p.w_ukv, p.g_kv, 128, 1024, p.w_ukvT, gtid, gth);
  wtrans(p.w_out, p.g_out, 1024, 1024, p.w_outT, gtid, gth, 512);
#pragma unroll 4
  for (int e = gtid; e < 1024 * 2048 / 4; e += gth) {
    const f32x4 v = *reinterpret_cast<const f32x4*>(p.w_q + (size_t)e * 4);
    *reinterpret_cast<uint2*>(p.w_qb + (size_t)e * 4) = pack4bf(v[0], v[1], v[2], v[3]);
  }
#pragma unroll 2
  for (int e = gtid; e < 8 * 2 * 128 * 128 / 4; e += gth) {
    const f32x4 v = *reinterpret_cast<const f32x4*>(p.subk + (size_t)e * 4);
    *reinterpret_cast<uint2*>(p.subkb + (size_t)e * 4) = pack4bf(v[0], v[1], v[2], v[3]);
  }
#pragma unroll 2
  for (int e = gtid; e < 1536 * 128; e += gth) {
    const int n = e >> 7, k = e & 127;
    float v = 0.f;
    if (n < 512) { if (k < 64) v = p.w_up[k * 512 + n]; }
    else if (n < 1024) { if (k < 64) v = p.a_up[k * 512 + n - 512]; }
    else v = p.g_up[k * 512 + n - 1024];
    p.w_lrT[e] = f2bf(v);
  }
}
template <bool RS_LDS>
__device__ __forceinline__ void inproj_epilogue(const Params& p, const char* smem, int m0, int n0, const float (&rsq)[8]) {
  const float* rsl = reinterpret_cast<const float*>(smem + 128 * 132 * 4);
#pragma unroll 2
  for (int q = 0; q < 8; ++q) {
    const int c = threadIdx.x + 256 * q;
    const int row = c >> 4, col8 = (c & 15) * 8;
    const int m = m0 + row, n = n0 + col8;
    const float rs = RS_LDS ? rsl[row] : rsq[q];
    float v[8];
    ld8(smem, row, col8, v);
    if (n0 == 384 && col8 < 64) {
      if (col8 < 32) {
        float v2[8], y1[8], y2[8];
        ld8(smem, row, col8 + 32, v2);
        const int pos = m % L;
        const f32x4 c0 = *reinterpret_cast<const f32x4*>(p.ropec + pos * 32 + col8), c1 = *reinterpret_cast<const f32x4*>(p.ropec + pos * 32 + col8 + 4);
        const f32x4 s0 = *reinterpret_cast<const f32x4*>(p.ropes + pos * 32 + col8), s1 = *reinterpret_cast<const f32x4*>(p.ropes + pos * 32 + col8 + 4);
#pragma unroll
        for (int e = 0; e < 8; ++e) {
          const float cs = e < 4 ? c0[e] : c1[e - 4], sn = e < 4 ? s0[e] : s1[e - 4];
          const float x1 = v[e] * rs, x2 = v2[e] * rs;
          y1[e] = x1 * cs - x2 * sn; y2[e] = x1 * sn + x2 * cs;
        }
        st8f(p.kr + (size_t)m * 64 + col8, y1);
        st8f(p.kr + (size_t)m * 64 + 32 + col8, y2);
      }
    } else if (n < DIN) {
#pragma unroll
      for (int e = 0; e < 8; ++e) v[e] *= rs;
      st8f(p.proj + (size_t)m * DIN + n, v);
    }
  }
}
__device__ __forceinline__ void inproj_tile_narrow(const Params& p, char* smem, int tm, int tn) {
  const int m0 = tm * 128, n0 = tn * 128;
  f32x4 acc[4][4];
  gemm_tile_glds<true>(smem, m0, n0, 32,
      [&](int r, int k) { return p.hb + (size_t)r * D + k; },
      [&](int n, int k) { return p.w_inT + (size_t)min(n, DIN - 1) * 1024 + k; }, acc);
  float rsq[8];
#pragma unroll
  for (int q = 0; q < 8; ++q) rsq[q] = p.rstd1[m0 + ((threadIdx.x + 256 * q) >> 4)];
  stage_acc(smem, acc);
  inproj_epilogue<false>(p, smem, m0, n0, rsq);
}
__device__ __forceinline__ void inproj_tile_wide(const Params& p, char* smem, int tm, int tw) {
  const int m0 = tm * 128, n0 = tw * 256;
  f32x4 acc[4][8];
  gemm_tile_wide(smem, m0, n0, 32,
      [&](int r, int k) { return p.hb + (size_t)r * D + k; },
      [&](int n, int k) { return p.w_inT + (size_t)n * 1024 + k; }, acc);
  const float rsmine = p.rstd1[m0 + (threadIdx.x & 127)];
  const float rsq[8] = {0.f, 0.f, 0.f, 0.f, 0.f, 0.f, 0.f, 0.f};
#pragma unroll 1
  for (int half = 0; half < 2; ++half) {
    stage_acc_half(smem, acc, half);
    if (half == 0) { if (threadIdx.x < 128) reinterpret_cast<float*>(smem + 128 * 132 * 4)[threadIdx.x] = rsmine; __syncthreads(); }
    inproj_epilogue<true>(p, smem, m0, n0 + 128 * half, rsq);
  }
}
__device__ __forceinline__ void ph_inproj(const Params& p, char* smem, int bid, int nb) {
  if (nb != 512) {
    for_tiles_xcd(T / 128, (DIN + 127) >> 7, bid, nb, [&](int tm, int tn) { inproj_tile_narrow(p, smem, tm, tn); });
    return;
  }
  const int x = bid & 7, lb = bid >> 3;
#pragma unroll 1
  for (int q = lb; q < 128; q += 64) {
    const int patch = q >> 5, r = q & 31;
    inproj_tile_wide(p, smem, x * 16 + patch * 4 + (r & 3), r >> 2);
  }
  if (lb < 32) inproj_tile_narrow(p, smem, x * 16 + (lb & 15), 16 + (lb >> 4));
  const int rb = nb - 1 - bid;
  if (rb < 18) inproj_tile_narrow(p, smem, 128, rb);
}
__device__ __forceinline__ void ph_w2(const Params& p, char* smem, int bid, int nb) {
  for (int e = bid; e < 128; e += nb) {
    const int hc = e >> 3, n0 = (e & 7) * 128;
    f32x4 acc[4][4];
    gemm_tile_glds<true>(smem, 0, n0, 4,
        [&](int r, int k) { return p.subkb + ((size_t)hc * 128 + r) * 128 + k; },
        [&](int n, int k) { return p.w_qb + (size_t)n * 2048 + hc * 128 + k; }, acc);
    stage_acc(smem, acc);
#pragma unroll 2
    for (int q = 0; q < 8; ++q) {
      const int c = threadIdx.x + 256 * q;
      const int row = c >> 4, col8 = (c & 15) * 8;
      float v[8];
      ld8(smem, row, col8, v);
      const f32x4 g0 = *reinterpret_cast<const f32x4*>(p.g_ffn + n0 + col8), g1 = *reinterpret_cast<const f32x4*>(p.g_ffn + n0 + col8 + 4);
#pragma unroll
      for (int e2 = 0; e2 < 8; ++e2) v[e2] *= e2 < 4 ? g0[e2] : g1[e2 - 4];
      st8f(p.w_qT + ((size_t)hc * 128 + row) * 1024 + n0 + col8, v);
    }
  }
}
__device__ __forceinline__ void ph_q_up(const Params& p, char* smem, int bid, int nb) {
  const int lane = threadIdx.x & 63, w = threadIdx.x >> 6, wm = w >> 1, wn = w & 1, g = lane >> 4, r16 = lane & 15;
  float* rowss = reinterpret_cast<float*>(smem);
  for_tiles_xcd(T / 128, 6, bid, nb, [&](int tm, int tn) {
    const int m0 = tm * 128, n0 = tn * 128;
    f32x4 acc[4][4];
    float ss[4] = {0.f, 0.f, 0.f, 0.f};
    gemm_tile<true>(smem, m0, n0, 0, 4,
        [&](int r, int k, int i) { const u32x4 v = *reinterpret_cast<const u32x4*>(p.proj + (size_t)r * DIN + k); ss[i] += sumsq8(v); return v; },
        [&](int n, int k) { return *reinterpret_cast<const u32x4*>(p.w_uqT + (size_t)n * 256 + k); }, acc);
    float rsum[4];
#pragma unroll
    for (int i = 0; i < 4; ++i) {
      float v = ss[i];
      v += __shfl_xor(v, 1, 64); v += __shfl_xor(v, 2, 64); v += __shfl_xor(v, 4, 64);
      rsum[i] = v;
    }
    stage_acc(smem, acc);
    float* rowss2 = reinterpret_cast<float*>(smem + 128 * 132 * 4);
    if ((threadIdx.x & 7) == 0) {
#pragma unroll
      for (int i = 0; i < 4; ++i) rowss2[(threadIdx.x >> 3) + 32 * i] = rsum[i];
    }
    __syncthreads();
#pragma unroll 2
    for (int q = 0; q < 8; ++q) {
      const int c = threadIdx.x + 256 * q;
      const int row = c >> 4, col8 = (c & 15) * 8;
      const int m = m0 + row, n = n0 + col8;
      const float rs = rsqrtf(rowss2[row] * (1.0f / 256) + RMS_EPS) * (0.07216878364870322f * 1.4426950408889634f);
      const int off = n % 192;
      float v[8];
      ld8(smem, row, col8, v);
      if (off >= 128) {
        if (off < 160) {
          float v2[8], y1[8], y2[8];
          ld8(smem, row, col8 + 32, v2);
          const int pos = m % L, ii = off - 128;
          const f32x4 c0 = *reinterpret_cast<const f32x4*>(p.ropec + pos * 32 + ii), c1 = *reinterpret_cast<const f32x4*>(p.ropec + pos * 32 + ii + 4);
          const f32x4 s0 = *reinterpret_cast<const f32x4*>(p.ropes + pos * 32 + ii), s1 = *reinterpret_cast<const f32x4*>(p.ropes + pos * 32 + ii + 4);
#pragma unroll
          for (int e = 0; e < 8; ++e) {
            const float cs = e < 4 ? c0[e] : c1[e - 4], sn = e < 4 ? s0[e] : s1[e - 4];
            const float x1 = v[e] * rs, x2 = v2[e] * rs;
            y1[e] = x1 * cs - x2 * sn; y2[e] = x1 * sn + x2 * cs;
          }
          st8f(p.qf + (size_t)m * 768 + n, y1);
          st8f(p.qf + (size_t)m * 768 + n + 32, y2);
        }
      } else {
#pragma unroll
        for (int e = 0; e < 8; ++e) v[e] *= rs;
        st8f(p.qf + (size_t)m * 768 + n, v);
      }
    }
  }, 12);
}
__device__ __forceinline__ void ph_kv_up(const Params& p, char* smem, int bid, int nb) {
  const int lane = threadIdx.x & 63, w = threadIdx.x >> 6, wm = w >> 1, wn = w & 1, g = lane >> 4, r16 = lane & 15;
  float* rowss = reinterpret_cast<float*>(smem);
  for_tiles_xcd(T / 128, 8, bid, nb, [&](int tm, int tn) {
    const bool vpart = tn >= 4;
    const int m0 = tm * 128, n0 = (tn & 3) * 128;
    f32x4 acc[4][4];
    float ss[4] = {0.f, 0.f, 0.f, 0.f};
    auto al = [&](int r, int k, int i) { const u32x4 v = *reinterpret_cast<const u32x4*>(p.proj + (size_t)r * DIN + 256 + k); ss[i] += sumsq8(v); return v; };
    if (!vpart) {
      gemm_tile<true>(smem, m0, n0, 0, 2, al,
          [&](int n, int k) { return *reinterpret_cast<const u32x4*>(p.w_ukvT + (size_t)((n >> 7) * 256 + (n & 127)) * 128 + k); }, acc);
      float rsum[4];
#pragma unroll
      for (int i = 0; i < 4; ++i) {
        float v = ss[i];
        v += __shfl_xor(v, 1, 64); v += __shfl_xor(v, 2, 64); v += __shfl_xor(v, 4, 64);
        rsum[i] = v;
      }
      stage_acc(smem, acc);
      float* rowss2 = reinterpret_cast<float*>(smem + 128 * 132 * 4);
      if ((threadIdx.x & 7) == 0) {
#pragma unroll
        for (int i = 0; i < 4; ++i) rowss2[(threadIdx.x >> 3) + 32 * i] = rsum[i];
      }
      __syncthreads();
#pragma unroll 2
      for (int q = 0; q < 8; ++q) {
        const int c = threadIdx.x + 256 * q;
        const int row = c >> 4, col8 = (c & 15) * 8;
        const int m = m0 + row, n = n0 + col8;
        const float rs = rsqrtf(rowss2[row] * (1.0f / 128) + RMS_EPS);
        const int b = m / L, pos = m - b * L;
        float v[8];
        ld8(smem, row, col8, v);
#pragma unroll
        for (int e = 0; e < 8; ++e) v[e] *= rs;
        st8f(p.kn + ((size_t)((b * 4 + (n >> 7)) * L + pos)) * 128 + (n & 127), v);
      }
    } else {
      gemm_tile<false>(smem, m0, n0, 0, 2, al,
          [&](int n, int k) { return *reinterpret_cast<const u32x4*>(p.w_ukvT + (size_t)((n >> 7) * 256 + 128 + (n & 127)) * 128 + k); }, acc);
      rowss_publish(rowss, ss);
      const int mb = m0 + wm * 64 + 4 * g, nbase = n0 + wn * 64 + r16;
#pragma unroll
      for (int i = 0; i < 4; ++i) {
        const int m = mb + 16 * i;
        f32x4 rs;
#pragma unroll
        for (int r = 0; r < 4; ++r) rs[r] = rsqrtf(rowss[wm * 64 + 16 * i + 4 * g + r] * (1.0f / 128) + RMS_EPS);
        const int b = m / L, pos = m - b * L;
#pragma unroll
        for (int j = 0; j < 4; ++j) {
          const int n = nbase + 16 * j;
          const int h = n >> 7, dv = n & 127;
          const f32x4 v = acc[i][j] * rs;
          *reinterpret_cast<uint2*>(p.vt + ((size_t)((b * 4 + h) * 128 + dv)) * L + pos) = pack4bf(v[0], v[1], v[2], v[3]);
        }
      }
    }
  }, 18);
}
__device__ __forceinline__ float fast_rcp(float x) { return __builtin_amdgcn_rcpf(x); }
__device__ __forceinline__ float fast_sigmoid(float x) { return fast_rcp(1.0f + __expf(-x)); }
__device__ __forceinline__ float fast_tanh(float x) { return 1.0f - 2.0f * fast_rcp(1.0f + __expf(2.0f * x)); }
__device__ __forceinline__ float lerp_tok(const Params& p, int tt, int pos, int c) {
  const float cur = bf2f(p.proj[(size_t)tt * DIN + 448 + c]);
  const float prev = pos > 0 ? bf2f(p.proj[(size_t)(tt - 1) * DIN + 448 + c]) : 0.0f;
  return cur + p.mu[c] * (prev - cur);
}
__device__ __forceinline__ f32x4 lerp4(const Params& p, int tt, int pos, int c) {
  const f32x4 cur = unpk4(*reinterpret_cast<const u32x2*>(p.proj + (size_t)tt * DIN + 448 + c));
  f32x4 prev = {0.f, 0.f, 0.f, 0.f};
  if (pos > 0) prev = unpk4(*reinterpret_cast<const u32x2*>(p.proj + (size_t)(tt - 1) * DIN + 448 + c));
  const f32x4 m = *reinterpret_cast<const f32x4*>(p.mu + c);
  return cur + m * (prev - cur);
}
__device__ __forceinline__ void ph_rwkv_prep(const Params& p, char* smem, int bid, int nb) {
  const int lane = threadIdx.x & 63, w = threadIdx.x >> 6, wm = w >> 1, wn = w & 1, g = lane >> 4, r16 = lane & 15;
  for_tiles_xcd(T / 128, 12, bid, nb, [&](int tm, int tn) {
    const int kind = tn >> 2, n0 = (tn & 3) * 128;
    const int m0 = tm * 128;
    const int kbase = kind == 0 ? 1536 : (kind == 1 ? 1600 : 1664);
    f32x4 acc[4][4];
    gemm_tile<true>(smem, m0, n0, 0, kind == 2 ? 2 : 1,
        [&](int r, int k, int) {
          const int pos = r % L;
          const u32x4 cu = *reinterpret_cast<const u32x4*>(p.proj + (size_t)r * DIN + 448 + kbase + k);
          u32x4 pv = {0u, 0u, 0u, 0u};
          if (pos > 0) pv = *reinterpret_cast<const u32x4*>(p.proj + (size_t)(r - 1) * DIN + 448 + kbase + k);
          u32x4 o;
#pragma unroll
          for (int q = 0; q < 4; ++q) {
            float c0 = __uint_as_float(cu[q] << 16), c1 = __uint_as_float(cu[q] & 0xffff0000u);
            const float p0 = __uint_as_float(pv[q] << 16), p1 = __uint_as_float(pv[q] & 0xffff0000u);
            c0 += p.mu[kbase + k + 2 * q] * (p0 - c0);
            c1 += p.mu[kbase + k + 2 * q + 1] * (p1 - c1);
            if (kind == 0) { c0 = fast_tanh(c0); c1 = fast_tanh(c1); }
            else if (kind == 2) { c0 = fast_sigmoid(c0); c1 = fast_sigmoid(c1); }
            o[q] = pk2bf(c0, c1);
          }
          return o;
        },
        [&](int n, int k) { return *reinterpret_cast<const u32x4*>(p.w_lrT + (size_t)(kind * 512 + n) * 128 + k); }, acc);
    float* Et = reinterpret_cast<float*>(smem);
#pragma unroll
    for (int i = 0; i < 4; ++i)
#pragma unroll
      for (int j = 0; j < 4; ++j)
        *reinterpret_cast<f32x4*>(Et + (wm * 64 + 16 * i + r16) * 132 + wn * 64 + 16 * j + 4 * g) = acc[i][j];
    __syncthreads();
    const int coloff = kind == 0 ? 0 : (kind == 1 ? 512 : 1024);
    bf16_t* const xdst = kind == 0 ? p.rr : (kind == 1 ? p.rk2 : p.rv);
    bf16_t* const ldst = kind == 0 ? p.rlw : (kind == 1 ? p.rkk : p.rg);
    const int chh = n0 + (threadIdx.x & 15) * 8;
    const f32x4 mu0 = *reinterpret_cast<const f32x4*>(p.mu + coloff + chh), mu1 = *reinterpret_cast<const f32x4*>(p.mu + coloff + chh + 4);
#pragma unroll 1
    for (int qb = 0; qb < 8; qb += 4) {
    u32x4 cuv[4], pvv[4];
#pragma unroll
    for (int qi = 0; qi < 4; ++qi) {
      const int c = threadIdx.x + 256 * (qb + qi);
      const int m = m0 + (c >> 4);
      const bf16_t* pc = p.proj + (size_t)m * DIN + 448 + coloff + n0 + (c & 15) * 8;
      cuv[qi] = *reinterpret_cast<const u32x4*>(pc);
      pvv[qi] = *reinterpret_cast<const u32x4*>(pc - ((m % L) > 0 ? DIN : 0));
    }
#pragma unroll
    for (int qi = 0; qi < 4; ++qi) {
      const int q = qb + qi;
      const int c = threadIdx.x + 256 * q;
      const int row = c >> 4, ch = n0 + (c & 15) * 8;
      const int m = m0 + row, pos = m % L;
      const f32x4 l0 = *reinterpret_cast<const f32x4*>(Et + row * 132 + (c & 15) * 8);
      const f32x4 l1 = *reinterpret_cast<const f32x4*>(Et + row * 132 + (c & 15) * 8 + 4);
      const u32x4 cu = cuv[qi];
      u32x4 pv = pvv[qi];
      if (pos == 0) pv = (u32x4){0u, 0u, 0u, 0u};
      float xs[8], lr[8];
#pragma unroll
      for (int e = 0; e < 4; ++e) {
        const float c0 = __uint_as_float(cu[e] << 16), c1 = __uint_as_float(cu[e] & 0xffff0000u);
        const float p0 = __uint_as_float(pv[e] << 16), p1 = __uint_as_float(pv[e] & 0xffff0000u);
        const float m0_ = e < 2 ? mu0[2 * e] : mu1[2 * e - 4], m1_ = e < 2 ? mu0[2 * e + 1] : mu1[2 * e - 3];
        xs[2 * e] = c0 + m0_ * (p0 - c0);
        xs[2 * e + 1] = c1 + m1_ * (p1 - c1);
      }
#pragma unroll
      for (int e = 0; e < 4; ++e) { lr[e] = l0[e]; lr[4 + e] = l1[e]; }
      const size_t o = (size_t)m * 512 + ch;
      if (kind == 0) {
        const f32x4 w00 = *reinterpret_cast<const f32x4*>(p.w0 + ch), w01 = *reinterpret_cast<const f32x4*>(p.w0 + ch + 4);
        float lw[8];
#pragma unroll
        for (int e = 0; e < 8; ++e) {
          const float nx = -(lr[e] + (e < 4 ? w00[e] : w01[e - 4]));
          lw[e] = -0.6065306597126334f * fast_rcp(1.0f + __expf(nx));
        }
        st8f(ldst + o, lw);
        st8f(xdst + o, xs);
      } else if (kind == 2) {
        st8f(ldst + o, lr);
        st8f(xdst + o, xs);
      } else {
        const f32x4 a00 = *reinterpret_cast<const f32x4*>(p.a0 + ch), a01 = *reinterpret_cast<const f32x4*>(p.a0 + ch + 4);
        const f32x4 kk0 = *reinterpret_cast<const f32x4*>(p.k_k + ch), kk1 = *reinterpret_cast<const f32x4*>(p.k_k + ch + 4);
        const f32x4 ka0 = *reinterpret_cast<const f32x4*>(p.k_a + ch), ka1 = *reinterpret_cast<const f32x4*>(p.k_a + ch + 4);
        float av[8], kkr[8], ss = 0.f;
#pragma unroll
        for (int e = 0; e < 8; ++e) {
          av[e] = fast_sigmoid(lr[e] + (e < 4 ? a00[e] : a01[e - 4]));
          kkr[e] = xs[e] * (e < 4 ? kk0[e] : kk1[e - 4]);
          ss += kkr[e] * kkr[e];
        }
        ss = dpp_sum8(ss);
        const float inr = 1.0f / fmaxf(sqrtf(ss), 1e-12f);
        float kkn[8], k2[8], bb[8];
#pragma unroll
        for (int e = 0; e < 8; ++e) {
          kkn[e] = kkr[e] * inr;
          k2[e] = xs[e] * (1.0f + (av[e] - 1.0f) * (e < 4 ? ka0[e] : ka1[e - 4]));
          bb[e] = kkn[e] * av[e];
        }
        st8f(ldst + o, kkn);
        st8f(xdst + o, k2);
        st8f(p.rbb + o, bb);
      }
    }
    }
  });
}
#define XB_TICKET 64
__device__ __forceinline__ unsigned tk_add(unsigned* q) { return __hip_atomic_fetch_add(q, 1u, __ATOMIC_RELAXED, __HIP_MEMORY_SCOPE_AGENT); }
template <bool STORE = true>
__device__ __forceinline__ void ph_attn(const Params& p, char* smem, int bid, int nb) {
  char* Kb = smem;
  char* Vs = smem + 49152;
  const int tid = threadIdx.x, lane = tid & 63, w = tid >> 6, g = lane >> 4, r16 = lane & 15;
  const int wu = __builtin_amdgcn_readfirstlane(tid) >> 6;
  const int nitems = 32 * 17;
  volatile int* tick = reinterpret_cast<volatile int*>(smem + 65600);
  (void)bid; (void)nb;
  for (;;) {
    __syncthreads();
    if (tid == 0) *tick = (int)tk_add(&p.bar[XB_TICKET]);
    __syncthreads();
    const int it = *tick;
    if (it >= nitems) break;
    const int bh = it & 31, grp = it >> 5;
    const bool meta = grp == 16;
    const int j = 15 - grp;
    const int b = bh >> 2, h = bh & 3;
    const int qbase = meta ? 0 : 16 + 128 * j;
    const int ntiles = meta ? 1 : 2 * j + 3;
    const int my_ntiles = meta ? 1 : (w < 2 ? 2 * j + 2 : 2 * j + 3);
    bf16x8 qf[2][6];
#pragma unroll
    for (int nt = 0; nt < 2; ++nt)
#pragma unroll
      for (int ks = 0; ks < 6; ++ks) {
        const int pos = qbase + 32 * w + 16 * nt + r16;
        qf[nt][ks] = *reinterpret_cast<const bf16x8*>(p.qf + ((size_t)(b * L + pos)) * 768 + h * 192 + ks * 32 + 8 * g);
      }
    f32x4 o[8][2];
#pragma unroll
    for (int a = 0; a < 8; ++a) { o[a][0] = (f32x4){0.f, 0.f, 0.f, 0.f}; o[a][1] = (f32x4){0.f, 0.f, 0.f, 0.f}; }
    float mrun[2] = {-1e30f, -1e30f}, lrun[2] = {0.f, 0.f};
    const bf16_t* knb = p.kn + (size_t)(b * 4 + h) * L * 128;
    const bf16_t* krb = p.kr + (size_t)b * L * 64;
    const bf16_t* vtb = p.vt + (size_t)(b * 4 + h) * 128 * L;
    int koff[6], voff[4];
    unsigned kmask = 0;
#pragma unroll
    for (int i = 0; i < 6; ++i) {
      const int Lk = 64 * (6 * wu + i) + lane;
      const int row = Lk / 24, sp = Lk - row * 24;
      const int ch = (sp & ~7) | ((sp ^ row) & 7);
      if (ch < 16) koff[i] = row * 128 + ch * 8; else { koff[i] = row * 64 + (ch - 16) * 8; kmask |= 1u << i; }
    }
#pragma unroll
    for (int i = 0; i < 4; ++i) {
      const int row = 8 * (4 * wu + i) + (lane >> 3);
      voff[i] = row * L + (((lane & 7) ^ ((row >> 1) & 7)) * 8);
    }
    auto issueK = [&](int t) {
      const int kp0 = t == 0 ? 0 : 16 + 64 * (t - 1);
      char* dst = Kb + (t & 1) * 24576;
      const bf16_t* kb0 = knb + (size_t)kp0 * 128;
      const bf16_t* kb1 = krb + (size_t)kp0 * 64;
#pragma unroll
      for (int i = 0; i < 6; ++i) GLDS16(((kmask >> i) & 1u ? kb1 : kb0) + koff[i], dst + (6 * wu + i) * 1024);
    };
    auto issueV = [&](int t) {
      const int kp0 = t == 0 ? 0 : 16 + 64 * (t - 1);
      const bf16_t* vb0 = vtb + kp0;
#pragma unroll
      for (int i = 0; i < 4; ++i) GLDS16(vb0 + voff[i], Vs + (4 * wu + i) * 1024);
    };
    __syncthreads();
    issueK(0);
    asm volatile("s_waitcnt vmcnt(0)\n\ts_barrier" ::: "memory");
    for (int t = 0; t < ntiles; ++t) {
      const char* Ks = Kb + (t & 1) * 24576;
      issueV(t);
      if (t + 1 < ntiles) issueK(t + 1);
      bf16x8 pb[2][2];
      if (t < my_ntiles) {
        f32x4 s[4][2];
#pragma unroll
        for (int a = 0; a < 4; ++a) { s[a][0] = (f32x4){0.f, 0.f, 0.f, 0.f}; s[a][1] = (f32x4){0.f, 0.f, 0.f, 0.f}; }
#pragma unroll
        for (int ks = 0; ks < 6; ++ks) {
          const int slot = ks * 4 + g;
          const int so = ((slot & ~7) | ((slot ^ lane) & 7)) << 4;
#pragma unroll
          for (int mt = 0; mt < 4; ++mt) {
            const bf16x8 kf = *reinterpret_cast<const bf16x8*>(Ks + (mt * 16 + r16) * 384 + so);
            s[mt][0] = __builtin_amdgcn_mfma_f32_16x16x32_bf16(kf, qf[0][ks], s[mt][0], 0, 0, 0);
            s[mt][1] = __builtin_amdgcn_mfma_f32_16x16x32_bf16(kf, qf[1][ks], s[mt][1], 0, 0, 0);
          }
        }
        if (t == 0) {
#pragma unroll
          for (int mt = 1; mt < 4; ++mt) { s[mt][0] = (f32x4){-1e30f, -1e30f, -1e30f, -1e30f}; s[mt][1] = s[mt][0]; }
        }
#pragma unroll
        for (int nt = 0; nt < 2; ++nt) {
          float mx = -1e30f;
#pragma unroll
          for (int mt = 0; mt < 4; ++mt)
#pragma unroll
            for (int r = 0; r < 4; ++r) mx = fmaxf(mx, s[mt][nt][r]);
          mx = fmaxf(mx, __shfl_xor(mx, 16, 64));
          mx = fmaxf(mx, __shfl_xor(mx, 32, 64));
          const float mn = fmaxf(mrun[nt], mx);
          const float alpha = __builtin_amdgcn_exp2f(mrun[nt] - mn);
          mrun[nt] = mn;
          float rs = 0.f;
#pragma unroll
          for (int mt = 0; mt < 4; ++mt)
#pragma unroll
            for (int r = 0; r < 4; ++r) { const float pv = __builtin_amdgcn_exp2f(s[mt][nt][r] - mn); s[mt][nt][r] = pv; rs += pv; }
          lrun[nt] = lrun[nt] * alpha + rs;
#pragma unroll
          for (int a = 0; a < 8; ++a) o[a][nt] *= alpha;
#pragma unroll
          for (int k2 = 0; k2 < 2; ++k2) {
            const uint2 lo = pack4bf(s[2 * k2][nt][0], s[2 * k2][nt][1], s[2 * k2][nt][2], s[2 * k2][nt][3]);
            const uint2 hi = pack4bf(s[2 * k2 + 1][nt][0], s[2 * k2 + 1][nt][1], s[2 * k2 + 1][nt][2], s[2 * k2 + 1][nt][3]);
            u32x4 pk; pk[0] = lo.x; pk[1] = lo.y; pk[2] = hi.x; pk[3] = hi.y;
            pb[k2][nt] = __builtin_bit_cast(bf16x8, pk);
          }
        }
      }
      if (t + 1 < ntiles) asm volatile("s_waitcnt vmcnt(6)\n\ts_barrier" ::: "memory");
      else asm volatile("s_waitcnt vmcnt(0)\n\ts_barrier" ::: "memory");
      if (t < my_ntiles) {
#pragma unroll
        for (int k2 = 0; k2 < 2; ++k2) {
          const int sa = ((8 * k2 + g) ^ (r16 & 14)) << 3;
          const int sb = ((8 * k2 + 4 + g) ^ (r16 & 14)) << 3;
#pragma unroll
          for (int a = 0; a < 8; ++a) {
            const uint2 va = *reinterpret_cast<const uint2*>(Vs + (a * 16 + r16) * 128 + sa);
            const uint2 vb = *reinterpret_cast<const uint2*>(Vs + (a * 16 + r16) * 128 + sb);
            u32x4 pk; pk[0] = va.x; pk[1] = va.y; pk[2] = vb.x; pk[3] = vb.y;
            const bf16x8 vf = __builtin_bit_cast(bf16x8, pk);
            o[a][0] = __builtin_amdgcn_mfma_f32_16x16x32_bf16(vf, pb[k2][0], o[a][0], 0, 0, 0);
            o[a][1] = __builtin_amdgcn_mfma_f32_16x16x32_bf16(vf, pb[k2][1], o[a][1], 0, 0, 0);
          }
        }
      }
      asm volatile("s_waitcnt vmcnt(0)\n\ts_waitcnt lgkmcnt(0)\n\ts_barrier" ::: "memory");
    }
#pragma unroll
    for (int nt = 0; nt < 2; ++nt) {
      float l = lrun[nt];
      l += __shfl_xor(l, 16, 64);
      l += __shfl_xor(l, 32, 64);
      const float il = 1.0f / l;
      const int pos = qbase + 32 * w + 16 * nt + r16;
      float sq = 0.f;
#pragma unroll
      for (int a = 0; a < 8; ++a) { const f32x4 v = o[a][nt] * il; sq += v[0] * v[0] + v[1] * v[1] + v[2] * v[2] + v[3] * v[3]; }
      sq += __shfl_xor(sq, 16, 64);
      sq += __shfl_xor(sq, 32, 64);
      if (STORE && (!meta || pos < NM)) {
        bf16_t* dst = p.qf + (size_t)(b * L + pos) * 768 + h * 192 + 4 * g;
#pragma unroll
        for (int a = 0; a < 8; ++a) {
          const f32x4 v = o[a][nt] * il;
          *reinterpret_cast<uint2*>(dst + a * 16) = pack4bf(v[0], v[1], v[2], v[3]);
        }
        if (g == 0) p.ossq[(size_t)(b * L + pos) * 4 + h] = sq;
      }
    }
  }
}
__device__ __forceinline__ void ph_rwkv_pre(const Params& p, char* smem, int bid, int nb) {
  const int lane = threadIdx.x & 63, wv = threadIdx.x >> 6, g = lane >> 4, r16 = lane & 15;
  char* my = smem + wv * 16384;
  char* At = my;
  char* Bt = my + 2048;
  char* Kt = my + 4096;
  char* Rt = my + 6144;
  char* AtT = my + 8192;
  char* VtT = my + 10240;
  char* BhT = my + 12288;
  char* KhT = my + 14336;
  const int nitems = NB_ * 8 * NCH;
  for (int wi = bid * 4 + wv; wi < nitems; wi += nb * 4) {
    const int chunk = wi % NCH, bh = wi / NCH, b = bh >> 3, h = bh & 7;
    float btv[16], ktv[16];
    unsigned atp[8], vtp[8];
    float cum = 0.f;
    const size_t o0 = ((size_t)b * L + chunk * 16) * 512 + h * 64 + lane;
#pragma unroll
    for (int t = 0; t < 16; ++t) {
      const size_t o = o0 + (size_t)t * 512;
      const float lw = bf2f(p.rlw[o]);
      const float gp = __expf(cum);
      cum += lw;
      const float gc = __expf(cum), ig = __expf(-cum);
      const float av = -bf2f(p.rkk[o]) * gp;
      const float bv = bf2f(p.rbb[o]) * ig;
      const float kv = bf2f(p.rk2[o]) * ig;
      const float rv = bf2f(p.rr[o]) * gc;
      const bf16_t vb = p.rv[o];
      btv[t] = bv; ktv[t] = kv;
      const bf16_t ab = f2bf(av);
      *reinterpret_cast<bf16_t*>(At + t * 128 + lane * 2) = ab;
      *reinterpret_cast<bf16_t*>(Bt + t * 128 + lane * 2) = f2bf(bv);
      *reinterpret_cast<bf16_t*>(Kt + t * 128 + lane * 2) = f2bf(kv);
      *reinterpret_cast<bf16_t*>(Rt + t * 128 + lane * 2) = f2bf(rv);
      if (t & 1) { atp[t >> 1] |= (unsigned)ab << 16; vtp[t >> 1] |= (unsigned)vb << 16; }
      else { atp[t >> 1] = ab; vtp[t >> 1] = vb; }
    }
    const float gC = __expf(cum);
    p.cd_gc[(size_t)wi * 64 + lane] = gC;
    {
      u32x4 w0, w1;
#pragma unroll
      for (int q = 0; q < 4; ++q) { w0[q] = atp[q]; w1[q] = atp[4 + q]; }
      *reinterpret_cast<u32x4*>(AtT + lane * 32) = w0; *reinterpret_cast<u32x4*>(AtT + lane * 32 + 16) = w1;
#pragma unroll
      for (int q = 0; q < 4; ++q) { w0[q] = vtp[q]; w1[q] = vtp[4 + q]; }
      *reinterpret_cast<u32x4*>(VtT + lane * 32) = w0; *reinterpret_cast<u32x4*>(VtT + lane * 32 + 16) = w1;
#pragma unroll
      for (int q = 0; q < 4; ++q) {
        w0[q] = pk2bf(btv[2 * q] * gC, btv[2 * q + 1] * gC);
        w1[q] = pk2bf(btv[8 + 2 * q] * gC, btv[8 + 2 * q + 1] * gC);
      }
      *reinterpret_cast<u32x4*>(BhT + lane * 32) = w0; *reinterpret_cast<u32x4*>(BhT + lane * 32 + 16) = w1;
#pragma unroll
      for (int q = 0; q < 4; ++q) {
        w0[q] = pk2bf(ktv[2 * q] * gC, ktv[2 * q + 1] * gC);
        w1[q] = pk2bf(ktv[8 + 2 * q] * gC, ktv[8 + 2 * q + 1] * gC);
      }
      *reinterpret_cast<u32x4*>(KhT + lane * 32) = w0; *reinterpret_cast<u32x4*>(KhT + lane * 32 + 16) = w1;
    }
    __builtin_amdgcn_wave_barrier();
    f32x4 mab = {0.f, 0.f, 0.f, 0.f}, mak = mab, nbr = mab, nkr = mab;
#pragma unroll
    for (int ks = 0; ks < 2; ++ks) {
      const int off = r16 * 128 + ks * 64 + g * 16;
      const bf16x8 fa = *reinterpret_cast<const bf16x8*>(At + off);
      const bf16x8 fb = *reinterpret_cast<const bf16x8*>(Bt + off);
      const bf16x8 fk = *reinterpret_cast<const bf16x8*>(Kt + off);
      const bf16x8 fr = *reinterpret_cast<const bf16x8*>(Rt + off);
      mab = MFMA32(fb, fa, mab); mak = MFMA32(fk, fa, mak);
      nbr = MFMA32(fb, fr, nbr); nkr = MFMA32(fk, fr, nkr);
    }
#pragma unroll
    for (int r = 0; r < 4; ++r) {
      const int sidx = 4 * g + r;
      if (!(sidx < r16)) { mab[r] = 0.f; mak[r] = 0.f; }
      if (!(sidx <= r16)) { nbr[r] = 0.f; nkr[r] = 0.f; }
    }
    float Tc[16];
#pragma unroll
    for (int sidx = 15; sidx >= 0; --sidx) {
      float acc = (r16 == sidx) ? 1.0f : 0.0f;
#pragma unroll
      for (int u = sidx + 1; u < 16; ++u) {
        const float m = __int_as_float(__builtin_amdgcn_readlane(__float_as_int(mab[sidx & 3]), 16 * (sidx >> 2) + u));
        acc += m * Tc[u];
      }
      Tc[sidx] = acc;
    }
    f32x4 tqf;
#pragma unroll
    for (int r = 0; r < 4; ++r) tqf[r] = g == 0 ? Tc[r] : (g == 1 ? Tc[4 + r] : (g == 2 ? Tc[8 + r] : Tc[12 + r]));
    const bf16x4 tq = pk4(tqf);
    const bf16x4 makA = pk4(mak), nbrA = pk4(nbr), nkrA = pk4(nkr);
    f32x4 ah[4], qm[4], wt[4], zt[4];
    bf16x4 vfr[4];
#pragma unroll
    for (int q = 0; q < 4; ++q) {
      const f32x4 z4 = {0.f, 0.f, 0.f, 0.f};
      const bf16x4 atf = *reinterpret_cast<const bf16x4*>(AtT + (16 * q + r16) * 32 + g * 8);
      vfr[q] = *reinterpret_cast<const bf16x4*>(VtT + (16 * q + r16) * 32 + g * 8);
      ah[q] = MFMA16(tq, atf, z4);
      const f32x4 xt = MFMA16(makA, vfr[q], z4);
      wt[q] = MFMA16(tq, pk4(xt), z4);
      qm[q] = MFMA16(nbrA, pk4(ah[q]), z4);
      zt[q] = MFMA16(nbrA, pk4(wt[q]), z4);
      zt[q] = MFMA16(nkrA, vfr[q], zt[q]);
    }
    unsigned char* oah = p.cd_ah + (size_t)wi * 2048;
    unsigned char* oqm = p.cd_qm + (size_t)wi * 2048;
    unsigned char* obk = p.cd_bk + (size_t)wi * 4096;
    unsigned char* owt = p.cd_wt + (size_t)wi * 2048;
    unsigned char* ozt = p.cd_zt + (size_t)wi * 2048;
    unsigned char* ovb = p.cd_vb + (size_t)wi * 2048;
#pragma unroll
    for (int q = 0; q < 4; ++q) {
      *reinterpret_cast<bf16x4*>(owt + (q * 64 + lane) * 8) = pk4(wt[q]);
      *reinterpret_cast<bf16x4*>(ozt + (q * 64 + lane) * 8) = pk4(zt[q]);
      *reinterpret_cast<bf16x4*>(ovb + (q * 64 + lane) * 8) = vfr[q];
      const u32x2 bh2 = *reinterpret_cast<const u32x2*>(BhT + (16 * q + r16) * 32 + g * 8);
      const u32x2 kh2 = *reinterpret_cast<const u32x2*>(KhT + (16 * q + r16) * 32 + g * 8);
      u32x4 bk; bk[0] = bh2[0]; bk[1] = bh2[1]; bk[2] = kh2[0]; bk[3] = kh2[1];
      *reinterpret_cast<u32x4*>(obk + (q * 64 + lane) * 16) = bk;
    }
    __builtin_amdgcn_wave_barrier();
#pragma unroll
    for (int q = 0; q < 4; ++q)
#pragma unroll
      for (int r = 0; r < 4; ++r) *reinterpret_cast<bf16_t*>(Bt + (4 * g + r) * 128 + (16 * q + r16) * 2) = f2bf(ah[q][r]);
    __builtin_amdgcn_wave_barrier();
#pragma unroll
    for (int ks = 0; ks < 2; ++ks) {
      const u32x2 lo = *reinterpret_cast<const u32x2*>(Bt + r16 * 128 + (32 * ks + 4 * g) * 2);
      const u32x2 hi = *reinterpret_cast<const u32x2*>(Bt + r16 * 128 + (32 * ks + 16 + 4 * g) * 2);
      u32x4 v; v[0] = lo[0]; v[1] = lo[1]; v[2] = hi[0]; v[3] = hi[1];
      *reinterpret_cast<u32x4*>(oah + (ks * 64 + lane) * 16) = v;
    }
    __builtin_amdgcn_wave_barrier();
#pragma unroll
    for (int q = 0; q < 4; ++q)
#pragma unroll
      for (int r = 0; r < 4; ++r) *reinterpret_cast<bf16_t*>(Bt + (4 * g + r) * 128 + (16 * q + r16) * 2) = f2bf(qm[q][r]);
    __builtin_amdgcn_wave_barrier();
#pragma unroll
    for (int ks = 0; ks < 2; ++ks) {
      const int o1 = r16 * 128 + (32 * ks + 4 * g) * 2, o2 = r16 * 128 + (32 * ks + 16 + 4 * g) * 2;
      const f32x4 a1 = unpk4(*reinterpret_cast<const u32x2*>(Bt + o1)) + unpk4(*reinterpret_cast<const u32x2*>(Rt + o1));
      const f32x4 a2 = unpk4(*reinterpret_cast<const u32x2*>(Bt + o2)) + unpk4(*reinterpret_cast<const u32x2*>(Rt + o2));
      const uint2 lo = pack4bf(a1[0], a1[1], a1[2], a1[3]), hi = pack4bf(a2[0], a2[1], a2[2], a2[3]);
      u32x4 v; v[0] = lo.x; v[1] = lo.y; v[2] = hi.x; v[3] = hi.y;
      *reinterpret_cast<u32x4*>(oqm + (ks * 64 + lane) * 16) = v;
    }
    __builtin_amdgcn_wave_barrier();
  }
}
__device__ __forceinline__ void ph_rwkv_pq(const Params& p, int bid, int nb) {
  const int lane = threadIdx.x & 63, wv = threadIdx.x >> 6;
  const int nitems = NB_ * 8 * NCH;
  for (int wi = bid * 4 + wv; wi < nitems; wi += nb * 4) {
    const int chunk = wi % NCH, bh = wi / NCH, b = bh >> 3, h = bh & 7;
    const size_t o0 = ((size_t)b * L + chunk * 16) * 512 + h * 64 + lane;
    float pdv[16];
    const float rkc = p.r_k[h * 64 + lane];
#pragma unroll
    for (int t = 0; t < 16; ++t) { const size_t o = o0 + (size_t)t * 512; pdv[t] = bf2f(p.rr[o]) * bf2f(p.rk2[o]) * rkc; }
    const float s3l = tr_reduce16(pdv, lane);
    const float lnw = p.ln_w[h * 64 + lane], lnb = p.ln_b[h * 64 + lane];
    bf16_t gtv[16], vtv[16];
#pragma unroll
    for (int t = 0; t < 16; ++t) { const size_t o = o0 + (size_t)t * 512; gtv[t] = p.rg[o]; vtv[t] = p.rv[o]; }
#pragma unroll
    for (int t = 0; t < 16; ++t) {
      const float s3 = __int_as_float(__builtin_amdgcn_readlane(__float_as_int(s3l), 4 * t));
      const size_t o = o0 + (size_t)t * 512;
      const float gt = bf2f(gtv[t]), vt_ = bf2f(vtv[t]);
      p.rlw[o] = f2bf(lnw * gt);
      p.rbb[o] = f2bf((lnb + s3 * vt_) * gt);
    }
  }
}
struct ChainRegs { u32x4 s0, s1; u32x2 wt, zt, vb; float gcs; };
__device__ __forceinline__ void chain_load(const Params& p, int wi, int it, int lane, ChainRegs& c) {
  const unsigned char* q0 = (it < 2 ? p.cd_ah : p.cd_qm) + (size_t)wi * 2048 + (it & 1) * 1024;
  c.gcs = p.cd_gc[(size_t)wi * 64 + lane];
  c.s0 = *reinterpret_cast<const u32x4*>(q0 + lane * 16);
  c.s1 = *reinterpret_cast<const u32x4*>(p.cd_bk + (size_t)wi * 4096 + it * 1024 + lane * 16);
  c.wt = *reinterpret_cast<const u32x2*>(p.cd_wt + (size_t)wi * 2048 + (it * 64 + lane) * 8);
  c.zt = *reinterpret_cast<const u32x2*>(p.cd_zt + (size_t)wi * 2048 + (it * 64 + lane) * 8);
  c.vb = *reinterpret_cast<const u32x2*>(p.cd_vb + (size_t)wi * 2048 + (it * 64 + lane) * 8);
}
__device__ __forceinline__ void chain_publish(char* sh, int it, int lane, const ChainRegs& c) {
  *reinterpret_cast<u32x4*>(sh + it * 1024 + lane * 16) = c.s0;
  *reinterpret_cast<u32x4*>(sh + 4096 + it * 1024 + lane * 16) = c.s1;
  if (it == 0) reinterpret_cast<float*>(sh + 8192)[lane] = c.gcs;
}
__device__ __forceinline__ float dpp_sum16(float v) {
  v += __int_as_float(__builtin_amdgcn_update_dpp(0, __float_as_int(v), 0xB1, 0xF, 0xF, true));
  v += __int_as_float(__builtin_amdgcn_update_dpp(0, __float_as_int(v), 0x4E, 0xF, 0xF, true));
  v += __int_as_float(__builtin_amdgcn_update_dpp(0, __float_as_int(v), 0x141, 0xF, 0xF, true));
  v += __int_as_float(__builtin_amdgcn_update_dpp(0, __float_as_int(v), 0x140, 0xF, 0xF, true));
  return v;
}
template <int NF>
__device__ __forceinline__ void chain_finalize(const Params& p, const char* ot0, int bufstride, unsigned ytok0, const u32x2 (&pp)[4], const u32x2 (&qq)[4]) {
  const int tid = threadIdx.x;
  f32x4 o4[NF];
  float s1[NF], s2[NF];
#pragma unroll
  for (int k = 0; k < NF; ++k) {
    o4[k] = *reinterpret_cast<const f32x4*>(ot0 + k * bufstride + (tid >> 4) * 256 + (tid & 15) * 16);
    s1[k] = o4[k][0] + o4[k][1] + o4[k][2] + o4[k][3];
    s2[k] = o4[k][0] * o4[k][0] + o4[k][1] * o4[k][1] + o4[k][2] * o4[k][2] + o4[k][3] * o4[k][3];
  }
#define DPP_STEP(ctrl) { _Pragma("unroll") for (int k = 0; k < NF; ++k) { \
    s1[k] += __int_as_float(__builtin_amdgcn_update_dpp(0, __float_as_int(s1[k]), ctrl, 0xF, 0xF, true)); \
    s2[k] += __int_as_float(__builtin_amdgcn_update_dpp(0, __float_as_int(s2[k]), ctrl, 0xF, 0xF, true)); } }
  DPP_STEP(0xB1) DPP_STEP(0x4E) DPP_STEP(0x141) DPP_STEP(0x140)
#undef DPP_STEP
#pragma unroll
  for (int k = 0; k < NF; ++k) {
    const float mean = s1[k] * (1.0f / 64);
    const float var = fmaxf(s2[k] * (1.0f / 64) - mean * mean, 0.0f);
    const float istd = rsqrtf(var + 64e-5f);
    const f32x4 y = (o4[k] - mean) * istd * unpk4(pp[k]) + unpk4(qq[k]);
    *reinterpret_cast<uint2*>(p.rkk + ytok0 + (unsigned)k * 8192u) = pack4bf(y[0], y[1], y[2], y[3]);
  }
}
template <bool FIN>
__device__ __forceinline__ void chain_step(const Params& p, char* otile, const char* otile_fin, unsigned ytok_fin, const u32x2 (&ppf)[4], const u32x2 (&qqf)[4],
                                           const char* sh, char* shn, int it, int lane,
                                           const ChainRegs& c, const ChainRegs& cn, f32x4 (&st)[4]) {
  const int g = lane >> 4, r16 = lane & 15;
  const float* gcur = reinterpret_cast<const float*>(sh + 8192);
  u32x4 s0, s1;
  {
    const uint2 a = pack4bf(st[0][0], st[0][1], st[0][2], st[0][3]), b = pack4bf(st[1][0], st[1][1], st[1][2], st[1][3]);
    const uint2 cc = pack4bf(st[2][0], st[2][1], st[2][2], st[2][3]), d = pack4bf(st[3][0], st[3][1], st[3][2], st[3][3]);
    s0[0] = a.x; s0[1] = a.y; s0[2] = b.x; s0[3] = b.y;
    s1[0] = cc.x; s1[1] = cc.y; s1[2] = d.x; s1[3] = d.y;
  }
  const bf16x8 sb0 = __builtin_bit_cast(bf16x8, s0), sb1 = __builtin_bit_cast(bf16x8, s1);
  f32x4 ut = unpk4(c.wt), ot = unpk4(c.zt);
  ut = MFMA32(*reinterpret_cast<const bf16x8*>(sh + lane * 16), sb0, ut);
  ot = MFMA32(*reinterpret_cast<const bf16x8*>(sh + 2048 + lane * 16), sb0, ot);
  ut = MFMA32(*reinterpret_cast<const bf16x8*>(sh + 1024 + lane * 16), sb1, ut);
  ot = MFMA32(*reinterpret_cast<const bf16x8*>(sh + 3072 + lane * 16), sb1, ot);
  chain_publish(shn, it, lane, cn);
  if (FIN) chain_finalize<4>(p, otile_fin, 4096, ytok_fin, ppf, qqf);
#pragma unroll
  for (int r = 0; r < 4; ++r) *reinterpret_cast<float*>(otile + (4 * g + r) * 256 + (16 * it + r16) * 4) = ot[r];
  const uint2 u2 = pack4bf(ut[0], ut[1], ut[2], ut[3]);
  u32x4 uv; uv[0] = u2.x; uv[1] = u2.y; uv[2] = c.vb[0]; uv[3] = c.vb[1];
  const bf16x8 uvb = __builtin_bit_cast(bf16x8, uv);
#pragma unroll
  for (int q = 0; q < 4; ++q)
    st[q] = MFMA32(*reinterpret_cast<const bf16x8*>(sh + 4096 + q * 1024 + lane * 16), uvb, st[q] * *reinterpret_cast<const f32x4*>(gcur + 16 * q + 4 * g));
  __syncthreads();
}
template <bool STORE = true>
__device__ __forceinline__ void ph_chain(const Params& p, char* smem, int bid, int nb) {
  const int tid = threadIdx.x, lane = tid & 63, it = tid >> 6;
  char* shb = smem + 32768;
  for (int bh = bid; bh < NB_ * 8; bh += nb) {
    f32x4 st[4];
#pragma unroll
    for (int q = 0; q < 4; ++q) st[q] = (f32x4){0.f, 0.f, 0.f, 0.f};
    const int w0 = bh * NCH;
    const int b = bh >> 3, h = bh & 7;
    const unsigned y0 = (unsigned)((b * L + (tid >> 4)) * 512 + h * 64 + (tid & 15) * 4);
    ChainRegs c0, c1, c2, c3, c4, c5, c6, c7;
#define CH_LOAD(cc, set) chain_load(p, w0 + min((cc), NCH - 1), it, lane, set)
    CH_LOAD(0, c0); CH_LOAD(1, c1); CH_LOAD(2, c2); CH_LOAD(3, c3); CH_LOAD(4, c4); CH_LOAD(5, c5); CH_LOAD(6, c6); CH_LOAD(7, c7);
    __syncthreads();
    chain_publish(shb, it, lane, c0);
    __syncthreads();
    u32x2 ppf[4], qqf[4];
#pragma unroll
    for (int q = 0; q < 4; ++q) { ppf[q] = (u32x2){0u, 0u}; qqf[q] = (u32x2){0u, 0u}; }
#define CH_STEP(ch_, k, cur, nxt) { const int cc_ = (ch_) + (k); const int par = (k) & 1; \
      if (((k) & 3) == 0 && cc_ > 0) \
        chain_step<true>(p, smem + (k) * 4096, smem + (((k) + 4) & 7) * 4096, y0 + (unsigned)(cc_ - 4) * 8192u, ppf, qqf, \
                         shb + par * 8448, shb + (1 - par) * 8448, it, lane, cur, nxt, st); \
      else \
        chain_step<false>(p, smem + (k) * 4096, smem, 0u, ppf, qqf, shb + par * 8448, shb + (1 - par) * 8448, it, lane, cur, nxt, st); \
      if (((k) & 3) == 0) { _Pragma("unroll") for (int q_ = 0; q_ < 4; ++q_) {        \
          const unsigned yt_ = y0 + (unsigned)min(cc_ + q_, NCH - 1) * 8192u; \
          ppf[q_] = *reinterpret_cast<const u32x2*>(p.rlw + yt_); qqf[q_] = *reinterpret_cast<const u32x2*>(p.rbb + yt_); } } \
      CH_LOAD(cc_ + 8, cur); }
    for (int ch = 0; ch < 128; ch += 8) {
      CH_STEP(ch, 0, c0, c1) CH_STEP(ch, 1, c1, c2) CH_STEP(ch, 2, c2, c3) CH_STEP(ch, 3, c3, c4)
      CH_STEP(ch, 4, c4, c5) CH_STEP(ch, 5, c5, c6) CH_STEP(ch, 6, c6, c7) CH_STEP(ch, 7, c7, c0)
    }
    CH_STEP(128, 0, c0, c1)
#undef CH_STEP
#undef CH_LOAD
    chain_finalize<1>(p, smem, 4096, y0 + (unsigned)(NCH - 1) * 8192u, ppf, qqf);
    __syncthreads();
  }
}
__device__ __forceinline__ void ph_tabconv(const Params& p, int bid, int nb) {
  const int nvec = 2 * 16384 * 256;
  const int stride = nb * NTHR;
  const int base0 = bid * NTHR + threadIdx.x;
  const f32x4 gf = *reinterpret_cast<const f32x4*>(p.g_ffn + (base0 & 255) * 4);
  f32x4 va[16], vb[16];
#define TC_LOAD(buf, bs) { _Pragma("unroll") for (int k = 0; k < 16; ++k) { \
      const int i = min((bs) + k * stride, nvec - 1); const bool tab = i >= 16384 * 256; \
      buf[k] = __builtin_nontemporal_load(reinterpret_cast<const f32x4*>((tab ? p.pv : p.pu) + (size_t)(tab ? i - 16384 * 256 : i) * 4)); } }
#define TC_STORE(buf, bs) { _Pragma("unroll") for (int k = 0; k < 16; ++k) { \
      const int i = (bs) + k * stride; \
      if (i < nvec) { const bool tab = i >= 16384 * 256; \
        f32x4 w = buf[k] * (tab ? 16.0f : 256.0f); if (!tab) w *= gf; \
        int wv = __builtin_amdgcn_cvt_pk_fp8_f32(w[0], w[1], 0, false); wv = __builtin_amdgcn_cvt_pk_fp8_f32(w[2], w[3], wv, true); \
        __builtin_nontemporal_store((unsigned)wv, reinterpret_cast<unsigned*>((tab ? p.v8 : p.u8) + (size_t)(tab ? i - 16384 * 256 : i) * 4)); } } }
  TC_LOAD(va, base0)
  for (int base = base0; base < nvec; base += 32 * stride) {
    TC_LOAD(vb, base + 16 * stride)
    TC_STORE(va, base)
    TC_LOAD(va, base + 32 * stride)
    TC_STORE(vb, base + 16 * stride)
  }
#undef TC_LOAD
#undef TC_STORE
}
__device__ __forceinline__ void ph_outproj(const Params& p, char* smem, int bid, int nb) {
  const int lane = threadIdx.x & 63, w = threadIdx.x >> 6, wm = w >> 1, wn = w & 1, g = lane >> 4, r16 = lane & 15;
  for_tiles_xcd(TR / 128, 4, bid, nb, [&](int tm, int tn) {
    const int m0 = tm * 128, n0 = tn * 256;
    f32x4 acc[4][8];
    gemm_tile_wide(smem, m0, n0, 32,
        [&](int r, int k) {
          const size_t tt = (size_t)rt2tt(r);
          return k < 512 ? p.qf + tt * 768 + (k >> 7) * 192 + (k & 127) : p.rkk + tt * 512 + (k - 512);
        },
        [&](int n, int k) { return p.w_outT + (size_t)n * 1024 + k; }, acc,
        [&](int kt, f32x4 (&a)[4][8]) {
          if (kt == 16) {
#pragma unroll
            for (int i = 0; i < 4; ++i) {
              const f32x4 q4 = *reinterpret_cast<const f32x4*>(p.ossq + (size_t)rt2tt(m0 + wm * 64 + 16 * i + r16) * 4);
              const float rs = rsqrtf((q4[0] + q4[1] + q4[2] + q4[3]) * (1.0f / 512) + RMS_EPS);
#pragma unroll
              for (int j = 0; j < 8; ++j) a[i][j] *= rs;
            }
          }
        });
#pragma unroll 1
    for (int half = 0; half < 2; ++half) {
      stage_acc_half(smem, acc, half);
#pragma unroll 1
      for (int qb = 0; qb < 8; qb += 4) {
      f32x4 hh[4][2];
#pragma unroll
      for (int qi = 0; qi < 4; ++qi) {
        const int c = threadIdx.x + 256 * (qb + qi);
        const float* hr = hrow(p, rt2tt(m0 + (c >> 4))) + n0 + half * 128 + (c & 15) * 8;
        hh[qi][0] = *reinterpret_cast<const f32x4*>(hr); hh[qi][1] = *reinterpret_cast<const f32x4*>(hr + 4);
      }
#pragma unroll
      for (int qi = 0; qi < 4; ++qi) {
        const int q = qb + qi;
        const int c = threadIdx.x + 256 * q;
        const int row = c >> 4, col8 = (c & 15) * 8;
        const int m = m0 + row, n = n0 + half * 128 + col8;
        const f32x4 h0 = hh[qi][0], h1 = hh[qi][1];
        float v[8];
        ld8(smem, row, col8, v);
        float sq = 0.f;
#pragma unroll
        for (int e = 0; e < 8; ++e) { v[e] += e < 4 ? h0[e] : h1[e - 4]; sq += v[e] * v[e]; }
        f32x4 o0, o1;
#pragma unroll
        for (int e = 0; e < 4; ++e) { o0[e] = v[e]; o1[e] = v[4 + e]; }
        *reinterpret_cast<f32x4*>(p.out + (size_t)m * D + n) = o0;
        *reinterpret_cast<f32x4*>(p.out + (size_t)m * D + n + 4) = o1;
        st8f(p.h2b + (size_t)m * D + n, v);
        sq += __shfl_xor(sq, 1, 64); sq += __shfl_xor(sq, 2, 64); sq += __shfl_xor(sq, 4, 64); sq += __shfl_xor(sq, 8, 64);
        if ((threadIdx.x & 15) == 0) atomicAdd(p.h2ss + m, sq);
      }
      }
    }
  });
}
#define CE_(a, b) { const int t_ = max(a, b); b = min(a, b); a = t_; }
__device__ __forceinline__ int fkey7(float x, int idx) {
  int b = __float_as_int(x);
  b ^= (b >> 31) & 0x7fffffff;
  return (b & ~127) | (127 - idx);
}
__device__ __forceinline__ float fvalm(int k, int mask) {
  int b = k & ~mask;
  b ^= (b >> 31) & 0x7fffffff;
  return __int_as_float(b);
}
__device__ __forceinline__ void bitonic_sort16(int (&v)[16]) {
#pragma unroll
  for (int k = 2; k <= 16; k <<= 1)
#pragma unroll
    for (int j = k >> 1; j > 0; j >>= 1)
#pragma unroll
      for (int i = 0; i < 16; ++i) {
        const int l = i ^ j;
        if (l > i) {
          if ((i & k) == 0) { CE_(v[i], v[l]); } else { CE_(v[l], v[i]); }
        }
      }
}
__device__ __forceinline__ void bitonic_merge16(int (&v)[16]) {
#pragma unroll
  for (int j = 8; j > 0; j >>= 1)
#pragma unroll
    for (int i = 0; i < 16; ++i) {
      const int l = i ^ j;
      if (l > i) { CE_(v[i], v[l]); }
    }
}
__device__ __forceinline__ void ph_route(const Params& p, char* smem, int bid, int nb) {
  const int tid = threadIdx.x, lane = tid & 63, w = tid >> 6, wm = w >> 1, wn = w & 1, g = lane >> 4, r16 = lane & 15;
#define L2W(t) (reinterpret_cast<int*>(smem + ((t) >> 5) * (32 * 528)) + ((t) & 31) * 16)
#define LXW(hf) (reinterpret_cast<int*>(smem + (hf) * (32 * 528) + 2048))
  int* L1l = reinterpret_cast<int*>(smem + 67584);
  for_tiles_xcd(TR / 128, 8, bid, nb, [&](int mt, int h) {
    const int m0 = mt * 128;
    f32x4 acc[4][8];
    gemm_tile_wide(smem, m0, 2 * h * 128, 32,
        [&](int r, int k) { return p.h2b + (size_t)r * D + k; },
        [&](int n, int k) { return p.w_qT + (size_t)n * 1024 + k; }, acc);
#pragma unroll 1
    for (int c = 0; c < 2; ++c) {
      float* Et = reinterpret_cast<float*>(smem);
      stage_acc_half(smem, acc, c);
#pragma unroll 1
      for (int tt = 0; tt < 2; ++tt) {
        f32x4 sc[8];
#pragma unroll
        for (int kt = 0; kt < 8; ++kt) sc[kt] = *reinterpret_cast<const f32x4*>(Et + (32 * w + 16 * tt + r16) * 132 + 16 * kt + 4 * g);
        int lo[16], hi[16];
#pragma unroll
        for (int kt = 0; kt < 4; ++kt)
#pragma unroll
          for (int r = 0; r < 4; ++r) {
            lo[kt * 4 + r] = fkey7(sc[kt][r], 16 * kt + 4 * g + r);
            hi[kt * 4 + r] = fkey7(sc[kt + 4][r], 16 * (kt + 4) + 4 * g + r);
          }
        bitonic_sort16(lo);
        bitonic_sort16(hi);
#pragma unroll
        for (int i = 0; i < 16; ++i) lo[i] = max(lo[i], hi[15 - i]);
        bitonic_merge16(lo);
#pragma unroll
        for (int st = 16; st <= 32; st <<= 1) {
          int ot[16];
#pragma unroll
          for (int i = 0; i < 16; ++i) ot[i] = __shfl_xor(lo[15 - i], st, 64);
#pragma unroll
          for (int i = 0; i < 16; ++i) lo[i] = max(lo[i], ot[i]);
          bitonic_merge16(lo);
        }
        if (g == 0) {
          int* dst = c ? L2W(32 * w + 16 * tt + r16) : L1l + (32 * w + 16 * tt + r16) * 16;
#pragma unroll
          for (int q = 0; q < 4; ++q) {
            u32x4 v; v[0] = lo[4 * q]; v[1] = lo[4 * q + 1]; v[2] = lo[4 * q + 2]; v[3] = lo[4 * q + 3];
            *reinterpret_cast<u32x4*>(dst + 4 * q) = v;
          }
        }
      }
      __syncthreads();
    }
    {
      const int tok = tid & 127, half = tid >> 7;
      int k1[16], k2[16];
      float v1[16], v2[16];
#pragma unroll
      for (int q = 0; q < 4; ++q) {
        const u32x4 a = *reinterpret_cast<const u32x4*>(L1l + tok * 16 + 4 * q);
        const u32x4 b = *reinterpret_cast<const u32x4*>(L2W(tok) + 4 * q);
#pragma unroll
        for (int e = 0; e < 4; ++e) { k1[4 * q + e] = (int)a[e]; k2[4 * q + e] = (int)b[e]; }
      }
#pragma unroll
      for (int i = 0; i < 16; ++i) { v1[i] = fvalm(k1[i], 127); v2[i] = fvalm(k2[i], 127); }
      int lst[16];
#pragma unroll
      for (int i = 0; i < 16; ++i) lst[i] = (int)0x80000000;
      if (half == 0) {
#pragma unroll
        for (int a = 0; a < 2; ++a)
#pragma unroll
          for (int b = 0; b < 16 / (a + 1); ++b) {
            int x = __float_as_int(v1[a] + v2[b]);
            x ^= (x >> 31) & 0x7fffffff;
            x = (x & ~255) | (255 - (a * 16 + b));
#pragma unroll
            for (int i = 0; i < 16; ++i) CE_(lst[i], x);
          }
      } else {
#pragma unroll
        for (int a = 2; a < 16; ++a)
#pragma unroll
          for (int b = 0; b < 16 / (a + 1); ++b) {
            int x = __float_as_int(v1[a] + v2[b]);
            x ^= (x >> 31) & 0x7fffffff;
            x = (x & ~255) | (255 - (a * 16 + b));
#pragma unroll
            for (int i = 0; i < 16; ++i) CE_(lst[i], x);
          }
      }
#pragma unroll
      for (int q = 0; q < 4; ++q) {
        u32x4 v; v[0] = lst[4 * q]; v[1] = lst[4 * q + 1]; v[2] = lst[4 * q + 2]; v[3] = lst[4 * q + 3];
        *reinterpret_cast<u32x4*>(LXW(half) + tok * 16 + 4 * q) = v;
      }
      __syncthreads();
      int fin[16];
#pragma unroll
      for (int q = 0; q < 4; ++q) {
        const u32x4 o = *reinterpret_cast<const u32x4*>(LXW(1 - half) + tok * 16 + 4 * q);
#pragma unroll
        for (int e = 0; e < 4; ++e) fin[4 * q + e] = (int)o[e];
      }
#pragma unroll
      for (int i = 0; i < 8; ++i) { const int t_ = fin[i]; fin[i] = fin[15 - i]; fin[15 - i] = t_; }
#pragma unroll
      for (int i = 0; i < 16; ++i) fin[i] = max(fin[i], lst[i]);
      float sv[16], mx = -1e30f;
      const float rs2 = rsqrtf(p.h2ss[m0 + tok] * (1.0f / D) + RMS_EPS);
#pragma unroll
      for (int i = 0; i < 16; ++i) { sv[i] = fvalm(fin[i], 255); mx = fmaxf(mx, sv[i]); }
      float sum = 0.f;
#pragma unroll
      for (int i = 0; i < 16; ++i) { sv[i] = __expf((sv[i] - mx) * rs2); sum += sv[i]; }
      const float isum = 1.0f / sum;
      const size_t ob = (size_t)(m0 + tok) * 128 + h * 16 + half * 8;
#pragma unroll
      for (int i = 0; i < 8; ++i) {
        const int code = 255 - (fin[i] & 255);
        const int a = code >> 4, b = code & 15;
        const int i1 = 127 - (L1l[tok * 16 + a] & 127), i2 = 127 - (L2W(tok)[b] & 127);
        p.pidx[ob + i] = i1 * 128 + i2;
        p.pgate[ob + i] = sv[i] * isum;
      }
    }
    __syncthreads();
  });
#undef L2W
#undef LXW
}
__device__ __forceinline__ void ph_expert(const Params& p, char* smem, int bid, int nb) {
  const int lane = threadIdx.x & 63, wv = threadIdx.x >> 6;
  const int g3 = lane >> 3, p8 = lane & 7;
  const bool b5 = lane & 32, b4 = lane & 16, b3 = lane & 8;
  const bool pb2 = lane & 4, pb1 = lane & 2, pb0 = lane & 1;
  unsigned* idxl = reinterpret_cast<unsigned*>(smem + wv * 8192);
  float* al = reinterpret_cast<float*>(smem + wv * 8192 + 4096);
  for (int grp = bid * 4 + wv; grp < TR / 8; grp += nb * 4) {
    const int rt0 = grp * 8;
    float rs2[8];
#pragma unroll
    for (int t = 0; t < 8; ++t) {
      rs2[t] = rsqrtf(p.h2ss[rt0 + t] * (1.0f / D) + RMS_EPS);
      const size_t pb = (size_t)(rt0 + t) * 128;
      idxl[t * 128 + lane] = (unsigned)p.pidx[pb + lane] << 10;
      idxl[t * 128 + 64 + lane] = (unsigned)p.pidx[pb + 64 + lane] << 10;
      al[t * 128 + lane] = p.pgate[pb + lane];
      al[t * 128 + 64 + lane] = p.pgate[pb + 64 + lane];
    }
    __builtin_amdgcn_wave_barrier();
    float dacc[8][2];
#pragma unroll
    for (int t = 0; t < 8; ++t) { dacc[t][0] = 0.f; dacc[t][1] = 0.f; }
#pragma unroll 1
    for (int x = 0; x < 8; ++x) {
      const unsigned coff = 128u * x + 16u * p8;
#pragma unroll 1
      for (int t = 0; t < 8; ++t) {
        f32x2 xp[8];
        {
          const bf16_t* hr = p.h2b + (size_t)(rt0 + t) * D + coff;
          const u32x4 a = *reinterpret_cast<const u32x4*>(hr);
          const u32x4 b = *reinterpret_cast<const u32x4*>(hr + 8);
#pragma unroll
          for (int q = 0; q < 4; ++q) {
            xp[q][0] = __uint_as_float(a[q] << 16); xp[q][1] = __uint_as_float(a[q] & 0xffff0000u);
            xp[4 + q][0] = __uint_as_float(b[q] << 16); xp[4 + q][1] = __uint_as_float(b[q] & 0xffff0000u);
          }
        }
        u32x4 rows[16];
#pragma unroll
        for (int j = 0; j < 16; ++j) {
          const unsigned off = idxl[t * 128 + 16 * g3 + j];
          rows[j] = *reinterpret_cast<const u32x4*>(p.u8 + off + coff);
        }
        float sj[16];
#pragma unroll
        for (int j = 0; j < 16; ++j) {
          f32x2 acc2 = {0.f, 0.f};
#pragma unroll
          for (int q = 0; q < 4; ++q) {
            acc2 += xp[2 * q] * __builtin_amdgcn_cvt_pk_f32_fp8((int)rows[j][q], false);
            acc2 += xp[2 * q + 1] * __builtin_amdgcn_cvt_pk_f32_fp8((int)rows[j][q], true);
          }
          sj[j] = acc2[0] + acc2[1];
        }
#pragma unroll
        for (int jj = 0; jj < 2; ++jj) {
          float r4[4], r2[2];
#pragma unroll
          for (int i = 0; i < 4; ++i) {
            const float kp = pb2 ? sj[8 * jj + i + 4] : sj[8 * jj + i], sd = pb2 ? sj[8 * jj + i] : sj[8 * jj + i + 4];
            r4[i] = kp + __int_as_float(__builtin_amdgcn_update_dpp(0, __float_as_int(sd), 0x141, 0xF, 0xF, true));
          }
#pragma unroll
          for (int i = 0; i < 2; ++i) {
            const float kp = pb1 ? r4[i + 2] : r4[i], sd = pb1 ? r4[i] : r4[i + 2];
            r2[i] = kp + __int_as_float(__builtin_amdgcn_update_dpp(0, __float_as_int(sd), 0x4E, 0xF, 0xF, true));
          }
          {
            const float kp = pb0 ? r2[1] : r2[0], sd = pb0 ? r2[0] : r2[1];
            dacc[0][jj] += kp + __int_as_float(__builtin_amdgcn_update_dpp(0, __float_as_int(sd), 0xB1, 0xF, 0xF, true));
          }
        }
        {
          const float r0 = dacc[0][0], r1 = dacc[0][1];
#pragma unroll
          for (int q = 0; q < 7; ++q) { dacc[q][0] = dacc[q + 1][0]; dacc[q][1] = dacc[q + 1][1]; }
          dacc[7][0] = r0; dacc[7][1] = r1;
        }
      }
    }
#pragma unroll
    for (int t = 0; t < 8; ++t)
#pragma unroll
      for (int jj = 0; jj < 2; ++jj) {
        const int slot = 16 * g3 + 8 * jj + p8;
        const float dot = dacc[t][jj] * rs2[t] * (1.0f / 256.0f);
        const float gt = al[t * 128 + slot];
        al[t * 128 + slot] = 0.5f * dot * (1.0f + erff(dot * 0.7071067811865476f)) * gt * (1.0f / 16.0f);
      }
    __builtin_amdgcn_wave_barrier();
    float ssq[8];
#pragma unroll
    for (int t = 0; t < 8; ++t) ssq[t] = 0.f;
    const int cw = 8 * (b5 ? 1 : 0) + 4 * (b4 ? 1 : 0) + 2 * (b3 ? 1 : 0);
#pragma unroll 1
    for (int x = 0; x < 8; ++x) {
      const unsigned coff = 128u * x + 16u * p8;
#pragma unroll 1
      for (int t = 0; t < 8; ++t) {
        u32x4 rows[16];
        float av[16];
#pragma unroll
        for (int j = 0; j < 16; ++j) {
          const unsigned off = idxl[t * 128 + 16 * g3 + j];
          av[j] = al[t * 128 + 16 * g3 + j];
          rows[j] = *reinterpret_cast<const u32x4*>(p.v8 + off + coff);
        }
        f32x2 oa[8];
#pragma unroll
        for (int q = 0; q < 8; ++q) oa[q] = (f32x2){0.f, 0.f};
#pragma unroll
        for (int j = 0; j < 16; ++j) {
          const f32x2 a2 = {av[j], av[j]};
#pragma unroll
          for (int q = 0; q < 4; ++q) {
            oa[2 * q] += a2 * __builtin_amdgcn_cvt_pk_f32_fp8((int)rows[j][q], false);
            oa[2 * q + 1] += a2 * __builtin_amdgcn_cvt_pk_f32_fp8((int)rows[j][q], true);
          }
        }
        f32x2 q4v[4], q2v[2], q1v;
#pragma unroll
        for (int i = 0; i < 4; ++i)
#pragma unroll
          for (int c = 0; c < 2; ++c) {
            const auto r = __builtin_amdgcn_permlane32_swap(__float_as_uint(oa[i][c]), __float_as_uint(oa[i + 4][c]), false, false);
            q4v[i][c] = __uint_as_float(r[0]) + __uint_as_float(r[1]);
          }
#pragma unroll
        for (int i = 0; i < 2; ++i)
#pragma unroll
          for (int c = 0; c < 2; ++c) {
            const auto r = __builtin_amdgcn_permlane16_swap(__float_as_uint(q4v[i][c]), __float_as_uint(q4v[i + 2][c]), false, false);
            q2v[i][c] = __uint_as_float(r[0]) + __uint_as_float(r[1]);
          }
        {
          const f32x2 sd = b3 ? q2v[0] : q2v[1], kp = b3 ? q2v[1] : q2v[0];
          q1v[0] = kp[0] + __int_as_float(__builtin_amdgcn_update_dpp(0, __float_as_int(sd[0]), 0x128, 0xF, 0xF, true));
          q1v[1] = kp[1] + __int_as_float(__builtin_amdgcn_update_dpp(0, __float_as_int(sd[1]), 0x128, 0xF, 0xF, true));
        }
        float* hp = p.out + (size_t)(rt0 + t) * D + coff + cw;
        const f32x2 h3 = *reinterpret_cast<const f32x2*>(hp) + q1v;
        *reinterpret_cast<f32x2*>(hp) = h3;
        {
          const float r0 = ssq[0] + h3[0] * h3[0] + h3[1] * h3[1];
#pragma unroll
          for (int q = 0; q < 7; ++q) ssq[q] = ssq[q + 1];
          ssq[7] = r0;
        }
      }
    }
    asm volatile("s_waitcnt vmcnt(0)" ::: "memory");
    {
      float rsv[8];
#pragma unroll
      for (int t = 0; t < 8; ++t) rsv[t] = rsqrtf(wave_sum(ssq[t]) * (1.0f / D) + RMS_EPS);
      f32x2 gfv[8];
#pragma unroll
      for (int x = 0; x < 8; ++x) gfv[x] = *reinterpret_cast<const f32x2*>(p.g_fin + 128 * x + 16 * p8 + cw);
      unsigned long long hv[8][8];
#pragma unroll
      for (int t = 0; t < 8; ++t)
#pragma unroll
        for (int x = 0; x < 8; ++x)
          hv[t][x] = __hip_atomic_load(reinterpret_cast<unsigned long long*>(p.out + (size_t)(rt0 + t) * D + 128 * x + 16 * p8 + cw),
                                       __ATOMIC_RELAXED, __HIP_MEMORY_SCOPE_AGENT);
#pragma unroll
      for (int t = 0; t < 8; ++t)
#pragma unroll
        for (int x = 0; x < 8; ++x) {
          f32x2 o2;
          o2[0] = __uint_as_float((unsigned)hv[t][x]) * rsv[t] * gfv[x][0];
          o2[1] = __uint_as_float((unsigned)(hv[t][x] >> 32)) * rsv[t] * gfv[x][1];
          __builtin_nontemporal_store(o2, reinterpret_cast<f32x2*>(p.out + (size_t)(rt0 + t) * D + 128 * x + 16 * p8 + cw));
        }
    }
    __builtin_amdgcn_wave_barrier();
  }
}

#define XB_TMO      128
#define XB_XCNT(j)  (256  + 64 * (j))
#define XB_XSUB(j)  (1280 + 64 * (j))
#define XB_XGEN(j)  (2304 + 64 * (j))
#define XB_TOP      3328
#define XB_TOPGEN   3392
#define XCD_BAR_WORDS 3456
#define XB_SPIN_CAP (1u << 18)
#define LAS __attribute__((address_space(3)))
__device__ __forceinline__ unsigned xb_ld(unsigned* p) { return __hip_atomic_load(p, __ATOMIC_RELAXED, __HIP_MEMORY_SCOPE_AGENT); }
__device__ __forceinline__ unsigned xb_add(unsigned* p, unsigned v) { return __hip_atomic_fetch_add(p, v, __ATOMIC_RELAXED, __HIP_MEMORY_SCOPE_AGENT); }
__device__ __forceinline__ unsigned xb_xcc_id() { return (unsigned)__builtin_amdgcn_s_getreg((3 << 11) | 20) & 0xFu; }
#define XB_SPIN(cond, bar) do { unsigned _sp = 0; while (cond) { __builtin_amdgcn_s_sleep(1); \
    if ((++_sp & 255u) == 0u) { if (xb_ld(&(bar)[XB_TMO])) break; if (_sp > XB_SPIN_CAP) { atomicAdd(&(bar)[XB_TMO], 1u); break; } } } } while (0)
struct XcdBarrier { unsigned* bar; unsigned x; volatile LAS unsigned* st; };
__device__ __forceinline__ XcdBarrier xcd_barrier_post(unsigned* bar, volatile LAS unsigned* st) {
  XcdBarrier b; b.bar = bar; b.x = xb_xcc_id(); b.st = st;
  if (threadIdx.x == 0) (void)xb_add(&bar[XB_XCNT(b.x)], 1u);
  return b;
}
__device__ __forceinline__ void xcd_barrier_complete(unsigned* bar, unsigned x, unsigned& nloc, unsigned& nx) {
  const unsigned G = gridDim.x * gridDim.y * gridDim.z;
  unsigned sum, cnt, mine, sp = 0u;
  for (;;) {
    sum = 0u; cnt = 0u; mine = 0u;
#pragma unroll
    for (unsigned j = 0; j < 16; ++j) { const unsigned c = xb_ld(&bar[XB_XCNT(j)]); sum += c; cnt += (c > 0u) ? 1u : 0u; mine = (j == x) ? c : mine; }
    if (sum == G) break;
    __builtin_amdgcn_s_sleep(1);
    if ((++sp & 255u) == 0u) { if (xb_ld(&bar[XB_TMO])) break; if (sp > XB_SPIN_CAP) { atomicAdd(&bar[XB_TMO], 1u); break; } }
  }
  nloc = mine > 0u ? mine : 1u; nx = cnt > 0u ? cnt : 1u;
}
__device__ __forceinline__ void xcd_barrier(const XcdBarrier& b) {
  asm volatile("s_waitcnt vmcnt(0)" ::: "memory");
  __syncthreads();
  if (threadIdx.x == 0) {
    unsigned* bar = b.bar;
    __builtin_amdgcn_s_waitcnt(0);
    unsigned nloc = b.st[0], nx = b.st[1];
    if (nloc == 0u) { xcd_barrier_complete(bar, b.x, nloc, nx); b.st[0] = nloc; b.st[1] = nx; }
    const unsigned old = xb_add(&bar[XB_XSUB(b.x)], 1u);
    const unsigned gen = old / nloc;
    if (old + 1u == (gen + 1u) * nloc) {
      __builtin_amdgcn_fence(__ATOMIC_RELEASE, "agent");
      asm volatile("s_waitcnt vmcnt(0)" ::: "memory");
      const unsigned og = xb_add(&bar[XB_TOP], 1u);
      const unsigned tg = og / nx;
      if (og + 1u == (tg + 1u) * nx) xb_add(&bar[XB_TOPGEN], 1u);
      else XB_SPIN(xb_ld(&bar[XB_TOPGEN]) == tg, bar);
      __builtin_amdgcn_fence(__ATOMIC_ACQUIRE, "agent");
      xb_add(&bar[XB_XGEN(b.x)], 1u);
      asm volatile("s_waitcnt vmcnt(0)" ::: "memory");
    } else {
      XB_SPIN(xb_ld(&bar[XB_XGEN(b.x)]) == gen, bar);
      __builtin_amdgcn_fence(__ATOMIC_ACQUIRE, "agent");
      asm volatile("s_waitcnt vmcnt(0)" ::: "memory");
    }
  }
  __syncthreads();
}

constexpr int SMEM_FLOATS = 18944 + 4;


__global__ void __launch_bounds__(NTHR, 2) k_mega(Params p) {
  __shared__ __attribute__((aligned(16))) float smem[SMEM_FLOATS];
  if (threadIdx.x == 0) { smem[18944] = 0.f; smem[18945] = 0.f; smem[18946] = 0.f; smem[18947] = 0.f; }
  __syncthreads();
  const XcdBarrier xb = xcd_barrier_post(p.bar, (volatile LAS unsigned*)&smem[18944]);
  const int bid = blockIdx.x, nb = gridDim.x;
  ph_prep(p, bid, nb);
  xcd_barrier(xb);
  ph_inproj(p, (char*)smem, bid, nb);
  if (nb > 384) { if (bid >= 256) ph_w2(p, (char*)smem, bid - 256, nb - 256); }
  else ph_w2(p, (char*)smem, bid, nb);
  xcd_barrier(xb);
  ph_rwkv_prep(p, (char*)smem, bid, nb);
  ph_q_up(p, (char*)smem, bid, nb);
  ph_kv_up(p, (char*)smem, bid, nb);
  xcd_barrier(xb);
  ph_rwkv_pre(p, (char*)smem, bid, nb);
  ph_rwkv_pq(p, bid, nb);
  xcd_barrier(xb);
  if (bid < 64) { ph_chain(p, (char*)smem, bid, 64); ph_attn(p, (char*)smem, 0, 0); }
  else {
    const int abid = bid - 64, NTC = (nb - 64) >= 256 ? 128 : (nb - 64);
    const int tc0 = (nb - 64) >= 448 ? 192 : 0;
    if (abid >= tc0 && abid < tc0 + NTC) ph_tabconv(p, abid - tc0, NTC);
    ph_attn(p, (char*)smem, abid, nb - 64);
  }
  xcd_barrier(xb);
  ph_outproj(p, (char*)smem, bid, nb);
  xcd_barrier(xb);
  ph_route(p, (char*)smem, bid, nb);
  xcd_barrier(xb);
  ph_expert(p, (char*)smem, bid, nb);
}

extern "C" void kernel_launch(void* const* d_in, const int* in_sizes, int n_in, void* d_out, int out_size, void* d_ws,
                              size_t ws_size, hipStream_t stream) {
  Params p{};
  const float* const* in = reinterpret_cast<const float* const*>(d_in);
  p.x = in[0]; p.meta = in[1]; p.g_mix = in[2]; p.w_in = in[3]; p.g_q = in[4]; p.w_uq = in[5]; p.g_kv = in[6];
  p.w_ukv = in[7]; p.g_out = in[8]; p.mu = in[9]; p.w0 = in[10]; p.w_up = in[11]; p.a0 = in[12]; p.a_up = in[13];
  p.g_up = in[14]; p.k_k = in[15]; p.k_a = in[16]; p.r_k = in[17]; p.ln_w = in[18]; p.ln_b = in[19]; p.w_out = in[20];
  p.g_ffn = in[21]; p.w_q = in[22]; p.subk = in[23]; p.pu = in[24]; p.pv = in[25]; p.g_fin = in[26];
  p.out = (float*)d_out;
  char* ws = (char*)d_ws;
  size_t off = 0;
  auto take = [&](size_t bytes) { char* r = ws + off; off += (bytes + 255) & ~(size_t)255; return r; };
  p.bar = (unsigned*)take((size_t)XCD_BAR_WORDS * 4);
  p.h2ss = (float*)take((size_t)TR * 4);
  const size_t zero_bytes = off;
  p.rstd1 = (float*)take((size_t)T * 4);
  p.ossq = (float*)take((size_t)T * 4 * 4);
  p.w_inT = (bf16_t*)take((size_t)DIN * 1024 * 2);
  p.w_uqT = (bf16_t*)take((size_t)768 * 256 * 2);
  p.w_ukvT = (bf16_t*)take((size_t)1024 * 128 * 2);
  p.w_outT = (bf16_t*)take((size_t)1024 * 1024 * 2);
  p.w_qT = (bf16_t*)take((size_t)2048 * 1024 * 2);
  p.subkb = (bf16_t*)take((size_t)8 * 2 * 128 * 128 * 2);
  p.w_lrT = (bf16_t*)take((size_t)1536 * 128 * 2);
  p.ropec = (float*)take((size_t)L * 32 * 4);
  p.ropes = (float*)take((size_t)L * 32 * 4);
  char* regA = take((size_t)T * DIN * 2);
  char* regB = take((size_t)T * (768 + 1024 + 64) * 2);
  char* regBend = ws + off;
  char* regC = take((size_t)T * 512 * 2 * 7);
  if (off > ws_size) fprintf(stderr, "workspace too small: need %zu have %zu\n", off, ws_size);
  p.proj = (bf16_t*)regA;
  {
    const size_t NW = (size_t)NB_ * 8 * NCH;
    p.cd_qm = (unsigned char*)regA;
    p.cd_wt = p.cd_qm + NW * 2048;
    p.cd_zt = p.cd_wt + NW * 2048;
    p.cd_vb = p.cd_zt + NW * 2048;
    p.cd_bk = (unsigned char*)d_out;
    p.cd_ah = p.cd_bk + NW * 4096;
    p.cd_gc = (float*)(p.cd_ah + NW * 2048);
  }
  p.h2b = (bf16_t*)regA;
  p.pidx = (int*)(regA + (size_t)TR * D * 2);
  p.pgate = (float*)(regA + (size_t)TR * D * 2 + (size_t)TR * 128 * 4);
  p.qf = (bf16_t*)regB;
  p.kn = (bf16_t*)(regB + (size_t)T * 768 * 2);
  p.vt = (bf16_t*)(regB + (size_t)T * (768 + 512) * 2);
  p.kr = (bf16_t*)(regB + (size_t)T * (768 + 1024) * 2);
  p.hb = (bf16_t*)regC;
  p.w_qb = (bf16_t*)(regC + (size_t)40 * 1024 * 1024);
  bf16_t* c = (bf16_t*)regC;
  const size_t a512 = (size_t)T * 512;
  p.rr = c; p.rk2 = c + a512; p.rv = c + 2 * a512; p.rkk = c + 3 * a512; p.rbb = c + 4 * a512; p.rg = c + 5 * a512; p.rlw = c + 6 * a512;
  p.u8 = (unsigned char*)regC;
  p.v8 = p.u8 + (size_t)16384 * 1024;
  static int grid_blocks = 0;
  if (!grid_blocks) {
    int dev = 0, cus = 0, per_cu = 0;
    (void)hipGetDevice(&dev);
    (void)hipDeviceGetAttribute(&cus, hipDeviceAttributeMultiprocessorCount, dev);
    (void)hipOccupancyMaxActiveBlocksPerMultiprocessor(&per_cu, k_mega, NTHR, 0);
    if (per_cu > 2) per_cu = 2;
    grid_blocks = cus * per_cu;
  }
  (void)hipMemsetAsync(p.bar, 0, zero_bytes, stream);
  void* args[] = {&p};
  hipError_t e = hipLaunchCooperativeKernel((void*)k_mega, dim3(grid_blocks), dim3(NTHR), args, 0, stream);
  if (e != hipSuccess) fprintf(stderr, "cooperative launch failed: %s (grid %d)\n", hipGetErrorString(e), grid_blocks);
}
```
